# Optimizing an MI355X kernel written in HIP

```python
import math
import jax, jax.numpy as jnp
from jax import lax
import numpy as np

D_MODEL = 4096
BATCH = 2
SEQ = 8192
DEPTH = 1

A_WIDTH = D_MODEL // 2
A_CHUNK = 128
A_HEADS = 16
A_HEAD_DIM = A_WIDTH // A_HEADS
B_WIDTH = D_MODEL // 4
S5_GROUP_DIM = 16
S5_GROUPS = B_WIDTH // S5_GROUP_DIM
S5_STATE = 64
DT_MIN = 1e-3
DT_MAX = 1e-1
D_FF = 4 * D_MODEL
NORM_EPS = 1e-6
IN_WIDTH = 2 * A_WIDTH + B_WIDTH + 2 * D_MODEL

kernel_name = "hybrid_gmlp_s5_gated_block"


def rms_norm(x, g):
    xf = x.astype(jnp.float32)
    y = xf * lax.rsqrt(jnp.mean(xf * xf, axis=-1, keepdims=True) + NORM_EPS)
    return (y * g.astype(jnp.float32)).astype(x.dtype)


def layer_norm(x, g, b):
    xf = x.astype(jnp.float32)
    mu = jnp.mean(xf, axis=-1, keepdims=True)
    xc = xf - mu
    y = xc * lax.rsqrt(jnp.mean(xc * xc, axis=-1, keepdims=True) + NORM_EPS)
    return (y * g.astype(jnp.float32) + b.astype(jnp.float32)).astype(x.dtype)


def chunked_spatial_gating(u, v, w_s, b_s):
    bt, seq_len, _ = u.shape
    n_chunks = seq_len // A_CHUNK
    v = v.reshape(bt, n_chunks, A_CHUNK, A_HEADS, A_HEAD_DIM)
    causal = jnp.tril(jnp.ones((A_CHUNK, A_CHUNK), dtype=bool))
    w = jnp.where(causal[None], w_s, jnp.zeros_like(w_s))
    mixed = jnp.einsum('hts,bcshe->bcthe', w, v) + b_s.T[None, None, :, :, None]
    return u * mixed.reshape(bt, seq_len, A_WIDTH)


def s5_layer(u, lam_re, lam_im, log_dt, b_re, b_im, c_re, c_im, d_skip):
    f32 = jnp.float32
    bt, seq_len, _ = u.shape
    uf = u.astype(f32).reshape(bt, seq_len, S5_GROUPS, S5_GROUP_DIM)
    lam = lax.complex(lam_re.astype(f32), lam_im.astype(f32))
    dt = jnp.exp(log_dt.astype(f32))[:, None]
    a_bar = jnp.exp(lam * dt)
    b_mat = lax.complex(b_re.astype(f32), b_im.astype(f32))
    b_bar = ((a_bar - 1.0) / lam)[..., None] * b_mat
    c_mat = lax.complex(c_re.astype(f32), c_im.astype(f32))
    bu = jnp.einsum('gph,blgh->blgp', b_bar, uf.astype(jnp.complex64))
    a_seq = jnp.broadcast_to(a_bar, bu.shape)

    def combine(left, right):
        a_l, b_l = left
        a_r, b_r = right
        return a_r * a_l, a_r * b_l + b_r

    _, states = lax.associative_scan(combine, (a_seq, bu), axis=1)
    y = jnp.einsum('ghp,blgp->blgh', c_mat, states).real
    y = y + d_skip.astype(f32).reshape(S5_GROUPS, S5_GROUP_DIM) * uf
    return y.reshape(bt, seq_len, B_WIDTH).astype(u.dtype)


def setup_inputs(seed: int = 0) -> dict:
    key = jax.random.key(seed)
    ks = jax.random.split(key, 32)
    f32 = jnp.float32
    L = DEPTH

    def nrm(k, shape, scale):
        return jax.random.normal(k, shape, f32) * scale

    def gain(k, shape):
        return 1.0 + 0.02 * jax.random.normal(k, shape, f32)

    x = jax.random.normal(ks[0], (BATCH, SEQ, D_MODEL), f32)
    norm_mix_pre = gain(ks[1], (L, D_MODEL))
    w_in = nrm(ks[2], (L, D_MODEL, IN_WIDTH), D_MODEL ** -0.5)
    v_norm_g = gain(ks[3], (L, A_WIDTH))
    v_norm_b = nrm(ks[4], (L, A_WIDTH), 0.02)
    w_spatial = nrm(ks[5], (L, A_HEADS, A_CHUNK, A_CHUNK), 0.5 * A_CHUNK ** -0.5)
    b_spatial = gain(ks[6], (L, A_HEADS, A_CHUNK))
    w_proj_a = nrm(ks[7], (L, A_WIDTH, D_MODEL), A_WIDTH ** -0.5)
    n = jnp.arange(S5_STATE, dtype=f32)
    lam_re = -0.5 + 0.01 * jax.random.normal(ks[8], (L, S5_GROUPS, S5_STATE), f32)
    lam_im = math.pi * n + 0.01 * jax.random.normal(ks[9], (L, S5_GROUPS, S5_STATE), f32)
    log_dt = jax.random.uniform(ks[10], (L, S5_GROUPS), f32, math.log(DT_MIN), math.log(DT_MAX))
    b_re = nrm(ks[11], (L, S5_GROUPS, S5_STATE, S5_GROUP_DIM), (2 * S5_GROUP_DIM) ** -0.5)
    b_im = nrm(ks[12], (L, S5_GROUPS, S5_STATE, S5_GROUP_DIM), (2 * S5_GROUP_DIM) ** -0.5)
    c_re = nrm(ks[13], (L, S5_GROUPS, S5_GROUP_DIM, S5_STATE), (2 * S5_STATE) ** -0.5)
    c_im = nrm(ks[14], (L, S5_GROUPS, S5_GROUP_DIM, S5_STATE), (2 * S5_STATE) ** -0.5)
    d_skip = nrm(ks[15], (L, B_WIDTH), 1.0)
    w_glu_a = nrm(ks[16], (L, B_WIDTH, D_MODEL), B_WIDTH ** -0.5)
    w_glu_b = nrm(ks[17], (L, B_WIDTH, D_MODEL), B_WIDTH ** -0.5)
    w_out = nrm(ks[18], (L, D_MODEL, D_MODEL), D_MODEL ** -0.5)
    norm_mix_post = gain(ks[19], (L, D_MODEL))
    norm_mlp_pre = gain(ks[20], (L, D_MODEL))
    w_ff_up = nrm(ks[21], (L, D_MODEL, D_FF), D_MODEL ** -0.5)
    w_ff_down = nrm(ks[22], (L, D_FF, D_MODEL), D_FF ** -0.5)
    norm_mlp_post = gain(ks[23], (L, D_MODEL))
    return {"x": x, "norm_mix_pre": norm_mix_pre, "w_in": w_in, "v_norm_g": v_norm_g,
            "v_norm_b": v_norm_b, "w_spatial": w_spatial, "b_spatial": b_spatial,
            "w_proj_a": w_proj_a, "lam_re": lam_re, "lam_im": lam_im, "log_dt": log_dt,
            "b_re": b_re, "b_im": b_im, "c_re": c_re, "c_im": c_im, "d_skip": d_skip,
            "w_glu_a": w_glu_a, "w_glu_b": w_glu_b, "w_out": w_out,
            "norm_mix_post": norm_mix_post, "norm_mlp_pre": norm_mlp_pre,
            "w_ff_up": w_ff_up, "w_ff_down": w_ff_down, "norm_mlp_post": norm_mlp_post}


def reference(x, norm_mix_pre, w_in, v_norm_g, v_norm_b, w_spatial, b_spatial, w_proj_a,
              lam_re, lam_im, log_dt, b_re, b_im, c_re, c_im, d_skip, w_glu_a, w_glu_b,
              w_out, norm_mix_post, norm_mlp_pre, w_ff_up, w_ff_down, norm_mlp_post):
    for l in range(DEPTH):
        h = rms_norm(x, norm_mix_pre[l])
        proj = h @ w_in[l]
        o1 = 2 * A_WIDTH
        o2 = o1 + B_WIDTH
        o3 = o2 + D_MODEL
        z_a = jax.nn.gelu(proj[..., :o1])
        u_a, v_a = z_a[..., :A_WIDTH], z_a[..., A_WIDTH:]
        x_b = proj[..., o1:o2]
        gate_a = jax.nn.sigmoid(proj[..., o2:o3])
        gate_b = jax.nn.sigmoid(proj[..., o3:])
        v_a = layer_norm(v_a, v_norm_g[l], v_norm_b[l])
        s_a = chunked_spatial_gating(u_a, v_a, w_spatial[l], b_spatial[l])
        branch_a = s_a @ w_proj_a[l]
        y_b = s5_layer(x_b, lam_re[l], lam_im[l], log_dt[l], b_re[l], b_im[l],
                       c_re[l], c_im[l], d_skip[l])
        z_b = jax.nn.gelu(y_b)
        branch_b = (z_b @ w_glu_a[l]) * jax.nn.sigmoid(z_b @ w_glu_b[l])
        mix = (gate_a * branch_a + gate_b * branch_b) @ w_out[l]
        x = x + rms_norm(mix, norm_mix_post[l])
        h = rms_norm(x, norm_mlp_pre[l])
        ff = jnp.square(jax.nn.relu(h @ w_ff_up[l])) @ w_ff_down[l]
        x = x + rms_norm(ff, norm_mlp_post[l])
    return x
```

```cpp
#include <hip/hip_runtime.h>
#include <cstdio>
#include <cstdint>

#ifndef MK_N_LAUNCHES
#define MK_N_LAUNCHES 1
#endif
namespace pg8 {
#define PG8_LAS __attribute__((address_space(3)))
typedef unsigned short bf16_t;
typedef short bf16x8 __attribute__((ext_vector_type(8)));
typedef float f32x4 __attribute__((ext_vector_type(4)));
typedef unsigned u32x4 __attribute__((ext_vector_type(4)));
typedef int v4i_t __attribute__((ext_vector_type(4)));
typedef int v8i_t __attribute__((ext_vector_type(8)));
constexpr int BM = 256, BK = 64, HALF = 128, HTB = HALF * BK * 2  , STAGE_BYTES = 8 * HTB, NXCD = 8, WGM = 8;

__host__ __device__ __forceinline__ int lds_byte(int r, int c) { const int st = (r >> 4) * 2 + (c >> 5), rr = r & 15, cc = c & 31, ob = rr * 64 + cc * 2; return st * 1024 + (ob ^ (((ob >> 9) & 1) << 5)); }
__host__ __device__ __forceinline__ void stage_rc(int b, int& R, int& C) { const int st = b / 1024, sb = b % 1024, swz = sb ^ (((sb >> 9) & 1) << 5); R = (st >> 1) * 16 + swz / 64; C = (st & 1) * 32 + (swz % 64) / 2; }
__host__ __device__ __forceinline__ int perm32(int rho) { const int n = rho >> 4, i = rho & 15; return 8 * (i >> 2) + 4 * n + (i & 3); }

struct Unit { int pm, pn; };
struct Gemm { const bf16_t* A; const bf16_t* Bt; int M, N, K; };

struct StaticOrder {
    int nM, nN, nwg, G, c, wgm;
    __host__ __device__ void init(int M, int N, int G_, int c_, int wgm_ = WGM) { nM = M / BM; nN = N / BM; nwg = nM * nN; G = G_; c = c_; wgm = wgm_; }
    __host__ __device__ __forceinline__ bool next(int i, Unit& u) const {
        const long L = (long)i * G + c; if (L >= nwg) return false;
        int wgid = (int)L; { const int q = nwg / NXCD, r = nwg % NXCD, xcd = wgid % NXCD, off = wgid / NXCD; wgid = (xcd < r ? xcd * (q + 1) : r * (q + 1) + (xcd - r) * q) + off; }
        const int nig = wgm * nN, gid = wgid / nig, fm = gid * wgm, gsz = (nM - fm) < wgm ? (nM - fm) : wgm;
        u.pm = fm + ((wgid % nig) % gsz); u.pn = (wgid % nig) / gsz; return true;
    }
    __device__ __forceinline__ void a_ready(const Unit&) const {}
    __device__ __forceinline__ void done(const Unit&) const {}
};

__device__ __forceinline__ unsigned cvt_pk_bf16(float lo, float hi) { unsigned r; asm volatile("v_cvt_pk_bf16_f32 %0, %1, %2" : "=v"(r) : "v"(lo), "v"(hi)); return r; }
#ifndef MANT6
#define MANT6 0
#endif
__device__ __forceinline__ unsigned cvt_pk_op(float lo, float hi) {
#if MANT6
    unsigned a = __float_as_uint(lo), b = __float_as_uint(hi); a += 0xFFFFu + ((a >> 17) & 1u); b += 0xFFFFu + ((b >> 17) & 1u); return ((a >> 16) & 0xFFFEu) | (b & 0xFFFE0000u);
#else
    return cvt_pk_bf16(lo, hi);
#endif
}
typedef float f32x2 __attribute__((ext_vector_type(2)));
__device__ __forceinline__ f32x2 gelu_pk(f32x2 v) {
    const f32x2 av = __builtin_elementwise_abs(v), d = av * 0.2316418882f + 1.0f;
    f32x2 t; t.x = __builtin_amdgcn_rcpf(d.x); t.y = __builtin_amdgcn_rcpf(d.y);
    f32x2 q = t * 0.5307027145f + (-0.7265760135f); q = q * t + 0.7107068705f; q = q * t + (-0.142248368f); q = q * t + 0.127414796f; q = q * t;
    const f32x2 s = (v * v) * (-0.72134752044f);
    f32x2 e; e.x = __builtin_amdgcn_exp2f(s.x); e.y = __builtin_amdgcn_exp2f(s.y);
    const f32x2 m = v * (q * e), r = v - m;
    f32x2 o; o.x = v.x < 0.f ? m.x : r.x; o.y = v.y < 0.f ? m.y : r.y; return o;
}

typedef unsigned u32x2 __attribute__((ext_vector_type(2)));
#ifndef UP_NT
#define UP_NT 0
#endif
#if UP_NT
#define UP_STORE(p, v) __builtin_nontemporal_store((v), (p))
#else
#define UP_STORE(p, v) (*(p) = (v))
#endif
#ifndef EPI_NT
#define EPI_NT 0
#endif
#if EPI_NT
#define NT_STORE(p, v) __builtin_nontemporal_store((v), (p))
#else
#define NT_STORE(p, v) (*(p) = (v))
#endif
__device__ __forceinline__ float sigmoid_f(float x) { return __builtin_amdgcn_rcpf(1.0f + __builtin_amdgcn_exp2f(-1.4426950409f * x)); }
__device__ __forceinline__ float gelu_tanh_f(float x) { const float u = x * (1.0f + 0.044715f * x * x); return x * __builtin_amdgcn_rcpf(1.0f + __builtin_amdgcn_exp2f(-2.3022082f * u)); }
__device__ __forceinline__ float bf_lo(unsigned w) { return __uint_as_float(w << 16); }
__device__ __forceinline__ float bf_hi(unsigned w) { return __uint_as_float(w & 0xffff0000u); }
__device__ __forceinline__ u32x4 pack8(const f32x4& v0, const f32x4& v1) { u32x4 w; w.x = cvt_pk_op(v0[0], v0[1]); w.y = cvt_pk_op(v0[2], v0[3]); w.z = cvt_pk_op(v1[0], v1[1]); w.w = cvt_pk_op(v1[2], v1[3]); return w; }
__device__ __forceinline__ u32x4 pack8f(const f32x4& v0, const f32x4& v1) { u32x4 w; w.x = cvt_pk_bf16(v0[0], v0[1]); w.y = cvt_pk_bf16(v0[2], v0[3]); w.z = cvt_pk_bf16(v1[0], v1[1]); w.w = cvt_pk_bf16(v1[2], v1[3]); return w; }

__device__ __forceinline__ size_t t4096_off(bool tiled, int row, int c) { return tiled ? ((((size_t)(row >> 8) * 64 + (size_t)(c >> 6)) * 256 + (size_t)(row & 255)) * 64 + (size_t)(c & 63)) : ((size_t)row * 4096 + c); }
struct EpiIn {
    static constexpr bool PERM = true, AFTER_DRAIN = false;
    bf16_t *UA, *VA, *XB2, *GA, *GB; float* VST; int split, off_lo, off_hi; const float* rs; const float* cs; int ga_tiled;
    __device__ __forceinline__ void operator()(const f32x4 (&acc)[2][2][4][2], const Unit& u, int wr, int wc, int fr, int fq) const {
        const int row0 = u.pm * BM + wr * 64 + fr; const int pn = u.pn + (u.pn < split ? off_lo : off_hi);
        int mode, ldc, colt; bf16_t* base;
        if (pn < 8) { mode = 0; base = UA; ldc = 2048; colt = pn * 256; }
        else if (pn < 16) { mode = 0; base = VA; ldc = 2048; colt = (pn - 8) * 256; }
        else if (pn < 20) { mode = 1; base = XB2; ldc = 0; colt = (pn - 16) * 256; }
        else if (pn < 36) { mode = 2; base = GA; ldc = 4096; colt = (pn - 20) * 256; }
        else { mode = 2; base = GB; ldc = 4096; colt = (pn - 36) * 256; }
        const int col0 = colt + wc * 32 + 8 * fq; const bool vstat = (pn >= 8 && pn < 16); const bool q8 = (rs != nullptr);
        f32x4 csv[2][2];
        if (q8) {
#pragma unroll
            for (int bj = 0; bj < 2; ++bj) { const float* cp = cs + u.pn * BM + wc * 32 + 8 * fq + bj * HALF; csv[bj][0] = *(const f32x4*)cp; csv[bj][1] = *(const f32x4*)(cp + 4); } }
        float rsa[2][4];
#pragma unroll
        for (int ai = 0; ai < 2; ++ai)
#pragma unroll
            for (int m = 0; m < 4; ++m) rsa[ai][m] = q8 ? rs[row0 + ai * HALF + m * 16] : 1.0f;
        __builtin_amdgcn_sched_barrier(0);
#pragma unroll
        for (int ai = 0; ai < 2; ++ai)
#pragma unroll
            for (int m = 0; m < 4; ++m) { const int row = row0 + ai * HALF + m * 16; float s1 = 0.f, s2 = 0.f; const float rsv = rsa[ai][m];
#pragma unroll
                for (int bj = 0; bj < 2; ++bj) { f32x4 v0 = acc[ai][bj][m][0], v1 = acc[ai][bj][m][1]; const int c = col0 + bj * HALF;
                    if (q8) {
#pragma unroll
                        for (int j = 0; j < 4; ++j) { v0[j] = (float)__float_as_int(v0[j]) * (rsv * csv[bj][0][j]); v1[j] = (float)__float_as_int(v1[j]) * (rsv * csv[bj][1][j]); } }
                    if (mode == 0) {
#pragma unroll
                        for (int j = 0; j < 4; ++j) { v0[j] = gelu_tanh_f(v0[j]); v1[j] = gelu_tanh_f(v1[j]); }
                        if (vstat) { s1 += ((v0[0] + v0[1]) + (v0[2] + v0[3])) + ((v1[0] + v1[1]) + (v1[2] + v1[3]));
                            s2 += ((v0[0] * v0[0] + v0[1] * v0[1]) + (v0[2] * v0[2] + v0[3] * v0[3])) + ((v1[0] * v1[0] + v1[1] * v1[1]) + (v1[2] * v1[2] + v1[3] * v1[3])); } }
                    else if (mode == 2) {
#pragma unroll
                        for (int j = 0; j < 4; ++j) { v0[j] = sigmoid_f(v0[j]); v1[j] = sigmoid_f(v1[j]); } }
                    bf16_t* p;
                    if (mode == 1) p = base + ((((size_t)(c >> 4) * 512 + (size_t)(row >> 5)) * 32 + (size_t)(row & 31)) * 16 + (size_t)(c & 15));
                    else if (mode == 0 && ga_tiled) p = base + ((((size_t)(row >> 7) * 16 + (size_t)(c >> 7)) * 128 + (size_t)(row & 127)) * 128 + (size_t)(c & 127));
                    else if (mode == 2) p = base + t4096_off(ga_tiled != 0, row, c);
                    else p = base + (size_t)row * ldc + c;
                    NT_STORE((u32x4*)p, pack8(v0, v1)); }
                if (vstat) { s1 += __shfl_xor(s1, 16); s1 += __shfl_xor(s1, 32); s2 += __shfl_xor(s2, 16); s2 += __shfl_xor(s2, 32);
                    if (fq == 0) { f32x2 o; o.x = s1; o.y = s2; *(f32x2*)(VST + ((size_t)row * 32 + (pn - 8) * 4 + wc) * 2) = o; } } }
    }
};
#ifndef EPI_NT_LD
#define EPI_NT_LD 1
#endif
#if EPI_NT_LD
#define EPI_LD1(p) __builtin_nontemporal_load(p)
#else
#define EPI_LD1(p) (*(p))
#endif
struct EpiGlu {
    static constexpr bool PERM = true, AFTER_DRAIN = false;
    bf16_t* GBm; int gb_tiled;
    __device__ __forceinline__ void operator()(const f32x4 (&acc)[2][2][4][2], const Unit& u, int wr, int wc, int fr, int fq) const {
        const int row0 = u.pm * BM + wr * 64 + fr, oc0 = u.pn * 128 + wc * 32 + 8 * fq;
        u32x4 ga[2][4];
#pragma unroll
        for (int ai = 0; ai < 2; ++ai)
#pragma unroll
            for (int m = 0; m < 4; ++m) ga[ai][m] = EPI_LD1((const u32x4*)(GBm + t4096_off(gb_tiled != 0, row0 + ai * HALF + m * 16, oc0)));
        __builtin_amdgcn_sched_barrier(0);
#pragma unroll
        for (int ai = 0; ai < 2; ++ai)
#pragma unroll
            for (int m = 0; m < 4; ++m) { bf16_t* p = GBm + t4096_off(gb_tiled != 0, row0 + ai * HALF + m * 16, oc0); const u32x4 g = ga[ai][m];
                const f32x4 a0 = acc[ai][0][m][0], a1 = acc[ai][0][m][1], b0 = acc[ai][1][m][0], b1 = acc[ai][1][m][1]; f32x4 o0, o1;
                o0[0] = a0[0] * sigmoid_f(b0[0]) * bf_lo(g.x); o0[1] = a0[1] * sigmoid_f(b0[1]) * bf_hi(g.x); o0[2] = a0[2] * sigmoid_f(b0[2]) * bf_lo(g.y); o0[3] = a0[3] * sigmoid_f(b0[3]) * bf_hi(g.y);
                o1[0] = a1[0] * sigmoid_f(b1[0]) * bf_lo(g.z); o1[1] = a1[1] * sigmoid_f(b1[1]) * bf_hi(g.z); o1[2] = a1[2] * sigmoid_f(b1[2]) * bf_lo(g.w); o1[3] = a1[3] * sigmoid_f(b1[3]) * bf_hi(g.w);
                *(u32x4*)p = pack8(o0, o1); }
    }
};
struct EpiProj {
    static constexpr bool PERM = true, AFTER_DRAIN = false;
    bf16_t* GA; const bf16_t* GBm; int ga_tiled;
    __device__ __forceinline__ void operator()(const f32x4 (&acc)[2][2][4][2], const Unit& u, int wr, int wc, int fr, int fq) const {
        const int row0 = u.pm * BM + wr * 64 + fr, col0 = u.pn * BM + wc * 32 + 8 * fq;
#pragma unroll
        for (int ai = 0; ai < 2; ++ai) {
            u32x4 gav[4][2], gbv[4][2];
#pragma unroll
            for (int m = 0; m < 4; ++m)
#pragma unroll
                for (int bj = 0; bj < 2; ++bj) { const int rr = row0 + ai * HALF + m * 16, cc = col0 + bj * HALF;
                    const bf16_t* gap = ga_tiled ? GA + ((((size_t)(rr >> 8) * 64 + (size_t)(cc >> 6)) * 256 + (size_t)(rr & 255)) * 64 + (size_t)(cc & 63)) : GA + (size_t)rr * 4096 + cc;
                    gav[m][bj] = EPI_LD1((const u32x4*)gap); gbv[m][bj] = EPI_LD1((const u32x4*)(GBm + t4096_off(ga_tiled != 0, rr, cc))); }
            __builtin_amdgcn_sched_barrier(0);
#pragma unroll
            for (int m = 0; m < 4; ++m) { const size_t off = (size_t)(row0 + ai * HALF + m * 16) * 4096 + col0;
#pragma unroll
                for (int bj = 0; bj < 2; ++bj) { const int rr = row0 + ai * HALF + m * 16, cc = col0 + bj * HALF;
                    bf16_t* gap = ga_tiled ? GA + ((((size_t)(rr >> 8) * 64 + (size_t)(cc >> 6)) * 256 + (size_t)(rr & 255)) * 64 + (size_t)(cc & 63)) : GA + off + bj * HALF;
                    const u32x4 ga = gav[m][bj], gb = gbv[m][bj];
                    const f32x4 a0 = acc[ai][bj][m][0], a1 = acc[ai][bj][m][1]; f32x4 o0, o1;
                    o0[0] = a0[0] * bf_lo(ga.x) + bf_lo(gb.x); o0[1] = a0[1] * bf_hi(ga.x) + bf_hi(gb.x); o0[2] = a0[2] * bf_lo(ga.y) + bf_lo(gb.y); o0[3] = a0[3] * bf_hi(ga.y) + bf_hi(gb.y);
                    o1[0] = a1[0] * bf_lo(ga.z) + bf_lo(gb.z); o1[1] = a1[1] * bf_hi(ga.z) + bf_hi(gb.z); o1[2] = a1[2] * bf_lo(ga.w) + bf_lo(gb.w); o1[3] = a1[3] * bf_hi(ga.w) + bf_hi(gb.w);
                    *(u32x4*)gap = pack8(o0, o1); } } }
    }
};
struct EpiStat {
    static constexpr bool PERM = true, AFTER_DRAIN = false;
    bf16_t* O; float* part; int tiled;
    __device__ __forceinline__ void operator()(const f32x4 (&acc)[2][2][4][2], const Unit& u, int wr, int wc, int fr, int fq) const {
        const int row0 = u.pm * BM + wr * 64 + fr, col0 = u.pn * BM + wc * 32 + 8 * fq;
#pragma unroll
        for (int ai = 0; ai < 2; ++ai)
#pragma unroll
            for (int m = 0; m < 4; ++m) { const int row = row0 + ai * HALF + m * 16; float s = 0.f;
#pragma unroll
                for (int bj = 0; bj < 2; ++bj) { const f32x4 v0 = acc[ai][bj][m][0], v1 = acc[ai][bj][m][1];
                    s += (v0[0] * v0[0] + v0[1] * v0[1]) + (v0[2] * v0[2] + v0[3] * v0[3]) + (v1[0] * v1[0] + v1[1] * v1[1]) + (v1[2] * v1[2] + v1[3] * v1[3]);
                    *(u32x4*)(O + t4096_off(tiled != 0, row, col0 + bj * HALF)) = pack8f(v0, v1); }
                s += __shfl_xor(s, 16); s += __shfl_xor(s, 32);
                if (fq == 0) part[(size_t)row * 64 + u.pn * 4 + wc] = s; }
    }
};
struct EpiUp {
    static constexpr bool PERM = true, AFTER_DRAIN = false;
    bf16_t* H; const float* rs; const float* cs; int tiled;
    __device__ __forceinline__ void operator()(const f32x4 (&acc)[2][2][4][2], const Unit& u, int wr, int wc, int fr, int fq) const {
        const int row0 = u.pm * BM + wr * 64 + fr, col0 = u.pn * BM + wc * 32 + 8 * fq; const bool q8 = (rs != nullptr);
        f32x4 csv[2][2];
        if (q8) {
#pragma unroll
            for (int bj = 0; bj < 2; ++bj) { const float* cp = cs + col0 + bj * HALF; csv[bj][0] = *(const f32x4*)cp; csv[bj][1] = *(const f32x4*)(cp + 4); } }
        float rsa[2][4];
#pragma unroll
        for (int ai = 0; ai < 2; ++ai)
#pragma unroll
            for (int m = 0; m < 4; ++m) rsa[ai][m] = q8 ? rs[row0 + ai * HALF + m * 16] : 1.0f;
        __builtin_amdgcn_sched_barrier(0);
#pragma unroll
        for (int ai = 0; ai < 2; ++ai)
#pragma unroll
            for (int m = 0; m < 4; ++m) { const int row = row0 + ai * HALF + m * 16; const float rsv = rsa[ai][m];
                bf16_t* rowp = tiled ? H + (((size_t)u.pm * 256 + (size_t)(u.pn * 4 + (wc >> 1))) * 256 + (size_t)(row & 255)) * 64 + (wc & 1) * 32 + 8 * fq : H + (size_t)row * 16384 + col0;
#pragma unroll
                for (int bj = 0; bj < 2; ++bj) { f32x4 v0 = acc[ai][bj][m][0], v1 = acc[ai][bj][m][1];
                    if (q8) {
#pragma unroll
                        for (int j = 0; j < 4; ++j) { v0[j] = (float)__float_as_int(v0[j]) * (rsv * csv[bj][0][j]); v1[j] = (float)__float_as_int(v1[j]) * (rsv * csv[bj][1][j]); } }
#pragma unroll
                    for (int j = 0; j < 4; ++j) { const float a = fmaxf(v0[j], 0.f), b = fmaxf(v1[j], 0.f); v0[j] = a * a; v1[j] = b * b; }
                    UP_STORE((u32x4*)(rowp + (tiled ? bj * 2 * 256 * 64 : bj * HALF)), pack8(v0, v1)); } }
    }
};

template <class Epi, class Sched, bool ALIGN_EPI = false, bool SP2 = false, bool I8 = false, int AUXA = 0, bool TA = false, bool TB = false>
__device__ __forceinline__ void gemm_phase(PG8_LAS unsigned char* lds, const Gemm g, const Sched& S, const Epi& E) {
    const int tid = threadIdx.x, wid = __builtin_amdgcn_readfirstlane(tid >> 6), lane = tid & 63, wr = wid >> 2, wc = wid & 3, fr = lane & 15, fq = lane >> 4;
    const int K = g.K, nt = K / BK;
    unsigned voffA[2], voffB[2];
#pragma unroll
    for (int i = 0; i < 2; ++i) { int R, C; stage_rc(tid * 16 + i * 8192, R, C); const int Rb = Epi::PERM ? ((R & ~31) + perm32(R & 31)) : R;
        voffA[i] = (unsigned)(R * (TA ? BK : K) + C) * 2u; voffB[i] = (unsigned)(Rb * (TB ? BK : K) + C) * 2u; }
    const size_t kstepA = TA ? (size_t)BM * BK * 2 : (size_t)(BK * 2), kstepB = TB ? (size_t)BM * BK * 2 : (size_t)(BK * 2);
    const size_t hstepA = TA ? (size_t)HALF * BK * 2 : (size_t)HALF * K * 2, hstepB = TB ? (size_t)HALF * BK * 2 : (size_t)HALF * K * 2;
    const size_t hstep = (size_t)HALF * K * 2;
    const size_t tstep = 2 * hstep;
    const unsigned ldsw = (unsigned)wid * 1024u;
    const int aoff = lds_byte(wr * 64 + fr, fq * 8), boff = lds_byte(wc * 32 + fr, fq * 8);
#define PG8_SA(b, h) (((b) * 2 + (h)) * HTB)
#define PG8_SB(b, h) ((4 + (b) * 2 + (h)) * HTB)
#define PG8_STAGE(bufoff, gbase, voff) do { _Pragma("unroll") for (int _i = 0; _i < 2; ++_i) \
        __builtin_amdgcn_global_load_lds((const unsigned*)((const char*)(gbase) + (voff)[_i]), (PG8_LAS unsigned*)(lds + (bufoff) + ldsw + _i * 8192), 16, 0, 0); } while (0)
#define PG8_STAGEA(bufoff, gbase, voff) do { _Pragma("unroll") for (int _i = 0; _i < 2; ++_i) \
        __builtin_amdgcn_global_load_lds((const unsigned*)((const char*)(gbase) + (voff)[_i]), (PG8_LAS unsigned*)(lds + (bufoff) + ldsw + _i * 8192), 16, 0, AUXA); } while (0)
#define PG8_LDA(dst, b, h) do { _Pragma("unroll") for (int m = 0; m < 4; ++m) _Pragma("unroll") for (int k = 0; k < 2; ++k) dst[m][k] = *(const PG8_LAS bf16x8*)(lds + PG8_SA(b, h) + aoff + m * 2048 + k * 1024); } while (0)
#define PG8_LDB(dst, b, h) do { _Pragma("unroll") for (int n = 0; n < 2; ++n) _Pragma("unroll") for (int k = 0; k < 2; ++k) dst[n][k] = *(const PG8_LAS bf16x8*)(lds + PG8_SB(b, h) + boff + n * 2048 + k * 1024); } while (0)
#define PG8_MMA(ai, bj, At, Bt) do { __builtin_amdgcn_s_setprio(1); _Pragma("unroll") for (int m = 0; m < 4; ++m) _Pragma("unroll") for (int n = 0; n < 2; ++n) _Pragma("unroll") for (int k = 0; k < 2; ++k) { \
        if constexpr (I8) { acc[ai][bj][m][n] = __builtin_bit_cast(f32x4, __builtin_amdgcn_mfma_i32_16x16x64_i8(__builtin_bit_cast(v4i_t, Bt[n][k]), __builtin_bit_cast(v4i_t, At[m][k]), __builtin_bit_cast(v4i_t, acc[ai][bj][m][n]), 0, 0, 0)); } \
        else acc[ai][bj][m][n] = __builtin_amdgcn_mfma_f32_16x16x32_bf16(Bt[n][k], At[m][k], acc[ai][bj][m][n], 0, 0, 0); } __builtin_amdgcn_s_setprio(0); } while (0)
#define PG8_WAIT_V(n) asm volatile("s_waitcnt vmcnt(" #n ")" ::: "memory")
#define PG8_WAIT_L(n) asm volatile("s_waitcnt lgkmcnt(" #n ")" ::: "memory")
#define PG8_BAR __builtin_amdgcn_s_barrier()
#define PG8_SCHED __builtin_amdgcn_sched_barrier(0)
    Unit cur, nxt; int ui = 0;
    if (!S.next(0, cur)) return;
    f32x4 acc[2][2][4][2];
#pragma unroll
    for (int a = 0; a < 2; ++a)
#pragma unroll
        for (int b = 0; b < 2; ++b)
#pragma unroll
            for (int m = 0; m < 4; ++m)
#pragma unroll
                for (int n = 0; n < 2; ++n) acc[a][b][m][n] = (f32x4){0.f, 0.f, 0.f, 0.f};
    bf16x8 At[4][2], B0[2][2], B1[2][2];
    const char* cA = (const char*)g.A + (size_t)cur.pm * tstep; const char* cB = (const char*)g.Bt + (size_t)cur.pn * tstep;
    S.a_ready(cur);
    if constexpr (SP2) {
        PG8_STAGE(PG8_SB(0, 0), cB, voffB); PG8_STAGE(PG8_SB(0, 1), cB + hstepB, voffB); PG8_STAGEA(PG8_SA(0, 0), cA, voffA); PG8_STAGEA(PG8_SA(0, 1), cA + hstepA, voffA);
        if (wr == 1) PG8_BAR;
        PG8_WAIT_V(2); PG8_BAR;
        PG8_STAGE(PG8_SB(1, 0), cB + kstepB, voffB); PG8_STAGEA(PG8_SA(1, 0), cA + kstepA, voffA); PG8_STAGE(PG8_SB(1, 1), cB + hstepB + kstepB, voffB);
        PG8_WAIT_V(6); PG8_BAR;
    } else {
        PG8_STAGE(PG8_SB(0, 0), cB, voffB); PG8_STAGEA(PG8_SA(0, 0), cA, voffA); PG8_STAGE(PG8_SB(0, 1), cB + hstepB, voffB); PG8_STAGEA(PG8_SA(0, 1), cA + hstepA, voffA);
        if (wr == 1) PG8_BAR;
        PG8_WAIT_V(4); PG8_BAR;
        PG8_STAGE(PG8_SB(1, 0), cB + kstepB, voffB); PG8_STAGEA(PG8_SA(1, 0), cA + kstepA, voffA); PG8_STAGE(PG8_SB(1, 1), cB + hstepB + kstepB, voffB);
        PG8_WAIT_V(6); PG8_BAR;
    }
    for (;;) {
        const bool has_next = S.next(ui + 1, nxt);
        const char* nA = has_next ? (const char*)g.A + (size_t)nxt.pm * tstep : cA; const char* nB = has_next ? (const char*)g.Bt + (size_t)nxt.pn * tstep : cB;
        for (int t = 0; t < nt; t += 2) {
            const bool last = (t == nt - 2);
            const char* a1 = cA + (size_t)(t + 1) * kstepA;
            const char* a2 = last ? nA : cA + (size_t)(t + 2) * kstepA; const char* b2 = last ? nB : cB + (size_t)(t + 2) * kstepB;
            const char* a3 = a2 + kstepA; const char* b3 = b2 + kstepB;
            if (last && has_next) S.a_ready(nxt);
            if constexpr (SP2) {
            PG8_LDB(B0, 0, 0); PG8_LDB(B1, 0, 1); PG8_SCHED; PG8_LDA(At, 0, 0); PG8_STAGEA(PG8_SA(1, 1), a1 + hstepA, voffA);
            PG8_WAIT_V(8); PG8_WAIT_L(0); PG8_BAR; PG8_MMA(0, 0, At, B0); PG8_MMA(0, 1, At, B1); PG8_BAR; PG8_SCHED;
            PG8_LDA(At, 0, 1); PG8_STAGE(PG8_SB(0, 0), b2, voffB); PG8_STAGE(PG8_SB(0, 1), b2 + hstepB, voffB); PG8_STAGEA(PG8_SA(0, 0), a2, voffA);
            PG8_WAIT_V(8); PG8_WAIT_L(0); PG8_BAR; PG8_MMA(1, 0, At, B0); PG8_MMA(1, 1, At, B1); PG8_BAR; PG8_SCHED;
            PG8_LDB(B0, 1, 0); PG8_LDB(B1, 1, 1); PG8_SCHED; PG8_LDA(At, 1, 0); PG8_STAGEA(PG8_SA(0, 1), a2 + hstepA, voffA);
            PG8_WAIT_V(8); PG8_WAIT_L(0); PG8_BAR; PG8_MMA(0, 0, At, B0); PG8_MMA(0, 1, At, B1); PG8_BAR; PG8_SCHED;
            PG8_LDA(At, 1, 1); PG8_STAGE(PG8_SB(1, 0), b3, voffB); PG8_STAGE(PG8_SB(1, 1), b3 + hstepB, voffB); PG8_STAGEA(PG8_SA(1, 0), a3, voffA);
            PG8_WAIT_V(8); PG8_WAIT_L(0); PG8_BAR; PG8_MMA(1, 0, At, B0); PG8_MMA(1, 1, At, B1); PG8_BAR; PG8_SCHED;
            } else {
            PG8_LDB(B0, 0, 0); PG8_SCHED; PG8_LDA(At, 0, 0); PG8_STAGEA(PG8_SA(1, 1), a1 + hstepA, voffA);
            PG8_WAIT_L(8); PG8_BAR; PG8_WAIT_L(0); PG8_MMA(0, 0, At, B0); PG8_BAR; PG8_SCHED;
            PG8_LDB(B1, 0, 1); PG8_STAGE(PG8_SB(0, 0), b2, voffB);
            PG8_BAR; PG8_WAIT_L(0); PG8_MMA(0, 1, At, B1); PG8_BAR;
            PG8_LDA(At, 0, 1); PG8_STAGEA(PG8_SA(0, 0), a2, voffA);
            PG8_BAR; PG8_WAIT_L(0); PG8_MMA(1, 0, At, B0); PG8_BAR; PG8_SCHED;
            PG8_STAGE(PG8_SB(0, 1), b2 + hstepB, voffB);
            PG8_WAIT_V(6); PG8_BAR; PG8_MMA(1, 1, At, B1); PG8_BAR;
            PG8_LDB(B0, 1, 0); PG8_SCHED; PG8_LDA(At, 1, 0); PG8_STAGEA(PG8_SA(0, 1), a2 + hstepA, voffA);
            PG8_WAIT_L(8); PG8_BAR; PG8_WAIT_L(0); PG8_MMA(0, 0, At, B0); PG8_BAR; PG8_SCHED;
            PG8_LDB(B1, 1, 1); PG8_STAGE(PG8_SB(1, 0), b3, voffB);
            PG8_BAR; PG8_WAIT_L(0); PG8_MMA(0, 1, At, B1); PG8_BAR;
            PG8_LDA(At, 1, 1); PG8_STAGEA(PG8_SA(1, 0), a3, voffA);
            PG8_BAR; PG8_WAIT_L(0); PG8_MMA(1, 0, At, B0); PG8_BAR; PG8_SCHED;
            PG8_STAGE(PG8_SB(1, 1), b3 + hstepB, voffB);
            PG8_WAIT_V(6); PG8_BAR; PG8_MMA(1, 1, At, B1); PG8_BAR;
            }
        }
        if constexpr (ALIGN_EPI) { if (wr == 0) PG8_BAR; }
        if constexpr (!Epi::AFTER_DRAIN) { E(acc, cur, wr, wc, fr, fq); S.done(cur); }
        if (!has_next) break;
#pragma unroll
        for (int a = 0; a < 2; ++a)
#pragma unroll
            for (int b = 0; b < 2; ++b)
#pragma unroll
                for (int m = 0; m < 4; ++m)
#pragma unroll
                    for (int n = 0; n < 2; ++n) acc[a][b][m][n] = (f32x4){0.f, 0.f, 0.f, 0.f};
        cur = nxt; cA = nA; cB = nB; ++ui;
        if constexpr (ALIGN_EPI) { if (wr == 1) PG8_BAR; }
    }
    PG8_WAIT_V(0);
    if constexpr (!ALIGN_EPI) { if (wr == 0) PG8_BAR; }
    PG8_BAR;
    if constexpr (Epi::AFTER_DRAIN) { E.fused(acc, cur, wr, wc, fr, fq, lds, wid, lane); S.done(cur); }
#undef PG8_SA
#undef PG8_SB
#undef PG8_STAGE
#undef PG8_STAGEA
#undef PG8_LDA
#undef PG8_LDB
#undef PG8_MMA
#undef PG8_WAIT_V
#undef PG8_WAIT_L
#undef PG8_BAR
#undef PG8_SCHED
}
}
#ifndef TILED_A
#define TILED_A true
#endif
#ifndef TILED_HID
#define TILED_HID 1
#endif
#ifndef P8_AUXA
#define P8_AUXA 0
#endif
#ifndef P7_WGM
#define P7_WGM 8
#endif
#ifndef I8_SP2
#define I8_SP2 PG8_SP2
#endif
#ifndef I8_ALIGN
#define I8_ALIGN PG8_ALIGN
#endif
#ifndef P345_WGM
#define P345_WGM 8
#endif
#ifndef P8_WGM
#define P8_WGM 4
#endif
#ifndef PG8_SP2
#define PG8_SP2 true
#endif
#ifndef PG8_ALIGN
#define PG8_ALIGN true
#endif

constexpr int NWAVES = 8;
constexpr int N_LAUNCHES = MK_N_LAUNCHES;
constexpr int N_PHASES = 10;
constexpr int BATCH = 2, SEQ = 8192, D = 4096, M = BATCH * SEQ;
constexpr int AW = 2048, ACH = 128, AH = 16, AHD = 128;
constexpr int BW = 1024, SG = 64, SGD = 16, SP = 64;
constexpr int DFF = 16384, INW = 2 * AW + BW + 2 * D;
constexpr int TC = 32, NCHB = SEQ / TC, NCH = M / TC;
constexpr float NORM_EPS = 1e-6f;

constexpr size_t MiB = 1u << 20;
constexpr size_t WS_CTL = 0, CTL_ZERO_BYTES = 1 * MiB;
constexpr size_t WS_WIN = 1 * MiB, WS_WPROJ = 105 * MiB, WS_WGLU = 121 * MiB, WS_WOUT = 137 * MiB, WS_WUP = 169 * MiB, WS_WDN = 297 * MiB;
constexpr size_t WS_KTAB = 425 * MiB, WS_BMAT = 426 * MiB, WS_CMAT = 434 * MiB, WS_AT = 442 * MiB;
constexpr size_t WS_PART = 443 * MiB;
constexpr size_t WS_ARB = 448 * MiB;
constexpr size_t WS_ARA = 576 * MiB;
constexpr size_t WS_UA = WS_ARA, WS_VA = WS_ARA + 64 * MiB, WS_XB2 = WS_ARA + 128 * MiB, WS_ZB = WS_ARA + 160 * MiB, WS_GA = WS_ARA + 192 * MiB, WS_GB = WS_ARA + 320 * MiB;
#ifndef IN_INT8
#define IN_INT8 2
#endif
constexpr int NG8 = IN_INT8 == 2 ? INW : IN_INT8 == 1 ? 1024 + 2048 + 8192 : 2048 + 8192, N16 = INW - NG8;
__host__ __device__ constexpr int win_row16(int n) { return n < 2048 ? n : n - 2048; }
__host__ __device__ constexpr int win_row8(int n) { return n < 4096 ? n - 2048 : n - 3072; }
__host__ __device__ constexpr int win_col8(int r) { return IN_INT8 == 2 ? r : IN_INT8 == 1 ? r + 2048 : (r < 2048 ? r + 2048 : r + 3072); }
__host__ __device__ constexpr int win_col16(int r) { return r < 2048 ? r : r + 2048; }
constexpr size_t WS_H8 = WS_ARA + 448 * MiB;
constexpr size_t WS_W8 = WS_WIN + (size_t)N16 * D * 2;
constexpr size_t WS_H2Q = WS_WIN;
static_assert(WS_W8 + (size_t)NG8 * D <= WS_WPROJ && WS_H2Q + (size_t)M * D <= WS_WOUT, "int8 copies");
constexpr size_t WS_RS1 = WS_AT + 64 * 1024, WS_RS2 = WS_AT + 128 * 1024, WS_CSIN = WS_AT + 192 * 1024, WS_CSUP = WS_AT + 256 * 1024;
static_assert(WS_CSIN + (size_t)NG8 * 4 <= WS_CSUP && WS_CSUP + (size_t)DFF * 4 <= WS_PART, "scale arrays");
constexpr int CW_CMAXIN = 16384, CW_CMAXUP = 32768;
static_assert((CW_CMAXUP + DFF) * 4 <= (int)(1u << 20) && CW_CMAXIN + NG8 <= CW_CMAXUP, "CTL words inside the memset region");
constexpr size_t WS_END = 1088 * MiB;
static_assert(WS_WIN + (size_t)INW * D * 2 <= WS_WPROJ && WS_WPROJ + (size_t)D * AW * 2 <= WS_WGLU && WS_WGLU + (size_t)2 * D * BW * 2 <= WS_WOUT && WS_WOUT + (size_t)D * D * 2 <= WS_WUP &&
              WS_WUP + (size_t)DFF * D * 2 <= WS_WDN && WS_WDN + (size_t)D * DFF * 2 <= WS_KTAB, "weight map");
static_assert(WS_KTAB + (size_t)SG * TC * 256 * 2 <= WS_BMAT && WS_BMAT + (size_t)SG * 128 * 512 * 2 <= WS_CMAT && WS_CMAT + (size_t)SG * 512 * 128 * 2 <= WS_AT && WS_AT + (size_t)SG * SP * 8 <= WS_PART &&
              WS_PART + (size_t)M * 64 * 4 <= WS_ARB && WS_ARB + (size_t)M * D * 2 <= WS_ARA && WS_GB + (size_t)M * D * 2 <= WS_END && WS_ARA + (size_t)M * DFF * 2 <= WS_END, "activation map");
constexpr int CW_TMO = 0, CW_CODE = 1, CW_BAR = 4096;

constexpr int RING_OFF = 0, RING_BYTES = 131072;
constexpr int LDSCTL_OFF = RING_BYTES, MISC_OFF = LDSCTL_OFF + 320;
constexpr int LDS_BYTES = 147456;
static_assert(MISC_OFF + 128 <= LDS_BYTES, "LDS map");

#define GAS __attribute__((address_space(1)))
#define LAS __attribute__((address_space(3)))
typedef unsigned short bf16;
typedef unsigned v4u __attribute__((ext_vector_type(4)));
typedef unsigned v2u __attribute__((ext_vector_type(2)));
typedef float f32x4 __attribute__((ext_vector_type(4)));
typedef float f32x2 __attribute__((ext_vector_type(2)));
typedef short bf16x8 __attribute__((ext_vector_type(8)));
typedef GAS unsigned gu32;
#define RLX_AGENT __ATOMIC_RELAXED, __HIP_MEMORY_SCOPE_AGENT
#ifndef NT_STREAM
#define NT_STREAM 1
#endif
#if NT_STREAM
#define LD_STREAM(p) __builtin_nontemporal_load(p)
#define ST_STREAM(p, v) __builtin_nontemporal_store((v), (p))
#else
#define LD_STREAM(p) (*(p))
#define ST_STREAM(p, v) (*(p) = (v))
#endif
#define LDS_WAIT() asm volatile("s_waitcnt lgkmcnt(0)" ::: "memory")
#define VM_WAIT() asm volatile("s_waitcnt vmcnt(0)" ::: "memory")
__device__ __forceinline__ unsigned pk2(float lo, float hi) { return pg8::cvt_pk_op(lo, hi); }
__device__ __forceinline__ unsigned pk2x(float lo, float hi) { return pg8::cvt_pk_bf16(lo, hi); }
__device__ __forceinline__ float bflo(unsigned w) { return __uint_as_float(w << 16); }
__device__ __forceinline__ float bfhi(unsigned w) { return __uint_as_float(w & 0xffff0000u); }
__device__ __forceinline__ float gelu_t(float x) { return pg8::gelu_tanh_f(x); }

#define XB_TMO      128
#define XB_XCNT(j)  (256  + 64 * (j))
#define XB_XSUB(j)  (1280 + 64 * (j))
#define XB_XGEN(j)  (2304 + 64 * (j))
#define XB_TOP      3328
#define XB_TOPGEN   3392
#define XCD_BAR_WORDS 3456
#define XB_SPIN_CAP (1u << 18)

__device__ __forceinline__ unsigned xb_ld(unsigned* p)              { return __hip_atomic_load(p, __ATOMIC_RELAXED, __HIP_MEMORY_SCOPE_AGENT); }
__device__ __forceinline__ unsigned xb_add(unsigned* p, unsigned v) { return __hip_atomic_fetch_add(p, v, __ATOMIC_RELAXED, __HIP_MEMORY_SCOPE_AGENT); }
__device__ __forceinline__ unsigned xb_xcc_id() { return (unsigned)__builtin_amdgcn_s_getreg((3 << 11) | 20) & 0xFu; }
#define XB_SPIN(cond, bar) do { unsigned _sp = 0; while (cond) { __builtin_amdgcn_s_sleep(1); \
    if ((++_sp & 255u) == 0u) { if (xb_ld(&(bar)[XB_TMO])) break; if (_sp > XB_SPIN_CAP) { atomicAdd(&(bar)[XB_TMO], 1u); break; } } } } while (0)

struct XcdBarrier { unsigned* bar; unsigned x; volatile LAS unsigned* st; };

__device__ __forceinline__ XcdBarrier xcd_barrier_post(unsigned* bar, volatile LAS unsigned* st) {
    XcdBarrier b; b.bar = bar; b.x = xb_xcc_id(); b.st = st;
    if (threadIdx.x == 0) (void)xb_add(&bar[XB_XCNT(b.x)], 1u);
    return b;
}
__device__ __forceinline__ void xcd_barrier_complete(unsigned* bar, unsigned x, unsigned& nloc, unsigned& nx) {
    const unsigned G = gridDim.x * gridDim.y * gridDim.z;
    unsigned sum, cnt, mine, sp = 0u;
    for (;;) {
        sum = 0u; cnt = 0u; mine = 0u;
#pragma unroll
        for (unsigned j = 0; j < 16; ++j) { const unsigned c = xb_ld(&bar[XB_XCNT(j)]); sum += c; cnt += (c > 0u) ? 1u : 0u; mine = (j == x) ? c : mine; }
        if (sum == G) break;
        __builtin_amdgcn_s_sleep(1);
        if ((++sp & 255u) == 0u) { if (xb_ld(&bar[XB_TMO])) break; if (sp > XB_SPIN_CAP) { atomicAdd(&bar[XB_TMO], 1u); break; } }
    }
    nloc = mine > 0u ? mine : 1u; nx = cnt > 0u ? cnt : 1u;
}
__device__ __forceinline__ void xcd_barrier(const XcdBarrier& b) {
    asm volatile("s_waitcnt vmcnt(0)" ::: "memory");
    __syncthreads();
    if (threadIdx.x == 0) {
        unsigned* bar = b.bar;
        __builtin_amdgcn_s_waitcnt(0);
        unsigned nloc = b.st[0], nx = b.st[1];
        if (nloc == 0u) { xcd_barrier_complete(bar, b.x, nloc, nx); b.st[0] = nloc; b.st[1] = nx; }
        const unsigned old = xb_add(&bar[XB_XSUB(b.x)], 1u);
        const unsigned gen = old / nloc;
        if (old + 1u == (gen + 1u) * nloc) {
            __builtin_amdgcn_fence(__ATOMIC_RELEASE, "agent");
            asm volatile("s_waitcnt vmcnt(0)" ::: "memory");
            const unsigned og = xb_add(&bar[XB_TOP], 1u);
            const unsigned tg = og / nx;
            if (og + 1u == (tg + 1u) * nx) xb_add(&bar[XB_TOPGEN], 1u);
            else XB_SPIN(xb_ld(&bar[XB_TOPGEN]) == tg, bar);
            __builtin_amdgcn_fence(__ATOMIC_ACQUIRE, "agent");
            xb_add(&bar[XB_XGEN(b.x)], 1u);
            asm volatile("s_waitcnt vmcnt(0)" ::: "memory");
        } else {
            XB_SPIN(xb_ld(&bar[XB_XGEN(b.x)]) == gen, bar);
            __builtin_amdgcn_fence(__ATOMIC_ACQUIRE, "agent");
            asm volatile("s_waitcnt vmcnt(0)" ::: "memory");
        }
    }
    __syncthreads();
}

struct Args { const float* in[24]; float* out; unsigned char* ws; int ph_lo, ph_hi; };
struct Frame {
    LAS unsigned char* lds;
    volatile LAS unsigned* MISC;
    gu32* ctl;
    int tid, lane, wave;
    int vcu, G;
    float* out; unsigned char* ws;
};
enum { I_X = 0, I_NMIXPRE, I_WIN, I_VNG, I_VNB, I_WSP, I_BSP, I_WPROJ, I_LRE, I_LIM, I_LOGDT, I_BRE, I_BIM, I_CRE, I_CIM, I_DSKIP, I_WGLUA, I_WGLUB, I_WOUT, I_NMIXPOST, I_NMLPPRE, I_WUP, I_WDN, I_NMLPPOST };

__device__ __forceinline__ float wave_sum(float v) {
#pragma unroll
    for (int o = 1; o < 64; o <<= 1) v += __shfl_xor(v, o);
    return v;
}

__device__ __forceinline__ void p0_transpose_item(const float* W, int K, int N, bf16* WT, int out_row0, LAS unsigned char* scr, int k0, int n0, int lane) {
    const int c = lane & 15, kq = lane >> 4;
    const float* src = W + (size_t)(k0 + 4 * kq) * N + n0 + 4 * c;
    f32x4 v[16];
#pragma unroll
    for (int i = 0; i < 16; ++i) v[i] = LD_STREAM((const GAS f32x4*)(src + (size_t)((i & 3) + 16 * (i >> 2)) * N));
#pragma unroll
    for (int mb = 0; mb < 4; ++mb)
#pragma unroll
        for (int j = 0; j < 4; ++j) { v2u o; o.x = pk2(v[4 * mb + 0][j], v[4 * mb + 1][j]); o.y = pk2(v[4 * mb + 2][j], v[4 * mb + 3][j]);
            *(LAS v2u*)(scr + (4 * c + j) * 136 + (16 * mb + 4 * kq) * 2) = o; }
    LDS_WAIT(); asm volatile("" ::: "memory");
#pragma unroll
    for (int r = 0; r < 8; ++r) { const int n = (lane >> 3) + 8 * r; const LAS unsigned char* p = scr + n * 136 + (lane & 7) * 16;
        const v2u x = *(const LAS v2u*)p, y = *(const LAS v2u*)(p + 8); v4u o; o.x = x.x; o.y = x.y; o.z = y.x; o.w = y.y;
        const int orow = out_row0 + n;
        *(GAS v4u*)(WT + ((((size_t)(orow >> 8) * (size_t)(K >> 6) + (size_t)(k0 >> 6)) * 256 + (size_t)(orow & 255)) * 64 + 8 * (lane & 7))) = o; }
    LDS_WAIT(); asm volatile("" ::: "memory");
}
__device__ __forceinline__ size_t tile16_off(int row, int col, int ncols) { return TILED_A ? ((((size_t)(row >> 8) * (size_t)(ncols >> 6) + (size_t)(col >> 6)) * 256 + (size_t)(row & 255)) * 64 + (size_t)(col & 63)) : ((size_t)row * ncols + col); }
__device__ __forceinline__ size_t tile8_off(int row, int kb, int nbytes) { return TILED_A ? ((((size_t)(row >> 8) * (size_t)(nbytes >> 7) + (size_t)(kb >> 7)) * 256 + (size_t)(row & 255)) * 128 + (size_t)(kb & 127)) : ((size_t)row * nbytes + kb); }
#ifndef TILED_MIX
#define TILED_MIX 0
#endif
__device__ __forceinline__ size_t mix_off(int row, int col) { return TILED_MIX ? ((((size_t)(row >> 8) * 64 + (size_t)(col >> 6)) * 256 + (size_t)(row & 255)) * 64 + (size_t)(col & 63)) : ((size_t)row * D + col); }
__device__ __forceinline__ float wave_max(float v) {
#pragma unroll
    for (int o = 1; o < 64; o <<= 1) v = fmaxf(v, __shfl_xor(v, o));
    return v;
}
__device__ __forceinline__ unsigned pk4_i8(float a, float b, float c, float d) {
    const int qa = (int)__builtin_rintf(fminf(fmaxf(a, -127.f), 127.f)), qb = (int)__builtin_rintf(fminf(fmaxf(b, -127.f), 127.f)), qc = (int)__builtin_rintf(fminf(fmaxf(c, -127.f), 127.f)), qd = (int)__builtin_rintf(fminf(fmaxf(d, -127.f), 127.f));
    return ((unsigned)qa & 0xffu) | (((unsigned)qb & 0xffu) << 8) | (((unsigned)qc & 0xffu) << 16) | ((unsigned)qd << 24);
}
__device__ __forceinline__ void rms_row_to_bf16(const float* xrow, const float* g, bf16* orow, unsigned char* o8base, int m, float* rs, int lane) {
    const GAS f32x4* xr = (const GAS f32x4*)xrow + lane; const GAS f32x4* gr = (const GAS f32x4*)g + lane;
    f32x4 v[16]; float s = 0.f;
#pragma unroll
    for (int j = 0; j < 16; ++j) { v[j] = LD_STREAM(xr + 64 * j); s += (v[j].x * v[j].x + v[j].y * v[j].y) + (v[j].z * v[j].z + v[j].w * v[j].w); }
    const float rstd = 1.0f / sqrtf(wave_sum(s) * (1.f / D) + NORM_EPS);
    GAS v2u* o8 = (GAS v2u*)orow + lane; float am = 0.f;
#pragma unroll
    for (int j = 0; j < 16; ++j) { const f32x4 gg = gr[64 * j]; v[j].x *= rstd * gg.x; v[j].y *= rstd * gg.y; v[j].z *= rstd * gg.z; v[j].w *= rstd * gg.w;
        am = fmaxf(fmaxf(am, fmaxf(fabsf(v[j].x), fabsf(v[j].y))), fmaxf(fabsf(v[j].z), fabsf(v[j].w)));
        if (N16 > 0) { v2u o; o.x = pk2(v[j].x, v[j].y); o.y = pk2(v[j].z, v[j].w); o8[64 * j] = o; } }
    am = fmaxf(wave_max(am), 1e-30f); const float qs = 127.0f / am;
    if (lane == 0) rs[0] = am * (1.0f / 127.0f);
    GAS unsigned char* q8 = (GAS unsigned char*)(o8base + tile8_off(m, 4 * lane, D)); const size_t qstep = tile8_off(0, 256, D);
#pragma unroll
    for (int j = 0; j < 16; ++j) { *(GAS unsigned*)q8 = pk4_i8(v[j].x * qs, v[j].y * qs, v[j].z * qs, v[j].w * qs); q8 += qstep; }
}
__device__ __forceinline__ void p0_colmax_item(const float* W, int N, unsigned* cmax, int k0, int n0, int ncol0, int lane) {
    const int c = lane & 15, kq = lane >> 4;
    f32x4 mx = (f32x4){0.f, 0.f, 0.f, 0.f};
    for (int sb = 0; sb < 8; ++sb) { const float* src = W + (size_t)(k0 + 64 * sb + 4 * kq) * N + n0 + 4 * c;
#pragma unroll
        for (int i = 0; i < 16; ++i) { const f32x4 t = *(const GAS f32x4*)(src + (size_t)((i & 3) + 16 * (i >> 2)) * N);
            mx.x = fmaxf(mx.x, fabsf(t.x)); mx.y = fmaxf(mx.y, fabsf(t.y)); mx.z = fmaxf(mx.z, fabsf(t.z)); mx.w = fmaxf(mx.w, fabsf(t.w)); } }
#pragma unroll
    for (int j = 0; j < 4; ++j) { float t = mx[j]; t = fmaxf(t, __shfl_xor(t, 16)); t = fmaxf(t, __shfl_xor(t, 32)); mx[j] = t; }
    if (kq == 0) {
#pragma unroll
        for (int j = 0; j < 4; ++j) atomicMax(cmax + (n0 - ncol0) + 4 * c + j, __float_as_uint(mx[j])); }
}
__device__ __forceinline__ void p0_quant_item(const float* W, int K, int N, unsigned char* Wq, int out_row0, LAS unsigned char* scr, int k0, int n0, const unsigned* cmax, float* cs, int lane) {
    const int c = lane & 15, kq = lane >> 4;
    const float* src = W + (size_t)(k0 + 4 * kq) * N + n0 + 4 * c;
    f32x4 v[16];
#pragma unroll
    for (int i = 0; i < 16; ++i) v[i] = *(const GAS f32x4*)(src + (size_t)((i & 3) + 16 * (i >> 2)) * N);
    float qs[4];
#pragma unroll
    for (int j = 0; j < 4; ++j) { const float am = fmaxf(__uint_as_float(cmax[out_row0 + 4 * c + j]), 1e-30f); qs[j] = 127.0f / am; if (k0 == 0 && kq == 0) cs[out_row0 + 4 * c + j] = am * (1.0f / 127.0f); }
#pragma unroll
    for (int mb = 0; mb < 4; ++mb)
#pragma unroll
        for (int j = 0; j < 4; ++j) *(LAS unsigned*)(scr + (4 * c + j) * 68 + 16 * mb + 4 * kq) = pk4_i8(qs[j] * v[4 * mb + 0][j], qs[j] * v[4 * mb + 1][j], qs[j] * v[4 * mb + 2][j], qs[j] * v[4 * mb + 3][j]);
    LDS_WAIT(); asm volatile("" ::: "memory");
#pragma unroll
    for (int r = 0; r < 4; ++r) { const int n = (lane >> 2) + 16 * r; const LAS unsigned* p = (const LAS unsigned*)(scr + n * 68 + 16 * (lane & 3));
        v4u o; o.x = p[0]; o.y = p[1]; o.z = p[2]; o.w = p[3];
        const int orow = out_row0 + n;
        *(GAS v4u*)(Wq + ((((size_t)(orow >> 8) * (size_t)(K >> 7) + (size_t)(k0 >> 7)) * 256 + (size_t)(orow & 255)) * 128 + (size_t)(k0 & 127) + 16 * (lane & 3))) = o; }
    LDS_WAIT(); asm volatile("" ::: "memory");
}
#ifndef REGQ
#define REGQ (IN_INT8 == 2)
#endif
template <int ROWS>
__device__ __forceinline__ void q_load(Frame& F, const float* W, int N, int n0, int k0, unsigned* cmax, unsigned (&d)[ROWS / 4]) {
    constexpr int RW = ROWS / 8, NB = RW < 16 ? RW : 16;
    int lane = F.lane; asm volatile("" : "+v"(lane));
    const GAS unsigned char* src = (const GAS unsigned char*)(W + (size_t)(k0 + F.wave * RW) * N + n0);
    const unsigned lo = 16u * (unsigned)lane, rstep = 4u * (unsigned)N;
    f32x4 mx = (f32x4){0.f, 0.f, 0.f, 0.f};
#pragma unroll
    for (int ib = 0; ib < RW; ib += NB) {
        f32x4 v[NB];
#pragma unroll
        for (int i = 0; i < NB; ++i) v[i] = LD_STREAM((const GAS f32x4*)(src + (size_t)(ib + i) * rstep + lo));
#pragma unroll
        for (int i = 0; i < NB; ++i) {
            mx.x = fmaxf(mx.x, fabsf(v[i].x)); mx.y = fmaxf(mx.y, fabsf(v[i].y)); mx.z = fmaxf(mx.z, fabsf(v[i].z)); mx.w = fmaxf(mx.w, fabsf(v[i].w));
            d[2 * (ib + i)] = pk2x(v[i].x, v[i].y); d[2 * (ib + i) + 1] = pk2x(v[i].z, v[i].w); }
    }
    LAS float* red = (LAS float*)(F.lds + RING_OFF);
    *(LAS f32x4*)(red + F.wave * 256 + 4 * lane) = mx;
    __syncthreads();
    if (F.tid < 256) { float m = red[F.tid];
#pragma unroll
        for (int w = 1; w < NWAVES; ++w) m = fmaxf(m, red[w * 256 + F.tid]);
        atomicMax(cmax + F.tid, __float_as_uint(m)); }
}
template <int ROWS>
__device__ __forceinline__ void q_store(Frame& F, unsigned char* Wq, int panel, int k0, const unsigned* cmax, float* cs, const unsigned (&d)[ROWS / 4]) {
    constexpr int RW = ROWS / 8;
    int lane = F.lane; asm volatile("" : "+v"(lane));
    const v4u cm = *(const GAS v4u*)(cmax + 4 * lane);
    float qs[4]; f32x4 sc;
#pragma unroll
    for (int j = 0; j < 4; ++j) { const float am = fmaxf(__uint_as_float(cm[j]), 1e-30f); qs[j] = 127.0f / am; sc[j] = am * (1.0f / 127.0f); }
    if (k0 == 0 && F.wave == 0) *(GAS f32x4*)(cs + 4 * lane) = sc;
    const int k = k0 + F.wave * RW;
    GAS unsigned char* o = (GAS unsigned char*)Wq + (((size_t)panel * (D / 128) + (size_t)(k >> 7)) * 256 + (size_t)(4 * lane)) * 128 + (size_t)(k & 127);
#define QV(i, j) (qs[j] * (((j) & 1) ? bfhi(d[2 * (i) + ((j) >> 1)]) : bflo(d[2 * (i) + ((j) >> 1)])))
#pragma unroll
    for (int j = 0; j < 4; ++j) {
        if constexpr (RW >= 16) {
#pragma unroll
            for (int g = 0; g < RW / 16; ++g) { v4u o4;
#pragma unroll
                for (int q = 0; q < 4; ++q) o4[q] = pk4_i8(QV(16 * g + 4 * q, j), QV(16 * g + 4 * q + 1, j), QV(16 * g + 4 * q + 2, j), QV(16 * g + 4 * q + 3, j));
                *(GAS v4u*)(o + j * 128 + 16 * g) = o4; }
        } else { v2u o2; o2.x = pk4_i8(QV(0, j), QV(1, j), QV(2, j), QV(3, j)); o2.y = pk4_i8(QV(4, j), QV(5, j), QV(6, j), QV(7, j)); *(GAS v2u*)(o + j * 128) = o2; }
    }
#undef QV
}
template <int ROWS>
__device__ __forceinline__ void q_rounds(Frame& F, const Args& A, const XcdBarrier& bar, int gp0, int ngp) {
    constexpr int KB = D / ROWS, PIN = INW / 256;
    const int NT = ngp * KB;
    for (int t0 = 0; t0 < NT; t0 += F.G) {
        const int t = t0 + F.vcu; const bool act = t < NT;
        const int gp = gp0 + t / KB, k0 = (t % KB) * ROWS; const bool isin = gp < PIN; const int panel = isin ? gp : gp - PIN;
        unsigned* cmax = (unsigned*)(F.ctl + (isin ? CW_CMAXIN : CW_CMAXUP)) + 256 * panel;
        unsigned d[ROWS / 4];
        if (act) q_load<ROWS>(F, isin ? A.in[I_WIN] : A.in[I_WUP], isin ? INW : DFF, 256 * panel, k0, cmax, d);
        if (N_LAUNCHES == 1) xcd_barrier(bar);
        if (act) q_store<ROWS>(F, isin ? F.ws + WS_W8 : F.ws + WS_WUP, panel, k0, cmax, (float*)(F.ws + (isin ? WS_CSIN : WS_CSUP)) + 256 * panel, d);
    }
}
__device__ __forceinline__ void p0_quant_rounds(Frame& F, const Args& A, const XcdBarrier& bar) {
    static_assert((INW + DFF) / 256 == 116 && (!REGQ || N_LAUNCHES == 1), "panel split below; the tiles cross a grid barrier");
    __syncthreads();
    q_rounds<512>(F, A, bar, 0, 96);
    q_rounds<256>(F, A, bar, 96, 16);
    q_rounds<64>(F, A, bar, 112, 4);
}
__device__ __forceinline__ void s5_pow(double lre, double lim, double dt, int n, double& re, double& im) {
    const double mag = exp((double)n * dt * lre), ang = (double)n * dt * lim; double sn, cs; sincos(ang, &sn, &cs); re = mag * cs; im = mag * sn;
}
__device__ __forceinline__ void s5_coef(double lre, double lim, double dt, double& re, double& im) {
    double are, aim; s5_pow(lre, lim, dt, 1, are, aim); const double nr = are - 1.0, ni = aim, den = lre * lre + lim * lim;
    re = (nr * lre + ni * lim) / den; im = (ni * lre - nr * lim) / den;
}
__device__ __forceinline__ void p0_s5_item(Frame& F, const Args& A, int item) {
    const int lane = F.lane, p = lane;
    bf16* KTAB = (bf16*)(F.ws + WS_KTAB); bf16* BMAT = (bf16*)(F.ws + WS_BMAT); bf16* CMAT = (bf16*)(F.ws + WS_CMAT); float* AT = (float*)(F.ws + WS_AT);
    const int kind = item >> 11, r = item & 2047, g = (kind < 3) ? (r >> 5) : r, n = r & 31;
    const double lre = (double)A.in[I_LRE][g * SP + p], lim = (double)A.in[I_LIM][g * SP + p], dt = exp((double)A.in[I_LOGDT][g]);
    if (kind == 3) { double re, im; s5_pow(lre, lim, dt, TC, re, im); AT[(g * SP + p) * 2] = (float)re; AT[(g * SP + p) * 2 + 1] = (float)im; return; }
    if (kind == 2) {
        double wr, wi; s5_pow(lre, lim, dt, n + 1, wr, wi); const float wrf = (float)wr, wif = (float)wi;
#pragma unroll
        for (int h = 0; h < SGD; ++h) { const float cr = A.in[I_CRE][(g * SGD + h) * SP + p], ci = A.in[I_CIM][(g * SGD + h) * SP + p];
            bf16* row = CMAT + ((size_t)g * 512 + n * 16 + h) * 128;
            row[p] = (bf16)(pk2x(cr * wrf - ci * wif, 0.f) & 0xffffu); row[64 + p] = (bf16)(pk2x(-(cr * wif + ci * wrf), 0.f) & 0xffffu); }
        return;
    }
    double cre, cim; s5_coef(lre, lim, dt, cre, cim);
    if (kind == 1) {
        double ar, ai; s5_pow(lre, lim, dt, TC - 1 - n, ar, ai); const float wr = (float)(ar * cre - ai * cim), wi = (float)(ar * cim + ai * cre);
        float vr[16], vi[16];
#pragma unroll
        for (int h = 0; h < SGD; ++h) { const float br = A.in[I_BRE][(g * SP + p) * SGD + h], bi = A.in[I_BIM][(g * SP + p) * SGD + h]; vr[h] = wr * br - wi * bi; vi[h] = wr * bi + wi * br; }
        v4u o; bf16* rr = BMAT + ((size_t)g * 128 + p) * 512 + n * 16; bf16* ri = BMAT + ((size_t)g * 128 + 64 + p) * 512 + n * 16;
        o.x = pk2x(vr[0], vr[1]); o.y = pk2x(vr[2], vr[3]); o.z = pk2x(vr[4], vr[5]); o.w = pk2x(vr[6], vr[7]); *(v4u*)rr = o;
        o.x = pk2x(vr[8], vr[9]); o.y = pk2x(vr[10], vr[11]); o.z = pk2x(vr[12], vr[13]); o.w = pk2x(vr[14], vr[15]); *(v4u*)(rr + 8) = o;
        o.x = pk2x(vi[0], vi[1]); o.y = pk2x(vi[2], vi[3]); o.z = pk2x(vi[4], vi[5]); o.w = pk2x(vi[6], vi[7]); *(v4u*)ri = o;
        o.x = pk2x(vi[8], vi[9]); o.y = pk2x(vi[10], vi[11]); o.z = pk2x(vi[12], vi[13]); o.w = pk2x(vi[14], vi[15]); *(v4u*)(ri + 8) = o;
        return;
    }
    double ar, ai; s5_pow(lre, lim, dt, n, ar, ai); const float wr = (float)(ar * cre - ai * cim), wi = (float)(ar * cim + ai * cre);
    float vr[16], vi[16];
#pragma unroll
    for (int h = 0; h < SGD; ++h) { const float br = A.in[I_BRE][(g * SP + p) * SGD + h], bi = A.in[I_BIM][(g * SP + p) * SGD + h]; vr[h] = wr * br - wi * bi; vi[h] = wr * bi + wi * br; }
    float crs[16], cis[16];
#pragma unroll
    for (int h = 0; h < SGD; ++h) { crs[h] = A.in[I_CRE][(g * SGD + h) * SP + p]; cis[h] = A.in[I_CIM][(g * SGD + h) * SP + p]; }
    __builtin_amdgcn_sched_barrier(0);
#pragma unroll
    for (int h = 0; h < SGD; ++h) { const float cr = crs[h], ci = cis[h];
        float t8[8], t4[4], t2[2], mine;
#pragma unroll
        for (int i = 0; i < 8; ++i) { const float a = cr * vr[2 * i] - ci * vi[2 * i], b = cr * vr[2 * i + 1] - ci * vi[2 * i + 1]; const bool up = lane & 1; t8[i] = (up ? b : a) + __shfl_xor(up ? a : b, 1); }
#pragma unroll
        for (int i = 0; i < 4; ++i) { const bool up = lane & 2; t4[i] = (up ? t8[2 * i + 1] : t8[2 * i]) + __shfl_xor(up ? t8[2 * i] : t8[2 * i + 1], 2); }
#pragma unroll
        for (int i = 0; i < 2; ++i) { const bool up = lane & 4; t2[i] = (up ? t4[2 * i + 1] : t4[2 * i]) + __shfl_xor(up ? t4[2 * i] : t4[2 * i + 1], 4); }
        { const bool up = lane & 8; mine = (up ? t2[1] : t2[0]) + __shfl_xor(up ? t2[0] : t2[1], 8); }
        mine += __shfl_xor(mine, 16); mine += __shfl_xor(mine, 32);
        if (lane < SGD) { if (n == 0 && lane == h) mine += A.in[I_DSKIP][g * SGD + h]; KTAB[(((size_t)g * TC + n) * SGD + h) * SGD + lane] = (bf16)(pk2x(mine, 0.f) & 0xffffu); } }
}
__device__ __forceinline__ void p0_prologue(Frame& F, const Args& A) {
    LAS unsigned char* scr = F.lds + RING_OFF + F.wave * 16384;
#ifndef P0_S5WAVE
#define P0_S5WAVE 0
#endif
    constexpr int NSW = P0_S5WAVE ? NWAVES - 1 : NWAVES;
    if (P0_S5WAVE && F.wave == NWAVES - 1) { for (int it = F.vcu; it < 3 * 2048 + SG; it += F.G) p0_s5_item(F, A, it); return; }
    const int gw = F.vcu * NSW + F.wave, NGW = F.G * NSW;
    if (!P0_S5WAVE) for (int it = gw; it < 3 * 2048 + SG; it += NGW) p0_s5_item(F, A, it);
    { bf16* Hh = (bf16*)(F.ws + WS_ARB); float* RS1 = (float*)(F.ws + WS_RS1);
      for (int m = gw; m < M; m += NGW) rms_row_to_bf16(A.in[I_X] + (size_t)m * D, A.in[I_NMIXPRE], Hh + (size_t)m * D, F.ws + WS_H8, m, RS1 + m, F.lane); }
    constexpr int I_1 = (D / 64) * (N16 / 64), I_2 = (AW / 64) * (D / 64), I_3 = (BW / 64) * (D / 64), I_4 = I_3, I_5 = (D / 64) * (D / 64), I_7 = (DFF / 64) * (D / 64);
    constexpr int NITEMS = I_1 + I_2 + I_3 + I_4 + I_5 + I_7;
    for (int it = gw; it < NITEMS; it += NGW) {
        int r = it;
        if (r < I_1) { const int nblk = N16 > 0 ? N16 / 64 : 1, kb = r / nblk, nb = r % nblk; p0_transpose_item(A.in[I_WIN], D, INW, (bf16*)(F.ws + WS_WIN), 64 * nb, scr, 64 * kb, win_col16(64 * nb), F.lane); continue; } r -= I_1;
        if (r < I_2) { const int nblk = D / 64, kb = r / nblk, nb = r % nblk; p0_transpose_item(A.in[I_WPROJ], AW, D, (bf16*)(F.ws + WS_WPROJ), 64 * nb, scr, 64 * kb, 64 * nb, F.lane); continue; } r -= I_2;
        if (r < I_3) { const int nblk = D / 64, kb = r / nblk, nb = r % nblk, n0 = 64 * nb; p0_transpose_item(A.in[I_WGLUA], BW, D, (bf16*)(F.ws + WS_WGLU), (n0 >> 7) * 256 + (n0 & 127), scr, 64 * kb, n0, F.lane); continue; } r -= I_3;
        if (r < I_4) { const int nblk = D / 64, kb = r / nblk, nb = r % nblk, n0 = 64 * nb; p0_transpose_item(A.in[I_WGLUB], BW, D, (bf16*)(F.ws + WS_WGLU), (n0 >> 7) * 256 + 128 + (n0 & 127), scr, 64 * kb, n0, F.lane); continue; } r -= I_4;
        if (r < I_5) { const int nblk = D / 64, kb = r / nblk, nb = r % nblk; p0_transpose_item(A.in[I_WOUT], D, D, (bf16*)(F.ws + WS_WOUT), 64 * nb, scr, 64 * kb, 64 * nb, F.lane); continue; } r -= I_5;
        { const int nblk = D / 64, kb = r / nblk, nb = r % nblk; p0_transpose_item(A.in[I_WDN], DFF, D, (bf16*)(F.ws + WS_WDN), 64 * nb, scr, 64 * kb, 64 * nb, F.lane); }
    }
    if (!REGQ) { unsigned* CMI = (unsigned*)(F.ctl + CW_CMAXIN); unsigned* CMU = (unsigned*)(F.ctl + CW_CMAXUP);
      constexpr int C_1 = (NG8 / 64) * (D / 512), C_2 = (DFF / 64) * (D / 512);
      for (int it = gw; it < C_1 + C_2; it += NGW) {
          if (it < C_1) { const int nb = it % (NG8 / 64), kb = it / (NG8 / 64), n0 = win_col8(64 * nb); p0_colmax_item(A.in[I_WIN], INW, CMI, 512 * kb, n0, n0 - 64 * nb, F.lane); }
          else { const int r = it - C_1, nb = r % (DFF / 64), kb = r / (DFF / 64); p0_colmax_item(A.in[I_WUP], DFF, CMU, 512 * kb, 64 * nb, 0, F.lane); } } }
}
__device__ __forceinline__ void p0_quantize(Frame& F, const Args& A) {
    LAS unsigned char* scr = F.lds + RING_OFF + F.wave * 16384;
    const int gw = F.vcu * NWAVES + F.wave, NGW = F.G * NWAVES;
    const unsigned* CMI = (const unsigned*)(F.ctl + CW_CMAXIN); const unsigned* CMU = (const unsigned*)(F.ctl + CW_CMAXUP);
    constexpr int Q_1 = (D / 128) * (NG8 / 64), Q_2 = (D / 128) * (DFF / 64);
    for (int it0 = gw; it0 < Q_1 + Q_2; it0 += NGW) { const int it = Q_1 + Q_2 - 1 - it0;
        if (it < Q_1) { const int nblk = NG8 / 64, kb2 = it / nblk, nb = it % nblk;
            p0_quant_item(A.in[I_WIN], D, INW, F.ws + WS_W8, 64 * nb, scr, 128 * kb2, win_col8(64 * nb), CMI, (float*)(F.ws + WS_CSIN), F.lane);
            p0_quant_item(A.in[I_WIN], D, INW, F.ws + WS_W8, 64 * nb, scr, 128 * kb2 + 64, win_col8(64 * nb), CMI, (float*)(F.ws + WS_CSIN), F.lane); }
        else { const int r = it - Q_1, nblk = DFF / 64, kb2 = r / nblk, nb = r % nblk;
            p0_quant_item(A.in[I_WUP], D, DFF, F.ws + WS_WUP, 64 * nb, scr, 128 * kb2, 64 * nb, CMU, (float*)(F.ws + WS_CSUP), F.lane);
            p0_quant_item(A.in[I_WUP], D, DFF, F.ws + WS_WUP, 64 * nb, scr, 128 * kb2 + 64, 64 * nb, CMU, (float*)(F.ws + WS_CSUP), F.lane); }
    }
}

constexpr int SPG_VNT_STRIDE = 136, SPG_BUF_BYTES = 128 * SPG_VNT_STRIDE * 2;
constexpr int DUMP_OFF = RING_BYTES - 2048;
__device__ __forceinline__ void l2_touch(Frame& F, const void* p) { __builtin_amdgcn_global_load_lds((const unsigned*)p, (LAS unsigned*)(F.lds + DUMP_OFF + F.wave * 256), 4, 0, 0); }
#ifndef SPG_H0
#define SPG_H0 9
#endif
__device__ __forceinline__ void spatial_unit(Frame& F, const Args& A, int unit) {
    const int c = unit >> 1, hh = unit & 1, lane = F.lane, w = F.wave, h0 = hh ? SPG_H0 : 0, nheads = hh ? AH - SPG_H0 : SPG_H0;
    const bf16* UA = (const bf16*)(F.ws + WS_UA); const bf16* VA = (const bf16*)(F.ws + WS_VA); bf16* SA = (bf16*)(F.ws + WS_ARB);
    const float* VST = (const float*)(F.ws + WS_PART);
    const size_t tok0 = (size_t)c * ACH;
    const int fr = lane & 15, fq = lane >> 4, trow = 16 * w + fr;
    const int sfill = 64 * (w & 1) + lane, c8b = 4 * (w >> 1);
    float mean, rstd;
    { const GAS f32x4* p = (const GAS f32x4*)(VST + (tok0 + sfill) * 64); float s1 = 0.f, s2 = 0.f;
#pragma unroll
      for (int j = 0; j < 16; ++j) { const f32x4 t = p[j]; s1 += t.x + t.z; s2 += t.y + t.w; }
      mean = s1 * (1.f / AW); const float var = fmaxf(s2 * (1.f / AW) - mean * mean, 0.f); rstd = 1.0f / sqrtf(var + NORM_EPS); }
    const bf16* vsrc = TILED_A ? VA + ((size_t)c * 16 * 128 + sfill) * 128 + 8 * c8b : VA + (tok0 + sfill) * AW + 8 * c8b; const size_t hstr = TILED_A ? (size_t)128 * 128 : (size_t)AHD;
    LAS float* gl = (LAS float*)(F.lds + 2 * SPG_BUF_BYTES); LAS float* bl = gl + 9 * AHD;
    for (int idx = F.tid; idx < nheads * AHD; idx += NWAVES * 64) { gl[idx] = A.in[I_VNG][h0 * AHD + idx]; bl[idx] = A.in[I_VNB][h0 * AHD + idx]; }
    const int nks = (w + 2) >> 1;
    v4u vreg[4]; f32x4 wv[4][2]; v2u uu[8]; float bsp;
#define SPG_FETCH(hh_) do { const int hq = (hh_); \
        _Pragma("unroll") for (int i = 0; i < 4; ++i) vreg[i] = LD_STREAM((const GAS v4u*)(vsrc + hq * hstr + 8 * i)); \
        const float* Wrow = A.in[I_WSP] + ((size_t)hq * ACH + trow) * ACH + 8 * fq; \
        _Pragma("unroll") for (int ks = 0; ks < 4; ++ks) if (ks < nks) { wv[ks][0] = *(const GAS f32x4*)(Wrow + 32 * ks); wv[ks][1] = *(const GAS f32x4*)(Wrow + 32 * ks + 4); } \
        const bf16* urow = TILED_A ? UA + (((size_t)c * 16 + hq) * 128 + trow) * 128 + 4 * fq : UA + (tok0 + trow) * AW + hq * AHD + 4 * fq; \
        _Pragma("unroll") for (int n = 0; n < 8; ++n) uu[n] = LD_STREAM((const GAS v2u*)(urow + 16 * n)); \
        bsp = A.in[I_BSP][hq * ACH + trow]; } while (0)
    SPG_FETCH(h0);
    __syncthreads();
#pragma unroll 1
    for (int hi = 0; hi < nheads; ++hi) { const int h = h0 + hi;
        LAS bf16* vnT = (LAS bf16*)(F.lds + (hi & 1) * SPG_BUF_BYTES);
#pragma unroll
        for (int i = 0; i < 4; ++i) { const int c8 = c8b + i; const v4u x = vreg[i];
            const float e[8] = {bflo(x.x), bfhi(x.x), bflo(x.y), bfhi(x.y), bflo(x.z), bfhi(x.z), bflo(x.w), bfhi(x.w)};
            const f32x4 g0 = *(const LAS f32x4*)(gl + hi * AHD + 8 * c8), g1 = *(const LAS f32x4*)(gl + hi * AHD + 8 * c8 + 4), b0 = *(const LAS f32x4*)(bl + hi * AHD + 8 * c8), b1 = *(const LAS f32x4*)(bl + hi * AHD + 8 * c8 + 4);
            const float gg[8] = {g0.x, g0.y, g0.z, g0.w, g1.x, g1.y, g1.z, g1.w}, bb[8] = {b0.x, b0.y, b0.z, b0.w, b1.x, b1.y, b1.z, b1.w};
#pragma unroll
            for (int j = 0; j < 8; ++j) { const float y = (e[j] - mean) * rstd * gg[j] + bb[j]; vnT[(8 * c8 + j) * SPG_VNT_STRIDE + sfill] = (bf16)(pk2x(y, 0.f) & 0xffffu); } }
        v4u wb[4];
#pragma unroll
        for (int ks = 0; ks < 4; ++ks) if (ks < nks) { const int s0 = 32 * ks + 8 * fq;
            float wvv[8] = {wv[ks][0].x, wv[ks][0].y, wv[ks][0].z, wv[ks][0].w, wv[ks][1].x, wv[ks][1].y, wv[ks][1].z, wv[ks][1].w};
#pragma unroll
            for (int j = 0; j < 8; ++j) wvv[j] = (s0 + j <= trow) ? wvv[j] : 0.f;
            wb[ks].x = pk2x(wvv[0], wvv[1]); wb[ks].y = pk2x(wvv[2], wvv[3]); wb[ks].z = pk2x(wvv[4], wvv[5]); wb[ks].w = pk2x(wvv[6], wvv[7]); }
        v2u uc[8];
#pragma unroll
        for (int n = 0; n < 8; ++n) uc[n] = uu[n];
        const float bc = bsp; const int srow_t = (int)(tok0 + trow), scol = h * AHD + 4 * fq;
        __builtin_amdgcn_sched_barrier(0);
        if (hi + 1 < nheads) SPG_FETCH(h + 1);
        __syncthreads();
        f32x4 acc[8];
#pragma unroll
        for (int n = 0; n < 8; ++n) acc[n] = (f32x4){0.f, 0.f, 0.f, 0.f};
#pragma unroll
        for (int ks = 0; ks < 4; ++ks) if (ks < nks) { const int s0 = 32 * ks + 8 * fq; const bf16x8 bfrag = __builtin_bit_cast(bf16x8, wb[ks]);
#pragma unroll
            for (int n = 0; n < 8; ++n) { const bf16x8 afrag = *(const LAS bf16x8*)(vnT + (16 * n + fr) * SPG_VNT_STRIDE + s0);
                acc[n] = __builtin_amdgcn_mfma_f32_16x16x32_bf16(afrag, bfrag, acc[n], 0, 0, 0); } }
#pragma unroll
        for (int n = 0; n < 8; ++n) { const v2u u2 = uc[n]; v2u o;
            o.x = pk2x(bflo(u2.x) * (acc[n][0] + bc), bfhi(u2.x) * (acc[n][1] + bc)); o.y = pk2x(bflo(u2.y) * (acc[n][2] + bc), bfhi(u2.y) * (acc[n][3] + bc)); *(GAS v2u*)(SA + tile16_off(srow_t, scol + 16 * n, AW)) = o; }
    }
#undef SPG_FETCH
    __syncthreads();
}

constexpr int S5_KT_OFF = 0;
constexpr int S5_E_OFF = 17408;
constexpr int S5_S_OFF = S5_E_OFF + 128 * 65 * 4;
constexpr int S5_S_STRIDE = 136;
static_assert(S5_S_OFF + 128 * S5_S_STRIDE * 2 <= RING_BYTES - 2048, "S5 LDS");
#ifndef S5_PF
#define S5_PF 1
#endif
#ifndef S5_SB3
#define S5_SB3 0
#endif
__device__ __forceinline__ void s5_unit(Frame& F, int unit, int part = 3) {
    const int q = unit & 1, g = (unit >> 1) & 63, b = unit >> 7, tid = F.tid, lane = F.lane, w = F.wave, fr = lane & 15, fq = lane >> 4;
    const bf16* KTAB = (const bf16*)(F.ws + WS_KTAB) + (size_t)g * TC * 256; const bf16* BMAT = (const bf16*)(F.ws + WS_BMAT) + (size_t)g * 128 * 512;
    const bf16* CMAT = (const bf16*)(F.ws + WS_CMAT) + (size_t)g * 512 * 128; const float* AT = (const float*)(F.ws + WS_AT) + g * SP * 2;
    const bf16* XB = (const bf16*)(F.ws + WS_XB2) + ((size_t)g * NCH + (size_t)b * NCHB) * 512;
    bf16* ZB = (bf16*)(F.ws + WS_ZB);
    LAS unsigned char* kt = F.lds + S5_KT_OFF; LAS float* Eb = (LAS float*)(F.lds + S5_E_OFF); LAS bf16* Sb = (LAS bf16*)(F.lds + S5_S_OFF);
    if (S5_PF && (part & 1)) { l2_touch(F, (const unsigned char*)XB + (size_t)tid * 128); l2_touch(F, (const unsigned char*)XB + 65536 + (size_t)tid * 128); }
    if (tid < 32) *(LAS v4u*)(kt + tid * 16) = (v4u){0u, 0u, 0u, 0u};
#pragma unroll
    for (int i = 0; i < 2; ++i) { const int pc = tid + 512 * i; *(LAS v4u*)(kt + 512 + pc * 16) = *(const GAS v4u*)(KTAB + pc * 8); }
    if (part & 1) {
        bf16x8 af[16];
#pragma unroll
        for (int kk = 0; kk < 16; ++kk) af[kk] = *(const GAS bf16x8*)(BMAT + (size_t)(16 * w + fr) * 512 + 32 * kk + 8 * fq);
        float sre = 0.f, sim = 0.f; const float are = AT[2 * lane], aim = AT[2 * lane + 1];
        const int nblk = 2 * (q + 1);
        for (int blk = 0; blk < nblk; ++blk) {
#pragma unroll 1
            for (int nt = 0; nt < 4; ++nt) { const bf16* xr = XB + (size_t)(64 * blk + 16 * nt + fr) * 512 + 8 * fq; f32x4 acc = (f32x4){0.f, 0.f, 0.f, 0.f};
                { bf16x8 bfr[16];
#pragma unroll
                    for (int kk = 0; kk < 16; ++kk) bfr[kk] = *(const GAS bf16x8*)(xr + 32 * kk);
                    __builtin_amdgcn_sched_barrier(0);
#pragma unroll
                    for (int kk = 0; kk < 16; ++kk) acc = __builtin_amdgcn_mfma_f32_16x16x32_bf16(af[kk], bfr[kk], acc, 0, 0, 0); }
#pragma unroll
                for (int r = 0; r < 4; ++r) Eb[(16 * w + 4 * fq + r) * 65 + 16 * nt + fr] = acc[r]; }
            if (S5_PF && blk + 2 < nblk) l2_touch(F, (const unsigned char*)XB + (size_t)(blk + 2) * 65536 + (size_t)tid * 128);
            __syncthreads();
            if (w == 0) {
                const bool wr_s = 64 * blk >= 128 * q;
#pragma unroll 1
                for (int j0 = 0; j0 < 64; j0 += 16) { float er[16], ei[16];
#pragma unroll
                    for (int i = 0; i < 16; ++i) { er[i] = Eb[lane * 65 + j0 + i]; ei[i] = Eb[(64 + lane) * 65 + j0 + i]; }
                    LAS bf16* sp = Sb + (64 * blk + j0 - 128 * q) * S5_S_STRIDE + lane;
#pragma unroll
                    for (int i = 0; i < 16; ++i) {
                        if (wr_s) { sp[i * S5_S_STRIDE] = (bf16)(pk2x(sre, 0.f) & 0xffffu); sp[i * S5_S_STRIDE + 64] = (bf16)(pk2x(sim, 0.f) & 0xffffu); }
                        const float nr = are * sre - aim * sim + er[i], ni = are * sim + aim * sre + ei[i]; sre = nr; sim = ni; } }
            }
            __syncthreads();
        }
    }
#ifndef S5_V3
#define S5_V3 1
#endif
#if S5_V3
    if (part & 2) {
        const bf16* xr = XB + (size_t)(128 * q + 16 * w + fr) * 512 + 8 * fq;
        bf16x8 bf[16], sf[4], cfa[4], cfb[4];
#pragma unroll
        for (int kk = 0; kk < 16; ++kk) bf[kk] = *(const GAS bf16x8*)(xr + 32 * kk);
        const bf16* cmp = CMAT + (size_t)fr * 128 + 8 * fq;
#pragma unroll
        for (int kk = 0; kk < 4; ++kk) cfa[kk] = *(const GAS bf16x8*)(cmp + 32 * kk);
#pragma unroll
        for (int kk = 0; kk < 4; ++kk) sf[kk] = *(const LAS bf16x8*)(Sb + (16 * w + fr) * S5_S_STRIDE + 32 * kk + 8 * fq);
        const int ktl = 512 - (lane >> 5) * 512 + fr * 32 + (fq & 1) * 16;
        const size_t tok0 = (size_t)b * SEQ + (size_t)(128 * q + 16 * w + fr) * TC;
#pragma unroll
        for (int mt = 0; mt < 32; ++mt) {
            if (mt + 1 < 32) {
#pragma unroll
                for (int kk = 0; kk < 4; ++kk) cfb[kk] = *(const GAS bf16x8*)(cmp + (size_t)(16 * (mt + 1)) * 128 + 32 * kk); }
            f32x4 acc = (f32x4){0.f, 0.f, 0.f, 0.f};
#pragma unroll
            for (int kk = 0; kk <= mt / 2; ++kk) { const bf16x8 afrag = *(const LAS bf16x8*)(kt + ktl + (mt - 2 * kk) * 512); acc = __builtin_amdgcn_mfma_f32_16x16x32_bf16(afrag, bf[kk], acc, 0, 0, 0); }
#pragma unroll
            for (int kk = 0; kk < 4; ++kk) acc = __builtin_amdgcn_mfma_f32_16x16x32_bf16(cfa[kk], sf[kk], acc, 0, 0, 0);
            v2u o; o.x = pk2x(gelu_t(acc[0]), gelu_t(acc[1])); o.y = pk2x(gelu_t(acc[2]), gelu_t(acc[3]));
            *(GAS v2u*)(ZB + tile16_off((int)(tok0 + mt), g * SGD + 4 * fq, BW)) = o;
#pragma unroll
            for (int kk = 0; kk < 4; ++kk) cfa[kk] = cfb[kk];
        }
    }
#else
    const int mts[4] = {w, 15 - w, 16 + w, 31 - w};
    bf16x8 cf[4][4];
#pragma unroll
    for (int i = 0; i < 4; ++i)
#pragma unroll
        for (int kk = 0; kk < 4; ++kk) cf[i][kk] = *(const GAS bf16x8*)(CMAT + (size_t)(16 * mts[i] + fr) * 128 + 32 * kk + 8 * fq);
    const int ktl = 512 - (lane >> 5) * 512 + fr * 32 + (fq & 1) * 16;
#pragma unroll 1
    for (int nt = 0; nt < ((part & 2) ? 8 : 0); ++nt) {
        const bf16* xr = XB + (size_t)(128 * q + 16 * nt + fr) * 512 + 8 * fq;
        f32x4 acc[4];
#pragma unroll
        for (int i = 0; i < 4; ++i) acc[i] = (f32x4){0.f, 0.f, 0.f, 0.f};
        { bf16x8 bf[16];
#pragma unroll
            for (int kk = 0; kk < 16; ++kk) bf[kk] = *(const GAS bf16x8*)(xr + 32 * kk);
#if S5_SB3
            __builtin_amdgcn_sched_barrier(0);
#endif
#pragma unroll
            for (int kk = 0; kk < 16; ++kk) {
#pragma unroll
                for (int i = 0; i < 4; ++i) { const int d0 = mts[i] - 2 * kk;
                    if (d0 >= 0) { const bf16x8 afrag = *(const LAS bf16x8*)(kt + ktl + d0 * 512); acc[i] = __builtin_amdgcn_mfma_f32_16x16x32_bf16(afrag, bf[kk], acc[i], 0, 0, 0); } }
                asm volatile("" ::: "memory"); } }
#pragma unroll
        for (int kk = 0; kk < 4; ++kk) { const bf16x8 sfrag = *(const LAS bf16x8*)(Sb + (16 * nt + fr) * S5_S_STRIDE + 32 * kk + 8 * fq);
#pragma unroll
            for (int i = 0; i < 4; ++i) acc[i] = __builtin_amdgcn_mfma_f32_16x16x32_bf16(cf[i][kk], sfrag, acc[i], 0, 0, 0); }
#pragma unroll
        for (int i = 0; i < 4; ++i) { const size_t tok = (size_t)b * SEQ + (size_t)(128 * q + 16 * nt + fr) * TC + mts[i];
            v2u o; o.x = pk2x(gelu_t(acc[i][0]), gelu_t(acc[i][1])); o.y = pk2x(gelu_t(acc[i][2]), gelu_t(acc[i][3]));
            *(GAS v2u*)(ZB + tile16_off((int)tok, g * SGD + 4 * fq, BW)) = o; }
    }
#endif
    __syncthreads();
}

#ifndef X1_BF16
#define X1_BF16 1
#endif
__device__ __forceinline__ void n1_load(Frame& F, const Args& A, int m, f32x4 (&xv)[16], float& pv) {
    const int lane = F.lane; const GAS f32x4* xr = (const GAS f32x4*)(A.in[I_X] + (size_t)m * D) + lane;
    pv = ((const float*)(F.ws + WS_PART) + (size_t)m * 64)[lane];
#pragma unroll
    for (int j = 0; j < 16; ++j) xv[j] = LD_STREAM(xr + 64 * j);
}
__device__ __forceinline__ void n1_mix(Frame& F, int m, v2u (&mv)[16]) {
    const int lane = F.lane;
    const GAS bf16* mixp = (const GAS bf16*)((const bf16*)(F.ws + WS_ARB) + mix_off(m, 4 * lane)); const size_t mstep = mix_off(0, 256);
#pragma unroll
    for (int j = 0; j < 16; ++j) { mv[j] = LD_STREAM((const GAS v2u*)mixp); mixp += mstep; }
}
__device__ __forceinline__ void n1_proc(Frame& F, const Args& A, int m, f32x4 (&v)[16], v2u (&mv)[16], float pv) {
    const int lane = F.lane; const float rstd1 = 1.0f / sqrtf(wave_sum(pv) * (1.f / D) + NORM_EPS);
    const LAS f32x4* g1 = (const LAS f32x4*)(F.lds + RING_OFF) + lane; const LAS f32x4* g2 = (const LAS f32x4*)(F.lds + RING_OFF + D * 4) + lane;
    GAS f32x4* orow = (GAS f32x4*)(F.out + (size_t)m * D) + lane; GAS v2u* x1row = (GAS v2u*)(F.out + (size_t)m * D + D / 2) + lane;
    float s = 0.f;
#pragma unroll
    for (int j = 0; j < 16; ++j) { const f32x4 gg = g1[64 * j]; const v2u mm = mv[j];
        v[j].x += bflo(mm.x) * rstd1 * gg.x; v[j].y += bfhi(mm.x) * rstd1 * gg.y; v[j].z += bflo(mm.y) * rstd1 * gg.z; v[j].w += bfhi(mm.y) * rstd1 * gg.w;
        s += (v[j].x * v[j].x + v[j].y * v[j].y) + (v[j].z * v[j].z + v[j].w * v[j].w);
        if (X1_BF16) { v2u o; o.x = pk2x(v[j].x, v[j].y); o.y = pk2x(v[j].z, v[j].w); ST_STREAM(x1row + 64 * j, o); } else orow[64 * j] = v[j];
        asm volatile("" ::: "memory"); }
    const float rstd2 = 1.0f / sqrtf(wave_sum(s) * (1.f / D) + NORM_EPS);
    float am = 0.f;
#pragma unroll
    for (int j = 0; j < 16; ++j) { const f32x4 gg = g2[64 * j]; v[j].x *= rstd2 * gg.x; v[j].y *= rstd2 * gg.y; v[j].z *= rstd2 * gg.z; v[j].w *= rstd2 * gg.w;
        am = fmaxf(fmaxf(am, fmaxf(fabsf(v[j].x), fabsf(v[j].y))), fmaxf(fabsf(v[j].z), fabsf(v[j].w))); asm volatile("" ::: "memory"); }
    am = fmaxf(wave_max(am), 1e-30f); const float qs = 127.0f / am;
    if (lane == 0) ((float*)(F.ws + WS_RS2))[m] = am * (1.0f / 127.0f);
    GAS unsigned char* q8 = (GAS unsigned char*)(F.ws + WS_H2Q + tile8_off(m, 4 * lane, D)); const size_t qstep = tile8_off(0, 256, D);
#pragma unroll
    for (int j = 0; j < 16; ++j) { *(GAS unsigned*)q8 = pk4_i8(v[j].x * qs, v[j].y * qs, v[j].z * qs, v[j].w * qs); q8 += qstep; }
}
__device__ __forceinline__ void n1_phase(Frame& F, const Args& A) {
    const int gw = F.vcu * NWAVES + F.wave, NGW = F.G * NWAVES;
    for (int i = F.tid; i < D / 4; i += NWAVES * 64) { ((LAS f32x4*)(F.lds + RING_OFF))[i] = ((const GAS f32x4*)A.in[I_NMIXPOST])[i]; ((LAS f32x4*)(F.lds + RING_OFF + D * 4))[i] = ((const GAS f32x4*)A.in[I_NMLPPRE])[i]; }
    __syncthreads();
    f32x4 xa[16], xb[16]; v2u mv[16]; float pa = 0.f, pb = 0.f;
    if (gw < M) n1_load(F, A, gw, xa, pa);
    for (int m = gw; m < M; m += 2 * NGW) {
        const int m1 = m + NGW < M ? m + NGW : m, m2 = m + 2 * NGW < M ? m + 2 * NGW : m1;
        n1_mix(F, m, mv);
        n1_load(F, A, m1, xb, pb);
        n1_proc(F, A, m, xa, mv, pa);
        if (m + NGW < M) {
            n1_mix(F, m1, mv);
            n1_load(F, A, m2, xa, pa);
            n1_proc(F, A, m1, xb, mv, pb); }
    }
}
#if X1_BF16
typedef v2u x1v_t;
#else
typedef f32x4 x1v_t;
#endif
#ifndef ROWS_BATCH
#define ROWS_BATCH 1
#endif
__device__ __forceinline__ void n2_load(Frame& F, int m, x1v_t (&xv)[16], v2u (&fv)[16], float& pv) {
    const int lane = F.lane; const GAS x1v_t* xr = (const GAS x1v_t*)(F.out + (size_t)m * D + (X1_BF16 ? D / 2 : 0)) + lane;
    pv = ((const float*)(F.ws + WS_PART) + (size_t)m * 64)[lane];
#pragma unroll
    for (int j = 0; j < 16; ++j) xv[j] = LD_STREAM(xr + 64 * j);
    const GAS bf16* ffp = (const GAS bf16*)((const bf16*)(F.ws + WS_ARB) + mix_off(m, 4 * lane)); const size_t fstep = mix_off(0, 256);
#pragma unroll
    for (int j = 0; j < 16; ++j) { fv[j] = LD_STREAM((const GAS v2u*)ffp); ffp += fstep; }
}
__device__ __forceinline__ void n2_proc(Frame& F, const Args& A, int m, x1v_t (&v)[16], v2u (&fv)[16], float pv) {
    const int lane = F.lane; const float rstd = 1.0f / sqrtf(wave_sum(pv) * (1.f / D) + NORM_EPS);
    const LAS f32x4* g1 = (const LAS f32x4*)(F.lds + RING_OFF) + lane; GAS f32x4* orow = (GAS f32x4*)(F.out + (size_t)m * D) + lane;
#pragma unroll
    for (int j = 0; j < 16; ++j) { const f32x4 gg = g1[64 * j]; const v2u mm = fv[j]; f32x4 x;
#if X1_BF16
        x.x = bflo(v[j].x); x.y = bfhi(v[j].x); x.z = bflo(v[j].y); x.w = bfhi(v[j].y);
#else
        x = v[j];
#endif
        x.x += bflo(mm.x) * rstd * gg.x; x.y += bfhi(mm.x) * rstd * gg.y; x.z += bflo(mm.y) * rstd * gg.z; x.w += bfhi(mm.y) * rstd * gg.w; ST_STREAM(orow + 64 * j, x); }
}
__device__ __forceinline__ void n2_phase(Frame& F, const Args& A) {
    const int gw = F.vcu * NWAVES + F.wave, NGW = F.G * NWAVES;
    for (int i = F.tid; i < D / 4; i += NWAVES * 64) ((LAS f32x4*)(F.lds + RING_OFF))[i] = ((const GAS f32x4*)A.in[I_NMLPPOST])[i];
    __syncthreads();
    x1v_t xa[16], xb[16]; v2u fa[16], fb[16]; float pa = 0.f, pb = 0.f;
    if (gw < M) n2_load(F, gw, xa, fa, pa);
    for (int m = gw; m < M; m += 2 * NGW) {
        const int m1 = m + NGW < M ? m + NGW : m, m2 = m + 2 * NGW < M ? m + 2 * NGW : m1;
        n2_load(F, m1, xb, fb, pb);
        n2_proc(F, A, m, xa, fa, pa);
        if (m + NGW < M) {
            n2_load(F, m2, xa, fa, pa);
            n2_proc(F, A, m1, xb, fb, pb); }
    }
}

__global__ void __launch_bounds__(NWAVES * 64, 2) mk_fwd(Args args) {
    extern __shared__ __attribute__((aligned(16))) unsigned char lds[];
    Frame F;
    F.lds = (LAS unsigned char*)lds;
    F.MISC = (volatile LAS unsigned*)(F.lds + MISC_OFF);
    F.tid = threadIdx.x; F.lane = F.tid & 63; F.wave = __builtin_amdgcn_readfirstlane(F.tid >> 6);
    F.G = gridDim.x; { const int bx = blockIdx.x; F.vcu = (F.G % 8 == 0) ? (bx % 8) * (F.G / 8) + bx / 8 : bx; }
    F.ws = args.ws; F.out = args.out;
    F.ctl = (gu32*)(F.ws + WS_CTL);
    for (int u = F.tid; u < (LDS_BYTES - LDSCTL_OFF) / 4; u += NWAVES * 64) ((LAS unsigned*)(F.lds + LDSCTL_OFF))[u] = 0u;
    __syncthreads();
    XcdBarrier bar; bar.bar = (unsigned*)(F.ctl + CW_BAR); bar.x = 0; bar.st = nullptr;
    if (N_LAUNCHES == 1) bar = xcd_barrier_post((unsigned*)(F.ctl + CW_BAR), F.MISC + 8);
#define GRID_BAR() do { if (N_LAUNCHES == 1) xcd_barrier(bar); } while (0)
    const int lo = args.ph_lo, hi = args.ph_hi;
#ifndef PH_MASK
#define PH_MASK 0x3ff
#endif
#define IN(k) (((PH_MASK >> (k)) & 1) && lo <= (k) && (k) < hi)
#define BOTH(k) (IN(k) && IN((k) + 1))
#ifndef DUP_MASK
#define DUP_MASK 0
#endif
#define NREP(k) (((DUP_MASK >> (k)) & 1) ? 2 : 1)
    unsigned char* ws = F.ws;
    bf16* ARB = (bf16*)(ws + WS_ARB);

    if (IN(0)) {
_Pragma("unroll")
        for (int rep = 0; rep < NREP(0); ++rep) { p0_prologue(F, args); if (REGQ) p0_quant_rounds(F, args, bar); else { GRID_BAR(); p0_quantize(F, args); } if (BOTH(0) || rep + 1 < NREP(0)) GRID_BAR(); }
    }

    if (IN(1)) {
_Pragma("unroll")
      for (int rep = 0; rep < NREP(1); ++rep) {
        if (N16 > 0) { pg8::Gemm g{ARB, (const bf16*)(ws + WS_WIN), M, N16, D}; pg8::StaticOrder S; S.init(M, N16, F.G, (int)blockIdx.x);
          pg8::EpiIn E{(bf16*)(ws + WS_UA), (bf16*)(ws + WS_VA), (bf16*)(ws + WS_XB2), (bf16*)(ws + WS_GA), (bf16*)(ws + WS_GB), (float*)(ws + WS_PART), 8, 0, 8, nullptr, nullptr, TILED_A};
          pg8::gemm_phase<pg8::EpiIn, pg8::StaticOrder, PG8_ALIGN, PG8_SP2, false, 0, false, true>(F.lds + RING_OFF, g, S, E); }
        { pg8::Gemm g{(const bf16*)(ws + WS_H8), (const bf16*)(ws + WS_W8), M, NG8, D / 2}; pg8::StaticOrder S; S.init(M, NG8, F.G, (int)blockIdx.x);
          pg8::EpiIn E{(bf16*)(ws + WS_UA), (bf16*)(ws + WS_VA), (bf16*)(ws + WS_XB2), (bf16*)(ws + WS_GA), (bf16*)(ws + WS_GB), (float*)(ws + WS_PART), IN_INT8 == 2 ? 0 : 8, IN_INT8 == 2 ? 0 : 8, IN_INT8 == 2 ? 0 : IN_INT8 == 1 ? 8 : 12, (const float*)(ws + WS_RS1), (const float*)(ws + WS_CSIN), TILED_A};
          pg8::gemm_phase<pg8::EpiIn, pg8::StaticOrder, I8_ALIGN, I8_SP2, true, 0, TILED_A, true>(F.lds + RING_OFF, g, S, E); }
        if (BOTH(1) || rep + 1 < NREP(1)) GRID_BAR();
      }
    }

    if (IN(2)) {
_Pragma("unroll")
      for (int rep = 0; rep < NREP(2); ++rep) {
#ifndef SPG_REP
#define SPG_REP 1
#endif
#ifndef S5_REP
#define S5_REP 1
#endif
#ifndef S5_PART
#define S5_PART 3
#endif
_Pragma("unroll 1")
        for (int u = F.vcu; u < 256 * SPG_REP; u += F.G) { spatial_unit(F, args, u & 255); if (SPG_REP > 1) __syncthreads(); }
        __syncthreads();
_Pragma("unroll 1")
        for (int u = F.vcu; u < 256 * S5_REP; u += F.G) { s5_unit(F, u & 255, u < 256 ? 3 : S5_PART); if (S5_REP > 1) __syncthreads(); }
        if (BOTH(2) || rep + 1 < NREP(2)) GRID_BAR();
      }
    }

    if (IN(3)) {
_Pragma("unroll")
      for (int rep = 0; rep < NREP(3); ++rep) {
        pg8::Gemm g{(const bf16*)(ws + WS_ZB), (const bf16*)(ws + WS_WGLU), M, 2 * D, BW}; pg8::StaticOrder S; S.init(M, 2 * D, F.G, (int)blockIdx.x, P345_WGM);
        pg8::EpiGlu E{(bf16*)(ws + WS_GB), TILED_A};
        pg8::gemm_phase<pg8::EpiGlu, pg8::StaticOrder, PG8_ALIGN, PG8_SP2, false, 0, TILED_A, true>(F.lds + RING_OFF, g, S, E);
        if (BOTH(3) || rep + 1 < NREP(3)) GRID_BAR();
      }
    }

    if (IN(4)) {
_Pragma("unroll")
      for (int rep = 0; rep < NREP(4); ++rep) {
        pg8::Gemm g{ARB, (const bf16*)(ws + WS_WPROJ), M, D, AW}; pg8::StaticOrder S; S.init(M, D, F.G, (int)blockIdx.x, P345_WGM);
        pg8::EpiProj E{(bf16*)(ws + WS_GA), (const bf16*)(ws + WS_GB), TILED_A};
        pg8::gemm_phase<pg8::EpiProj, pg8::StaticOrder, PG8_ALIGN, PG8_SP2, false, 0, TILED_A, true>(F.lds + RING_OFF, g, S, E);
        if (BOTH(4) || rep + 1 < NREP(4)) GRID_BAR();
      }
    }

    if (IN(5)) {
_Pragma("unroll")
      for (int rep = 0; rep < NREP(5); ++rep) {
        pg8::Gemm g{(const bf16*)(ws + WS_GA), (const bf16*)(ws + WS_WOUT), M, D, D}; pg8::StaticOrder S; S.init(M, D, F.G, (int)blockIdx.x, P345_WGM);
        pg8::EpiStat E{ARB, (float*)(ws + WS_PART), TILED_MIX};
        pg8::gemm_phase<pg8::EpiStat, pg8::StaticOrder, PG8_ALIGN, PG8_SP2, false, 0, TILED_A, true>(F.lds + RING_OFF, g, S, E);
        if (BOTH(5) || rep + 1 < NREP(5)) GRID_BAR();
      }
    }

    if (IN(6)) {
_Pragma("unroll")
      for (int rep = 0; rep < NREP(6); ++rep) {
        n1_phase(F, args);
        if (BOTH(6) || rep + 1 < NREP(6)) GRID_BAR();
      }
    }

    if (IN(7)) {
_Pragma("unroll")
      for (int rep = 0; rep < NREP(7); ++rep) {
        pg8::Gemm g{(const bf16*)(ws + WS_H2Q), (const bf16*)(ws + WS_WUP), M, DFF, D / 2}; pg8::StaticOrder S; S.init(M, DFF, F.G, (int)blockIdx.x, P7_WGM);
        pg8::EpiUp E{(bf16*)(ws + WS_ARA), (const float*)(ws + WS_RS2), (const float*)(ws + WS_CSUP), TILED_HID};
        pg8::gemm_phase<pg8::EpiUp, pg8::StaticOrder, I8_ALIGN, I8_SP2, true, 0, TILED_A, true>(F.lds + RING_OFF, g, S, E);
        if (BOTH(7) || rep + 1 < NREP(7)) GRID_BAR();
      }
    }

    if (IN(8)) {
_Pragma("unroll")
      for (int rep = 0; rep < NREP(8); ++rep) {
        pg8::Gemm g{(const bf16*)(ws + WS_ARA), (const bf16*)(ws + WS_WDN), M, D, DFF}; pg8::StaticOrder S; S.init(M, D, F.G, (int)blockIdx.x, P8_WGM);
        pg8::EpiStat E{ARB, (float*)(ws + WS_PART), TILED_MIX};
        pg8::gemm_phase<pg8::EpiStat, pg8::StaticOrder, PG8_ALIGN, PG8_SP2, false, P8_AUXA, TILED_HID != 0, true>(F.lds + RING_OFF, g, S, E);
        if (BOTH(8) || rep + 1 < NREP(8)) GRID_BAR();
      }
    }

    if (IN(9)) {
_Pragma("unroll")
      for (int rep = 0; rep < NREP(9); ++rep) {
        n2_phase(F, args);
        if (rep + 1 < NREP(9)) GRID_BAR();
      }
    }
#undef IN
#undef BOTH
}

extern "C" void kernel_launch(void* const* d_in, const int* in_sizes, int n_in, void* d_out, int out_size, void* d_ws, size_t ws_size, hipStream_t stream) {
    static int grid = 0;
    if (grid == 0) {
        if (n_in != 24 || in_sizes[0] != M * D || out_size != M * D || ws_size < WS_END) { fprintf(stderr, "kernel_launch: unexpected shapes / workspace (n_in %d, ws %zu < %zu)\n", n_in, ws_size, (size_t)WS_END); grid = -1; return; }
        int dev = 0, cus = 0, per_cu = 0;
        if (hipGetDevice(&dev) != hipSuccess || hipDeviceGetAttribute(&cus, hipDeviceAttributeMultiprocessorCount, dev) != hipSuccess) { grid = -1; return; }
        if (hipFuncSetAttribute((const void*)mk_fwd, hipFuncAttributeMaxDynamicSharedMemorySize, LDS_BYTES) != hipSuccess) { grid = -1; return; }
        if (hipOccupancyMaxActiveBlocksPerMultiprocessor(&per_cu, (const void*)mk_fwd, NWAVES * 64, LDS_BYTES) != hipSuccess || per_cu < 1) { fprintf(stderr, "kernel_launch: occupancy query says %d\n", per_cu); }
        (void)hipGetLastError();
        grid = cus;
    }
    if (grid < 0) return;
    if (hipMemsetAsync((char*)d_ws + WS_CTL, 0, CTL_ZERO_BYTES, stream) != hipSuccess) return;
    Args a{};
    for (int i = 0; i < 24; ++i) a.in[i] = (const float*)d_in[i];
    a.out = (float*)d_out; a.ws = (unsigned char*)d_ws;
    if (N_LAUNCHES == 1) { a.ph_lo = 0; a.ph_hi = N_PHASES; hipLaunchKernelGGL(mk_fwd, dim3(grid), dim3(NWAVES * 64), LDS_BYTES, stream, a); }
    else for (int li = 0; li < N_PHASES; ++li) { a.ph_lo = li; a.ph_hi = li + 1; hipLaunchKernelGGL(mk_fwd, dim3(grid), dim3(NWAVES * 64), LDS_BYTES, stream, a); }
}
```

```cpp
#include <hip/hip_runtime.h>
#include <cstdio>
#include <cstdint>

#ifndef MK_N_LAUNCHES
#define MK_N_LAUNCHES 1
#endif
namespace pg8 {
#define PG8_LAS __attribute__((address_space(3)))
typedef unsigned short bf16_t;
typedef short bf16x8 __attribute__((ext_vector_type(8)));
typedef float f32x4 __attribute__((ext_vector_type(4)));
typedef unsigned u32x4 __attribute__((ext_vector_type(4)));
typedef int v4i_t __attribute__((ext_vector_type(4)));
typedef int v8i_t __attribute__((ext_vector_type(8)));
constexpr int BM = 256, BK = 64, HALF = 128, HTB = HALF * BK * 2  , STAGE_BYTES = 8 * HTB, NXCD = 8, WGM = 8;

__host__ __device__ __forceinline__ int lds_byte(int r, int c) { const int st = (r >> 4) * 2 + (c >> 5), rr = r & 15, cc = c & 31, ob = rr * 64 + cc * 2; return st * 1024 + (ob ^ (((ob >> 9) & 1) << 5)); }
__host__ __device__ __forceinline__ void stage_rc(int b, int& R, int& C) { const int st = b / 1024, sb = b % 1024, swz = sb ^ (((sb >> 9) & 1) << 5); R = (st >> 1) * 16 + swz / 64; C = (st & 1) * 32 + (swz % 64) / 2; }
__host__ __device__ __forceinline__ int perm32(int rho) { const int n = rho >> 4, i = rho & 15; return 8 * (i >> 2) + 4 * n + (i & 3); }

struct Unit { int pm, pn; };
struct Gemm { const bf16_t* A; const bf16_t* Bt; int M, N, K; };

struct StaticOrder {
    int nM, nN, nwg, G, c, wgm;
    __host__ __device__ void init(int M, int N, int G_, int c_, int wgm_ = WGM) { nM = M / BM; nN = N / BM; nwg = nM * nN; G = G_; c = c_; wgm = wgm_; }
    __host__ __device__ __forceinline__ bool next(int i, Unit& u) const {
        const long L = (long)i * G + c; if (L >= nwg) return false;
        int wgid = (int)L; { const int q = nwg / NXCD, r = nwg % NXCD, xcd = wgid % NXCD, off = wgid / NXCD; wgid = (xcd < r ? xcd * (q + 1) : r * (q + 1) + (xcd - r) * q) + off; }
        const int nig = wgm * nN, gid = wgid / nig, fm = gid * wgm, gsz = (nM - fm) < wgm ? (nM - fm) : wgm;
        u.pm = fm + ((wgid % nig) % gsz); u.pn = (wgid % nig) / gsz; return true;
    }
    __device__ __forceinline__ void a_ready(const Unit&) const {}
    __device__ __forceinline__ void done(const Unit&) const {}
};

__device__ __forceinline__ unsigned cvt_pk_bf16(float lo, float hi) { unsigned r; asm volatile("v_cvt_pk_bf16_f32 %0, %1, %2" : "=v"(r) : "v"(lo), "v"(hi)); return r; }
#ifndef MANT6
#define MANT6 0
#endif
__device__ __forceinline__ unsigned cvt_pk_op(float lo, float hi) {
#if MANT6
    unsigned a = __float_as_uint(lo), b = __float_as_uint(hi); a += 0xFFFFu + ((a >> 17) & 1u); b += 0xFFFFu + ((b >> 17) & 1u); return ((a >> 16) & 0xFFFEu) | (b & 0xFFFE0000u);
#else
    return cvt_pk_bf16(lo, hi);
#endif
}
typedef float f32x2 __attribute__((ext_vector_type(2)));
__device__ __forceinline__ f32x2 gelu_pk(f32x2 v) {
    const f32x2 av = __builtin_elementwise_abs(v), d = av * 0.2316418882f + 1.0f;
    f32x2 t; t.x = __builtin_amdgcn_rcpf(d.x); t.y = __builtin_amdgcn_rcpf(d.y);
    f32x2 q = t * 0.5307027145f + (-0.7265760135f); q = q * t + 0.7107068705f; q = q * t + (-0.142248368f); q = q * t + 0.127414796f; q = q * t;
    const f32x2 s = (v * v) * (-0.72134752044f);
    f32x2 e; e.x = __builtin_amdgcn_exp2f(s.x); e.y = __builtin_amdgcn_exp2f(s.y);
    const f32x2 m = v * (q * e), r = v - m;
    f32x2 o; o.x = v.x < 0.f ? m.x : r.x; o.y = v.y < 0.f ? m.y : r.y; return o;
}

typedef unsigned u32x2 __attribute__((ext_vector_type(2)));
#ifndef UP_NT
#define UP_NT 0
#endif
#if UP_NT
#define UP_STORE(p, v) __builtin_nontemporal_store((v), (p))
#else
#define UP_STORE(p, v) (*(p) = (v))
#endif
#ifndef EPI_NT
#define EPI_NT 0
#endif
#if EPI_NT
#define NT_STORE(p, v) __builtin_nontemporal_store((v), (p))
#else
#define NT_STORE(p, v) (*(p) = (v))
#endif
__device__ __forceinline__ float sigmoid_f(float x) { return __builtin_amdgcn_rcpf(1.0f + __builtin_amdgcn_exp2f(-1.4426950409f * x)); }
__device__ __forceinline__ float gelu_tanh_f(float x) { const float u = x * (1.0f + 0.044715f * x * x); return x * __builtin_amdgcn_rcpf(1.0f + __builtin_amdgcn_exp2f(-2.3022082f * u)); }
__device__ __forceinline__ float bf_lo(unsigned w) { return __uint_as_float(w << 16); }
__device__ __forceinline__ float bf_hi(unsigned w) { return __uint_as_float(w & 0xffff0000u); }
__device__ __forceinline__ u32x4 pack8(const f32x4& v0, const f32x4& v1) { u32x4 w; w.x = cvt_pk_op(v0[0], v0[1]); w.y = cvt_pk_op(v0[2], v0[3]); w.z = cvt_pk_op(v1[0], v1[1]); w.w = cvt_pk_op(v1[2], v1[3]); return w; }
__device__ __forceinline__ u32x4 pack8f(const f32x4& v0, const f32x4& v1) { u32x4 w; w.x = cvt_pk_bf16(v0[0], v0[1]); w.y = cvt_pk_bf16(v0[2], v0[3]); w.z = cvt_pk_bf16(v1[0], v1[1]); w.w = cvt_pk_bf16(v1[2], v1[3]); return w; }

__device__ __forceinline__ size_t t4096_off(bool tiled, int row, int c) { return tiled ? ((((size_t)(row >> 8) * 64 + (size_t)(c >> 6)) * 256 + (size_t)(row & 255)) * 64 + (size_t)(c & 63)) : ((size_t)row * 4096 + c); }
struct EpiIn {
    static constexpr bool PERM = true, AFTER_DRAIN = false;
    bf16_t *UA, *VA, *XB2, *GA, *GB; float* VST; int split, off_lo, off_hi; const float* rs; const float* cs; int ga_tiled;
    __device__ __forceinline__ void operator()(const f32x4 (&acc)[2][2][4][2], const Unit& u, int wr, int wc, int fr, int fq) const {
        const int row0 = u.pm * BM + wr * 64 + fr; const int pn = u.pn + (u.pn < split ? off_lo : off_hi);
        int mode, ldc, colt; bf16_t* base;
        if (pn < 8) { mode = 0; base = UA; ldc = 2048; colt = pn * 256; }
        else if (pn < 16) { mode = 0; base = VA; ldc = 2048; colt = (pn - 8) * 256; }
        else if (pn < 20) { mode = 1; base = XB2; ldc = 0; colt = (pn - 16) * 256; }
        else if (pn < 36) { mode = 2; base = GA; ldc = 4096; colt = (pn - 20) * 256; }
        else { mode = 2; base = GB; ldc = 4096; colt = (pn - 36) * 256; }
        const int col0 = colt + wc * 32 + 8 * fq; const bool vstat = (pn >= 8 && pn < 16); const bool q8 = (rs != nullptr);
        f32x4 csv[2][2];
        if (q8) {
#pragma unroll
            for (int bj = 0; bj < 2; ++bj) { const float* cp = cs + u.pn * BM + wc * 32 + 8 * fq + bj * HALF; csv[bj][0] = *(const f32x4*)cp; csv[bj][1] = *(const f32x4*)(cp + 4); } }
        float rsa[2][4];
#pragma unroll
        for (int ai = 0; ai < 2; ++ai)
#pragma unroll
            for (int m = 0; m < 4; ++m) rsa[ai][m] = q8 ? rs[row0 + ai * HALF + m * 16] : 1.0f;
        __builtin_amdgcn_sched_barrier(0);
#pragma unroll
        for (int ai = 0; ai < 2; ++ai)
#pragma unroll
            for (int m = 0; m < 4; ++m) { const int row = row0 + ai * HALF + m * 16; float s1 = 0.f, s2 = 0.f; const float rsv = rsa[ai][m];
#pragma unroll
                for (int bj = 0; bj < 2; ++bj) { f32x4 v0 = acc[ai][bj][m][0], v1 = acc[ai][bj][m][1]; const int c = col0 + bj * HALF;
                    if (q8) {
#pragma unroll
                        for (int j = 0; j < 4; ++j) { v0[j] = (float)__float_as_int(v0[j]) * (rsv * csv[bj][0][j]); v1[j] = (float)__float_as_int(v1[j]) * (rsv * csv[bj][1][j]); } }
                    if (mode == 0) {
#pragma unroll
                        for (int j = 0; j < 4; ++j) { v0[j] = gelu_tanh_f(v0[j]); v1[j] = gelu_tanh_f(v1[j]); }
                        if (vstat) { s1 += ((v0[0] + v0[1]) + (v0[2] + v0[3])) + ((v1[0] + v1[1]) + (v1[2] + v1[3]));
                            s2 += ((v0[0] * v0[0] + v0[1] * v0[1]) + (v0[2] * v0[2] + v0[3] * v0[3])) + ((v1[0] * v1[0] + v1[1] * v1[1]) + (v1[2] * v1[2] + v1[3] * v1[3])); } }
                    else if (mode == 2) {
#pragma unroll
                        for (int j = 0; j < 4; ++j) { v0[j] = sigmoid_f(v0[j]); v1[j] = sigmoid_f(v1[j]); } }
                    bf16_t* p;
                    if (mode == 1) p = base + ((((size_t)(c >> 4) * 512 + (size_t)(row >> 5)) * 32 + (size_t)(row & 31)) * 16 + (size_t)(c & 15));
                    else if (mode == 0 && ga_tiled) p = base + ((((size_t)(row >> 7) * 16 + (size_t)(c >> 7)) * 128 + (size_t)(row & 127)) * 128 + (size_t)(c & 127));
                    else if (mode == 2) p = base + t4096_off(ga_tiled != 0, row, c);
                    else p = base + (size_t)row * ldc + c;
                    NT_STORE((u32x4*)p, pack8(v0, v1)); }
                if (vstat) { s1 += __shfl_xor(s1, 16); s1 += __shfl_xor(s1, 32); s2 += __shfl_xor(s2, 16); s2 += __shfl_xor(s2, 32);
                    if (fq == 0) { f32x2 o; o.x = s1; o.y = s2; *(f32x2*)(VST + ((size_t)row * 32 + (pn - 8) * 4 + wc) * 2) = o; } } }
    }
};
#ifndef EPI_NT_LD
#define EPI_NT_LD 1
#endif
#if EPI_NT_LD
#define EPI_LD1(p) __builtin_nontemporal_load(p)
#else
#define EPI_LD1(p) (*(p))
#endif
struct EpiGlu {
    static constexpr bool PERM = true, AFTER_DRAIN = false;
    bf16_t* GBm; int gb_tiled;
    __device__ __forceinline__ void operator()(const f32x4 (&acc)[2][2][4][2], const Unit& u, int wr, int wc, int fr, int fq) const {
        const int row0 = u.pm * BM + wr * 64 + fr, oc0 = u.pn * 128 + wc * 32 + 8 * fq;
        u32x4 ga[2][4];
#pragma unroll
        for (int ai = 0; ai < 2; ++ai)
#pragma unroll
            for (int m = 0; m < 4; ++m) ga[ai][m] = EPI_LD1((const u32x4*)(GBm + t4096_off(gb_tiled != 0, row0 + ai * HALF + m * 16, oc0)));
        __builtin_amdgcn_sched_barrier(0);
#pragma unroll
        for (int ai = 0; ai < 2; ++ai)
#pragma unroll
            for (int m = 0; m < 4; ++m) { bf16_t* p = GBm + t4096_off(gb_tiled != 0, row0 + ai * HALF + m * 16, oc0); const u32x4 g = ga[ai][m];
                const f32x4 a0 = acc[ai][0][m][0], a1 = acc[ai][0][m][1], b0 = acc[ai][1][m][0], b1 = acc[ai][1][m][1]; f32x4 o0, o1;
                o0[0] = a0[0] * sigmoid_f(b0[0]) * bf_lo(g.x); o0[1] = a0[1] * sigmoid_f(b0[1]) * bf_hi(g.x); o0[2] = a0[2] * sigmoid_f(b0[2]) * bf_lo(g.y); o0[3] = a0[3] * sigmoid_f(b0[3]) * bf_hi(g.y);
                o1[0] = a1[0] * sigmoid_f(b1[0]) * bf_lo(g.z); o1[1] = a1[1] * sigmoid_f(b1[1]) * bf_hi(g.z); o1[2] = a1[2] * sigmoid_f(b1[2]) * bf_lo(g.w); o1[3] = a1[3] * sigmoid_f(b1[3]) * bf_hi(g.w);
                *(u32x4*)p = pack8(o0, o1); }
    }
};
struct EpiProj {
    static constexpr bool PERM = true, AFTER_DRAIN = false;
    bf16_t* GA; const bf16_t* GBm; int ga_tiled;
    __device__ __forceinline__ void operator()(const f32x4 (&acc)[2][2][4][2], const Unit& u, int wr, int wc, int fr, int fq) const {
        const int row0 = u.pm * BM + wr * 64 + fr, col0 = u.pn * BM + wc * 32 + 8 * fq;
#pragma unroll
        for (int ai = 0; ai < 2; ++ai) {
            u32x4 gav[4][2], gbv[4][2];
#pragma unroll
            for (int m = 0; m < 4; ++m)
#pragma unroll
                for (int bj = 0; bj < 2; ++bj) { const int rr = row0 + ai * HALF + m * 16, cc = col0 + bj * HALF;
                    const bf16_t* gap = ga_tiled ? GA + ((((size_t)(rr >> 8) * 64 + (size_t)(cc >> 6)) * 256 + (size_t)(rr & 255)) * 64 + (size_t)(cc & 63)) : GA + (size_t)rr * 4096 + cc;
                    gav[m][bj] = EPI_LD1((const u32x4*)gap); gbv[m][bj] = EPI_LD1((const u32x4*)(GBm + t4096_off(ga_tiled != 0, rr, cc))); }
            __builtin_amdgcn_sched_barrier(0);
#pragma unroll
            for (int m = 0; m < 4; ++m) { const size_t off = (size_t)(row0 + ai * HALF + m * 16) * 4096 + col0;
#pragma unroll
                for (int bj = 0; bj < 2; ++bj) { const int rr = row0 + ai * HALF + m * 16, cc = col0 + bj * HALF;
                    bf16_t* gap = ga_tiled ? GA + ((((size_t)(rr >> 8) * 64 + (size_t)(cc >> 6)) * 256 + (size_t)(rr & 255)) * 64 + (size_t)(cc & 63)) : GA + off + bj * HALF;
                    const u32x4 ga = gav[m][bj], gb = gbv[m][bj];
                    const f32x4 a0 = acc[ai][bj][m][0], a1 = acc[ai][bj][m][1]; f32x4 o0, o1;
                    o0[0] = a0[0] * bf_lo(ga.x) + bf_lo(gb.x); o0[1] = a0[1] * bf_hi(ga.x) + bf_hi(gb.x); o0[2] = a0[2] * bf_lo(ga.y) + bf_lo(gb.y); o0[3] = a0[3] * bf_hi(ga.y) + bf_hi(gb.y);
                    o1[0] = a1[0] * bf_lo(ga.z) + bf_lo(gb.z); o1[1] = a1[1] * bf_hi(ga.z) + bf_hi(gb.z); o1[2] = a1[2] * bf_lo(ga.w) + bf_lo(gb.w); o1[3] = a1[3] * bf_hi(ga.w) + bf_hi(gb.w);
                    *(u32x4*)gap = pack8(o0, o1); } } }
    }
};
struct EpiStat {
    static constexpr bool PERM = true, AFTER_DRAIN = false;
    bf16_t* O; float* part; int tiled;
    __device__ __forceinline__ void operator()(const f32x4 (&acc)[2][2][4][2], const Unit& u, int wr, int wc, int fr, int fq) const {
        const int row0 = u.pm * BM + wr * 64 + fr, col0 = u.pn * BM + wc * 32 + 8 * fq;
#pragma unroll
        for (int ai = 0; ai < 2; ++ai)
#pragma unroll
            for (int m = 0; m < 4; ++m) { const int row = row0 + ai * HALF + m * 16; float s = 0.f;
#pragma unroll
                for (int bj = 0; bj < 2; ++bj) { const f32x4 v0 = acc[ai][bj][m][0], v1 = acc[ai][bj][m][1];
                    s += (v0[0] * v0[0] + v0[1] * v0[1]) + (v0[2] * v0[2] + v0[3] * v0[3]) + (v1[0] * v1[0] + v1[1] * v1[1]) + (v1[2] * v1[2] + v1[3] * v1[3]);
                    *(u32x4*)(O + t4096_off(tiled != 0, row, col0 + bj * HALF)) = pack8f(v0, v1); }
                s += __shfl_xor(s, 16); s += __shfl_xor(s, 32);
                if (fq == 0) part[(size_t)row * 64 + u.pn * 4 + wc] = s; }
    }
};
struct EpiUp {
    static constexpr bool PERM = true, AFTER_DRAIN = false;
    bf16_t* H; const float* rs; const float* cs; int tiled;
    __device__ __forceinline__ void operator()(const f32x4 (&acc)[2][2][4][2], const Unit& u, int wr, int wc, int fr, int fq) const {
        const int row0 = u.pm * BM + wr * 64 + fr, col0 = u.pn * BM + wc * 32 + 8 * fq; const bool q8 = (rs != nullptr);
        f32x4 csv[2][2];
        if (q8) {
#pragma unroll
            for (int bj = 0; bj < 2; ++bj) { const float* cp = cs + col0 + bj * HALF; csv[bj][0] = *(const f32x4*)cp; csv[bj][1] = *(const f32x4*)(cp + 4); } }
        float rsa[2][4];
#pragma unroll
        for (int ai = 0; ai < 2; ++ai)
#pragma unroll
            for (int m = 0; m < 4; ++m) rsa[ai][m] = q8 ? rs[row0 + ai * HALF + m * 16] : 1.0f;
        __builtin_amdgcn_sched_barrier(0);
#pragma unroll
        for (int ai = 0; ai < 2; ++ai)
#pragma unroll
            for (int m = 0; m < 4; ++m) { const int row = row0 + ai * HALF + m * 16; const float rsv = rsa[ai][m];
                bf16_t* rowp = tiled ? H + (((size_t)u.pm * 256 + (size_t)(u.pn * 4 + (wc >> 1))) * 256 + (size_t)(row & 255)) * 64 + (wc & 1) * 32 + 8 * fq : H + (size_t)row * 16384 + col0;
#pragma unroll
                for (int bj = 0; bj < 2; ++bj) { f32x4 v0 = acc[ai][bj][m][0], v1 = acc[ai][bj][m][1];
                    if (q8) {
#pragma unroll
                        for (int j = 0; j < 4; ++j) { v0[j] = (float)__float_as_int(v0[j]) * (rsv * csv[bj][0][j]); v1[j] = (float)__float_as_int(v1[j]) * (rsv * csv[bj][1][j]); } }
#pragma unroll
                    for (int j = 0; j < 4; ++j) { const float a = fmaxf(v0[j], 0.f), b = fmaxf(v1[j], 0.f); v0[j] = a * a; v1[j] = b * b; }
                    UP_STORE((u32x4*)(rowp + (tiled ? bj * 2 * 256 * 64 : bj * HALF)), pack8(v0, v1)); } }
    }
};

template <class Epi, class Sched, bool ALIGN_EPI = false, bool SP2 = false, bool I8 = false, int AUXA = 0, bool TA = false, bool TB = false>
__device__ __forceinline__ void gemm_phase(PG8_LAS unsigned char* lds, const Gemm g, const Sched& S, const Epi& E) {
    const int tid = threadIdx.x, wid = __builtin_amdgcn_readfirstlane(tid >> 6), lane = tid & 63, wr = wid >> 2, wc = wid & 3, fr = lane & 15, fq = lane >> 4;
    const int K = g.K, nt = K / BK;
    unsigned voffA[2], voffB[2];
#pragma unroll
    for (int i = 0; i < 2; ++i) { int R, C; stage_rc(tid * 16 + i * 8192, R, C); const int Rb = Epi::PERM ? ((R & ~31) + perm32(R & 31)) : R;
        voffA[i] = (unsigned)(R * (TA ? BK : K) + C) * 2u; voffB[i] = (unsigned)(Rb * (TB ? BK : K) + C) * 2u; }
    const size_t kstepA = TA ? (size_t)BM * BK * 2 : (size_t)(BK * 2), kstepB = TB ? (size_t)BM * BK * 2 : (size_t)(BK * 2);
    const size_t hstepA = TA ? (size_t)HALF * BK * 2 : (size_t)HALF * K * 2, hstepB = TB ? (size_t)HALF * BK * 2 : (size_t)HALF * K * 2;
    const size_t hstep = (size_t)HALF * K * 2;
    const size_t tstep = 2 * hstep;
    const unsigned ldsw = (unsigned)wid * 1024u;
    const int aoff = lds_byte(wr * 64 + fr, fq * 8), boff = lds_byte(wc * 32 + fr, fq * 8);
#define PG8_SA(b, h) (((b) * 2 + (h)) * HTB)
#define PG8_SB(b, h) ((4 + (b) * 2 + (h)) * HTB)
#define PG8_STAGE(bufoff, gbase, voff) do { _Pragma("unroll") for (int _i = 0; _i < 2; ++_i) \
        __builtin_amdgcn_global_load_lds((const unsigned*)((const char*)(gbase) + (voff)[_i]), (PG8_LAS unsigned*)(lds + (bufoff) + ldsw + _i * 8192), 16, 0, 0); } while (0)
#define PG8_STAGEA(bufoff, gbase, voff) do { _Pragma("unroll") for (int _i = 0; _i < 2; ++_i) \
        __builtin_amdgcn_global_load_lds((const unsigned*)((const char*)(gbase) + (voff)[_i]), (PG8_LAS unsigned*)(lds + (bufoff) + ldsw + _i * 8192), 16, 0, AUXA); } while (0)
#define PG8_LDA(dst, b, h) do { _Pragma("unroll") for (int m = 0; m < 4; ++m) _Pragma("unroll") for (int k = 0; k < 2; ++k) dst[m][k] = *(const PG8_LAS bf16x8*)(lds + PG8_SA(b, h) + aoff + m * 2048 + k * 1024); } while (0)
#define PG8_LDB(dst, b, h) do { _Pragma("unroll") for (int n = 0; n < 2; ++n) _Pragma("unroll") for (int k = 0; k < 2; ++k) dst[n][k] = *(const PG8_LAS bf16x8*)(lds + PG8_SB(b, h) + boff + n * 2048 + k * 1024); } while (0)
#define PG8_MMA(ai, bj, At, Bt) do { __builtin_amdgcn_s_setprio(1); _Pragma("unroll") for (int m = 0; m < 4; ++m) _Pragma("unroll") for (int n = 0; n < 2; ++n) _Pragma("unroll") for (int k = 0; k < 2; ++k) { \
        if constexpr (I8) { acc[ai][bj][m][n] = __builtin_bit_cast(f32x4, __builtin_amdgcn_mfma_i32_16x16x64_i8(__builtin_bit_cast(v4i_t, Bt[n][k]), __builtin_bit_cast(v4i_t, At[m][k]), __builtin_bit_cast(v4i_t, acc[ai][bj][m][n]), 0, 0, 0)); } \
        else acc[ai][bj][m][n] = __builtin_amdgcn_mfma_f32_16x16x32_bf16(Bt[n][k], At[m][k], acc[ai][bj][m][n], 0, 0, 0); } __builtin_amdgcn_s_setprio(0); } while (0)
#define PG8_WAIT_V(n) asm volatile("s_waitcnt vmcnt(" #n ")" ::: "memory")
#define PG8_WAIT_L(n) asm volatile("s_waitcnt lgkmcnt(" #n ")" ::: "memory")
#define PG8_BAR __builtin_amdgcn_s_barrier()
#define PG8_SCHED __builtin_amdgcn_sched_barrier(0)
    Unit cur, nxt; int ui = 0;
    if (!S.next(0, cur)) return;
    f32x4 acc[2][2][4][2];
#pragma unroll
    for (int a = 0; a < 2; ++a)
#pragma unroll
        for (int b = 0; b < 2; ++b)
#pragma unroll
            for (int m = 0; m < 4; ++m)
#pragma unroll
                for (int n = 0; n < 2; ++n) acc[a][b][m][n] = (f32x4){0.f, 0.f, 0.f, 0.f};
    bf16x8 At[4][2], B0[2][2], B1[2][2];
    const char* cA = (const char*)g.A + (size_t)cur.pm * tstep; const char* cB = (const char*)g.Bt + (size_t)cur.pn * tstep;
    S.a_ready(cur);
    if constexpr (SP2) {
        PG8_STAGE(PG8_SB(0, 0), cB, voffB); PG8_STAGE(PG8_SB(0, 1), cB + hstepB, voffB); PG8_STAGEA(PG8_SA(0, 0), cA, voffA); PG8_STAGEA(PG8_SA(0, 1), cA + hstepA, voffA);
        if (wr == 1) PG8_BAR;
        PG8_WAIT_V(2); PG8_BAR;
        PG8_STAGE(PG8_SB(1, 0), cB + kstepB, voffB); PG8_STAGEA(PG8_SA(1, 0), cA + kstepA, voffA); PG8_STAGE(PG8_SB(1, 1), cB + hstepB + kstepB, voffB);
        PG8_WAIT_V(6); PG8_BAR;
    } else {
        PG8_STAGE(PG8_SB(0, 0), cB, voffB); PG8_STAGEA(PG8_SA(0, 0), cA, voffA); PG8_STAGE(PG8_SB(0, 1), cB + hstepB, voffB); PG8_STAGEA(PG8_SA(0, 1), cA + hstepA, voffA);
        if (wr == 1) PG8_BAR;
        PG8_WAIT_V(4); PG8_BAR;
        PG8_STAGE(PG8_SB(1, 0), cB + kstepB, voffB); PG8_STAGEA(PG8_SA(1, 0), cA + kstepA, voffA); PG8_STAGE(PG8_SB(1, 1), cB + hstepB + kstepB, voffB);
        PG8_WAIT_V(6); PG8_BAR;
    }
    for (;;) {
        const bool has_next = S.next(ui + 1, nxt);
        const char* nA = has_next ? (const char*)g.A + (size_t)nxt.pm * tstep : cA; const char* nB = has_next ? (const char*)g.Bt + (size_t)nxt.pn * tstep : cB;
        for (int t = 0; t < nt; t += 2) {
            const bool last = (t == nt - 2);
            const char* a1 = cA + (size_t)(t + 1) * kstepA;
            const char* a2 = last ? nA : cA + (size_t)(t + 2) * kstepA; const char* b2 = last ? nB : cB + (size_t)(t + 2) * kstepB;
            const char* a3 = a2 + kstepA; const char* b3 = b2 + kstepB;
            if (last && has_next) S.a_ready(nxt);
            if constexpr (SP2) {
            PG8_LDB(B0, 0, 0); PG8_LDB(B1, 0, 1); PG8_SCHED; PG8_LDA(At, 0, 0); PG8_STAGEA(PG8_SA(1, 1), a1 + hstepA, voffA);
            PG8_WAIT_V(8); PG8_WAIT_L(0); PG8_BAR; PG8_MMA(0, 0, At, B0); PG8_MMA(0, 1, At, B1); PG8_BAR; PG8_SCHED;
            PG8_LDA(At, 0, 1); PG8_STAGE(PG8_SB(0, 0), b2, voffB); PG8_STAGE(PG8_SB(0, 1), b2 + hstepB, voffB); PG8_STAGEA(PG8_SA(0, 0), a2, voffA);
            PG8_WAIT_V(8); PG8_WAIT_L(0); PG8_BAR; PG8_MMA(1, 0, At, B0); PG8_MMA(1, 1, At, B1); PG8_BAR; PG8_SCHED;
            PG8_LDB(B0, 1, 0); PG8_LDB(B1, 1, 1); PG8_SCHED; PG8_LDA(At, 1, 0); PG8_STAGEA(PG8_SA(0, 1), a2 + hstepA, voffA);
            PG8_WAIT_V(8); PG8_WAIT_L(0); PG8_BAR; PG8_MMA(0, 0, At, B0); PG8_MMA(0, 1, At, B1); PG8_BAR; PG8_SCHED;
            PG8_LDA(At, 1, 1); PG8_STAGE(PG8_SB(1, 0), b3, voffB); PG8_STAGE(PG8_SB(1, 1), b3 + hstepB, voffB); PG8_STAGEA(PG8_SA(1, 0), a3, voffA);
            PG8_WAIT_V(8); PG8_WAIT_L(0); PG8_BAR; PG8_MMA(1, 0, At, B0); PG8_MMA(1, 1, At, B1); PG8_BAR; PG8_SCHED;
            } else {
            PG8_LDB(B0, 0, 0); PG8_SCHED; PG8_LDA(At, 0, 0); PG8_STAGEA(PG8_SA(1, 1), a1 + hstepA, voffA);
            PG8_WAIT_L(8); PG8_BAR; PG8_WAIT_L(0); PG8_MMA(0, 0, At, B0); PG8_BAR; PG8_SCHED;
            PG8_LDB(B1, 0, 1); PG8_STAGE(PG8_SB(0, 0), b2, voffB);
            PG8_BAR; PG8_WAIT_L(0); PG8_MMA(0, 1, At, B1); PG8_BAR;
            PG8_LDA(At, 0, 1); PG8_STAGEA(PG8_SA(0, 0), a2, voffA);
            PG8_BAR; PG8_WAIT_L(0); PG8_MMA(1, 0, At, B0); PG8_BAR; PG8_SCHED;
            PG8_STAGE(PG8_SB(0, 1), b2 + hstepB, voffB);
            PG8_WAIT_V(6); PG8_BAR; PG8_MMA(1, 1, At, B1); PG8_BAR;
            PG8_LDB(B0, 1, 0); PG8_SCHED; PG8_LDA(At, 1, 0); PG8_STAGEA(PG8_SA(0, 1), a2 + hstepA, voffA);
            PG8_WAIT_L(8); PG8_BAR; PG8_WAIT_L(0); PG8_MMA(0, 0, At, B0); PG8_BAR; PG8_SCHED;
            PG8_LDB(B1, 1, 1); PG8_STAGE(PG8_SB(1, 0), b3, voffB);
            PG8_BAR; PG8_WAIT_L(0); PG8_MMA(0, 1, At, B1); PG8_BAR;
            PG8_LDA(At, 1, 1); PG8_STAGEA(PG8_SA(1, 0), a3, voffA);
            PG8_BAR; PG8_WAIT_L(0); PG8_MMA(1, 0, At, B0); PG8_BAR; PG8_SCHED;
            PG8_STAGE(PG8_SB(1, 1), b3 + hstepB, voffB);
            PG8_WAIT_V(6); PG8_BAR; PG8_MMA(1, 1, At, B1); PG8_BAR;
            }
        }
        if constexpr (ALIGN_EPI) { if (wr == 0) PG8_BAR; }
        if constexpr (!Epi::AFTER_DRAIN) { E(acc, cur, wr, wc, fr, fq); S.done(cur); }
        if (!has_next) break;
#pragma unroll
        for (int a = 0; a < 2; ++a)
#pragma unroll
            for (int b = 0; b < 2; ++b)
#pragma unroll
                for (int m = 0; m < 4; ++m)
#pragma unroll
                    for (int n = 0; n < 2; ++n) acc[a][b][m][n] = (f32x4){0.f, 0.f, 0.f, 0.f};
        cur = nxt; cA = nA; cB = nB; ++ui;
        if constexpr (ALIGN_EPI) { if (wr == 1) PG8_BAR; }
    }
    PG8_WAIT_V(0);
    if constexpr (!ALIGN_EPI) { if (wr == 0) PG8_BAR; }
    PG8_BAR;
    if constexpr (Epi::AFTER_DRAIN) { E.fused(acc, cur, wr, wc, fr, fq, lds, wid, lane); S.done(cur); }
#undef PG8_SA
#undef PG8_SB
#undef PG8_STAGE
#undef PG8_STAGEA
#undef PG8_LDA
#undef PG8_LDB
#undef PG8_MMA
#undef PG8_WAIT_V
#undef PG8_WAIT_L
#undef PG8_BAR
#undef PG8_SCHED
}
}
#ifndef TILED_A
#define TILED_A true
#endif
#ifndef TILED_HID
#define TILED_HID 1
#endif
#ifndef P8_AUXA
#define P8_AUXA 0
#endif
#ifndef P7_WGM
#define P7_WGM 8
#endif
#ifndef I8_SP2
#define I8_SP2 PG8_SP2
#endif
#ifndef I8_ALIGN
#define I8_ALIGN PG8_ALIGN
#endif
#ifndef P345_WGM
#define P345_WGM 8
#endif
#ifndef P8_WGM
#define P8_WGM 4
#endif
#ifndef PG8_SP2
#define PG8_SP2 true
#endif
#ifndef PG8_ALIGN
#define PG8_ALIGN true
#endif

constexpr int NWAVES = 8;
constexpr int N_LAUNCHES = MK_N_LAUNCHES;
constexpr int N_PHASES = 10;
constexpr int BATCH = 2, SEQ = 8192, D = 4096, M = BATCH * SEQ;
constexpr int AW = 2048, ACH = 128, AH = 16, AHD = 128;
constexpr int BW = 1024, SG = 64, SGD = 16, SP = 64;
constexpr int DFF = 16384, INW = 2 * AW + BW + 2 * D;
constexpr int TC = 32, NCHB = SEQ / TC, NCH = M / TC;
constexpr float NORM_EPS = 1e-6f;

constexpr size_t MiB = 1u << 20;
constexpr size_t WS_CTL = 0, CTL_ZERO_BYTES = 1 * MiB;
constexpr size_t WS_WIN = 1 * MiB, WS_WPROJ = 105 * MiB, WS_WGLU = 121 * MiB, WS_WOUT = 137 * MiB, WS_WUP = 169 * MiB, WS_WDN = 297 * MiB;
constexpr size_t WS_KTAB = 425 * MiB, WS_BMAT = 426 * MiB, WS_CMAT = 434 * MiB, WS_AT = 442 * MiB;
constexpr size_t WS_PART = 443 * MiB;
constexpr size_t WS_ARB = 448 * MiB;
constexpr size_t WS_ARA = 576 * MiB;
constexpr size_t WS_UA = WS_ARA, WS_VA = WS_ARA + 64 * MiB, WS_XB2 = WS_ARA + 128 * MiB, WS_ZB = WS_ARA + 160 * MiB, WS_GA = WS_ARA + 192 * MiB, WS_GB = WS_ARA + 320 * MiB;
#ifndef IN_INT8
#define IN_INT8 2
#endif
constexpr int NG8 = IN_INT8 == 2 ? INW : IN_INT8 == 1 ? 1024 + 2048 + 8192 : 2048 + 8192, N16 = INW - NG8;
__host__ __device__ constexpr int win_row16(int n) { return n < 2048 ? n : n - 2048; }
__host__ __device__ constexpr int win_row8(int n) { return n < 4096 ? n - 2048 : n - 3072; }
__host__ __device__ constexpr int win_col8(int r) { return IN_INT8 == 2 ? r : IN_INT8 == 1 ? r + 2048 : (r < 2048 ? r + 2048 : r + 3072); }
__host__ __device__ constexpr int win_col16(int r) { return r < 2048 ? r : r + 2048; }
constexpr size_t WS_H8 = WS_ARA + 448 * MiB;
constexpr size_t WS_W8 = WS_WIN + (size_t)N16 * D * 2;
constexpr size_t WS_H2Q = WS_WIN;
static_assert(WS_W8 + (size_t)NG8 * D <= WS_WPROJ && WS_H2Q + (size_t)M * D <= WS_WOUT, "int8 copies");
constexpr size_t WS_RS1 = WS_AT + 64 * 1024, WS_RS2 = WS_AT + 128 * 1024, WS_CSIN = WS_AT + 192 * 1024, WS_CSUP = WS_AT + 256 * 1024;
static_assert(WS_CSIN + (size_t)NG8 * 4 <= WS_CSUP && WS_CSUP + (size_t)DFF * 4 <= WS_PART, "scale arrays");
constexpr int CW_CMAXIN = 16384, CW_CMAXUP = 32768;
static_assert((CW_CMAXUP + DFF) * 4 <= (int)(1u << 20) && CW_CMAXIN + NG8 <= CW_CMAXUP, "CTL words inside the memset region");
constexpr size_t WS_END = 1088 * MiB;
static_assert(WS_WIN + (size_t)INW * D * 2 <= WS_WPROJ && WS_WPROJ + (size_t)D * AW * 2 <= WS_WGLU && WS_WGLU + (size_t)2 * D * BW * 2 <= WS_WOUT && WS_WOUT + (size_t)D * D * 2 <= WS_WUP &&
              WS_WUP + (size_t)DFF * D * 2 <= WS_WDN && WS_WDN + (size_t)D * DFF * 2 <= WS_KTAB, "weight map");
static_assert(WS_KTAB + (size_t)SG * TC * 256 * 2 <= WS_BMAT && WS_BMAT + (size_t)SG * 128 * 512 * 2 <= WS_CMAT && WS_CMAT + (size_t)SG * 512 * 128 * 2 <= WS_AT && WS_AT + (size_t)SG * SP * 8 <= WS_PART &&
              WS_PART + (size_t)M * 64 * 4 <= WS_ARB && WS_ARB + (size_t)M * D * 2 <= WS_ARA && WS_GB + (size_t)M * D * 2 <= WS_END && WS_ARA + (size_t)M * DFF * 2 <= WS_END, "activation map");
constexpr int CW_TMO = 0, CW_CODE = 1, CW_BAR = 4096;

constexpr int RING_OFF = 0, RING_BYTES = 131072;
constexpr int LDSCTL_OFF = RING_BYTES, MISC_OFF = LDSCTL_OFF + 320;
constexpr int LDS_BYTES = 147456;
static_assert(MISC_OFF + 128 <= LDS_BYTES, "LDS map");

#define GAS __attribute__((address_space(1)))
#define LAS __attribute__((address_space(3)))
typedef unsigned short bf16;
typedef unsigned v4u __attribute__((ext_vector_type(4)));
typedef unsigned v2u __attribute__((ext_vector_type(2)));
typedef float f32x4 __attribute__((ext_vector_type(4)));
typedef float f32x2 __attribute__((ext_vector_type(2)));
typedef short bf16x8 __attribute__((ext_vector_type(8)));
typedef GAS unsigned gu32;
#define RLX_AGENT __ATOMIC_RELAXED, __HIP_MEMORY_SCOPE_AGENT
#ifndef NT_STREAM
#define NT_STREAM 1
#endif
#if NT_STREAM
#define LD_STREAM(p) __builtin_nontemporal_load(p)
#define ST_STREAM(p, v) __builtin_nontemporal_store((v), (p))
#else
#define LD_STREAM(p) (*(p))
#define ST_STREAM(p, v) (*(p) = (v))
#endif
#define LDS_WAIT() asm volatile("s_waitcnt lgkmcnt(0)" ::: "memory")
#define VM_WAIT() asm volatile("s_waitcnt vmcnt(0)" ::: "memory")
__device__ __forceinline__ unsigned pk2(float lo, float hi) { return pg8::cvt_pk_op(lo, hi); }
__device__ __forceinline__ unsigned pk2x(float lo, float hi) { return pg8::cvt_pk_bf16(lo, hi); }
__device__ __forceinline__ float bflo(unsigned w) { return __uint_as_float(w << 16); }
__device__ __forceinline__ float bfhi(unsigned w) { return __uint_as_float(w & 0xffff0000u); }
__device__ __forceinline__ float gelu_t(float x) { return pg8::gelu_tanh_f(x); }

#define XB_TMO      128
#define XB_XCNT(j)  (256  + 64 * (j))
#define XB_XSUB(j)  (1280 + 64 * (j))
#define XB_XGEN(j)  (2304 + 64 * (j))
#define XB_TOP      3328
#define XB_TOPGEN   3392
#define XCD_BAR_WORDS 3456
#define XB_SPIN_CAP (1u << 18)

__device__ __forceinline__ unsigned xb_ld(unsigned* p)              { return __hip_atomic_load(p, __ATOMIC_RELAXED, __HIP_MEMORY_SCOPE_AGENT); }
__device__ __forceinline__ unsigned xb_add(unsigned* p, unsigned v) { return __hip_atomic_fetch_add(p, v, __ATOMIC_RELAXED, __HIP_MEMORY_SCOPE_AGENT); }
__device__ __forceinline__ unsigned xb_xcc_id() { return (unsigned)__builtin_amdgcn_s_getreg((3 << 11) | 20) & 0xFu; }
#define XB_SPIN(cond, bar) do { unsigned _sp = 0; while (cond) { __builtin_amdgcn_s_sleep(1); \
    if ((++_sp & 255u) == 0u) { if (xb_ld(&(bar)[XB_TMO])) break; if (_sp > XB_SPIN_CAP) { atomicAdd(&(bar)[XB_TMO], 1u); break; } } } } while (0)

struct XcdBarrier { unsigned* bar; unsigned x; volatile LAS unsigned* st; };

__device__ __forceinline__ XcdBarrier xcd_barrier_post(unsigned* bar, volatile LAS unsigned* st) {
    XcdBarrier b; b.bar = bar; b.x = xb_xcc_id(); b.st = st;
    if (threadIdx.x == 0) (void)xb_add(&bar[XB_XCNT(b.x)], 1u);
    return b;
}
__device__ __forceinline__ void xcd_barrier_complete(unsigned* bar, unsigned x, unsigned& nloc, unsigned& nx) {
    const unsigned G = gridDim.x * gridDim.y * gridDim.z;
    unsigned sum, cnt, mine, sp = 0u;
    for (;;) {
        sum = 0u; cnt = 0u; mine = 0u;
#pragma unroll
        for (unsigned j = 0; j < 16; ++j) { const unsigned c = xb_ld(&bar[XB_XCNT(j)]); sum += c; cnt += (c > 0u) ? 1u : 0u; mine = (j == x) ? c : mine; }
        if (sum == G) break;
        __builtin_amdgcn_s_sleep(1);
        if ((++sp & 255u) == 0u) { if (xb_ld(&bar[XB_TMO])) break; if (sp > XB_SPIN_CAP) { atomicAdd(&bar[XB_TMO], 1u); break; } }
    }
    nloc = mine > 0u ? mine : 1u; nx = cnt > 0u ? cnt : 1u;
}
__device__ __forceinline__ void xcd_barrier(const XcdBarrier& b) {
    asm volatile("s_waitcnt vmcnt(0)" ::: "memory");
    __syncthreads();
    if (threadIdx.x == 0) {
        unsigned* bar = b.bar;
        __builtin_amdgcn_s_waitcnt(0);
        unsigned nloc = b.st[0], nx = b.st[1];
        if (nloc == 0u) { xcd_barrier_complete(bar, b.x, nloc, nx); b.st[0] = nloc; b.st[1] = nx; }
        const unsigned old = xb_add(&bar[XB_XSUB(b.x)], 1u);
        const unsigned gen = old / nloc;
        if (old + 1u == (gen + 1u) * nloc) {
            __builtin_amdgcn_fence(__ATOMIC_RELEASE, "agent");
            asm volatile("s_waitcnt vmcnt(0)" ::: "memory");
            const unsigned og = xb_add(&bar[XB_TOP], 1u);
            const unsigned tg = og / nx;
            if (og + 1u == (tg + 1u) * nx) xb_add(&bar[XB_TOPGEN], 1u);
            else XB_SPIN(xb_ld(&bar[XB_TOPGEN]) == tg, bar);
            __builtin_amdgcn_fence(__ATOMIC_ACQUIRE, "agent");
            xb_add(&bar[XB_XGEN(b.x)], 1u);
            asm volatile("s_waitcnt vmcnt(0)" ::: "memory");
        } else {
            XB_SPIN(xb_ld(&bar[XB_XGEN(b.x)]) == gen, bar);
            __builtin_amdgcn_fence(__ATOMIC_ACQUIRE, "agent");
            asm volatile("s_waitcnt vmcnt(0)" ::: "memory");
        }
    }
    __syncthreads();
}

struct Args { const float* in[24]; float* out; unsigned char* ws; int ph_lo, ph_hi; };
struct Frame {
    LAS unsigned char* lds;
    volatile LAS unsigned* MISC;
    gu32* ctl;
    int tid, lane, wave;
    int vcu, G;
    float* out; unsigned char* ws;
};
enum { I_X = 0, I_NMIXPRE, I_WIN, I_VNG, I_VNB, I_WSP, I_BSP, I_WPROJ, I_LRE, I_LIM, I_LOGDT, I_BRE, I_BIM, I_CRE, I_CIM, I_DSKIP, I_WGLUA, I_WGLUB, I_WOUT, I_NMIXPOST, I_NMLPPRE, I_WUP, I_WDN, I_NMLPPOST };

__device__ __forceinline__ float wave_sum(float v) {
#pragma unroll
    for (int o = 1; o < 64; o <<= 1) v += __shfl_xor(v, o);
    return v;
}

__device__ __forceinline__ void p0_transpose_item(const float* W, int K, int N, bf16* WT, int out_row0, LAS unsigned char* scr, int k0, int n0, int lane) {
    const int c = lane & 15, kq = lane >> 4;
    const float* src = W + (size_t)(k0 + 4 * kq) * N + n0 + 4 * c;
    f32x4 v[16];
#pragma unroll
    for (int i = 0; i < 16; ++i) v[i] = LD_STREAM((const GAS f32x4*)(src + (size_t)((i & 3) + 16 * (i >> 2)) * N));
#pragma unroll
    for (int mb = 0; mb < 4; ++mb)
#pragma unroll
        for (int j = 0; j < 4; ++j) { v2u o; o.x = pk2(v[4 * mb + 0][j], v[4 * mb + 1][j]); o.y = pk2(v[4 * mb + 2][j], v[4 * mb + 3][j]);
            *(LAS v2u*)(scr + (4 * c + j) * 136 + (16 * mb + 4 * kq) * 2) = o; }
    LDS_WAIT(); asm volatile("" ::: "memory");
#pragma unroll
    for (int r = 0; r < 8; ++r) { const int n = (lane >> 3) + 8 * r; const LAS unsigned char* p = scr + n * 136 + (lane & 7) * 16;
        const v2u x = *(const LAS v2u*)p, y = *(const LAS v2u*)(p + 8); v4u o; o.x = x.x; o.y = x.y; o.z = y.x; o.w = y.y;
        const int orow = out_row0 + n;
        *(GAS v4u*)(WT + ((((size_t)(orow >> 8) * (size_t)(K >> 6) + (size_t)(k0 >> 6)) * 256 + (size_t)(orow & 255)) * 64 + 8 * (lane & 7))) = o; }
    LDS_WAIT(); asm volatile("" ::: "memory");
}
__device__ __forceinline__ size_t tile16_off(int row, int col, int ncols) { return TILED_A ? ((((size_t)(row >> 8) * (size_t)(ncols >> 6) + (size_t)(col >> 6)) * 256 + (size_t)(row & 255)) * 64 + (size_t)(col & 63)) : ((size_t)row * ncols + col); }
__device__ __forceinline__ size_t tile8_off(int row, int kb, int nbytes) { return TILED_A ? ((((size_t)(row >> 8) * (size_t)(nbytes >> 7) + (size_t)(kb >> 7)) * 256 + (size_t)(row & 255)) * 128 + (size_t)(kb & 127)) : ((size_t)row * nbytes + kb); }
#ifndef TILED_MIX
#define TILED_MIX 0
#endif
__device__ __forceinline__ size_t mix_off(int row, int col) { return TILED_MIX ? ((((size_t)(row >> 8) * 64 + (size_t)(col >> 6)) * 256 + (size_t)(row & 255)) * 64 + (size_t)(col & 63)) : ((size_t)row * D + col); }
__device__ __forceinline__ float wave_max(float v) {
#pragma unroll
    for (int o = 1; o < 64; o <<= 1) v = fmaxf(v, __shfl_xor(v, o));
    return v;
}
__device__ __forceinline__ unsigned pk4_i8(float a, float b, float c, float d) {
    const int qa = (int)__builtin_rintf(fminf(fmaxf(a, -127.f), 127.f)), qb = (int)__builtin_rintf(fminf(fmaxf(b, -127.f), 127.f)), qc = (int)__builtin_rintf(fminf(fmaxf(c, -127.f), 127.f)), qd = (int)__builtin_rintf(fminf(fmaxf(d, -127.f), 127.f));
    return ((unsigned)qa & 0xffu) | (((unsigned)qb & 0xffu) << 8) | (((unsigned)qc & 0xffu) << 16) | ((unsigned)qd << 24);
}
__device__ __forceinline__ void rms_row_to_bf16(const float* xrow, const float* g, bf16* orow, unsigned char* o8base, int m, float* rs, int lane) {
    const GAS f32x4* xr = (const GAS f32x4*)xrow + lane; const GAS f32x4* gr = (const GAS f32x4*)g + lane;
    f32x4 v[16]; float s = 0.f;
#pragma unroll
    for (int j = 0; j < 16; ++j) { v[j] = LD_STREAM(xr + 64 * j); s += (v[j].x * v[j].x + v[j].y * v[j].y) + (v[j].z * v[j].z + v[j].w * v[j].w); }
    const float rstd = 1.0f / sqrtf(wave_sum(s) * (1.f / D) + NORM_EPS);
    GAS v2u* o8 = (GAS v2u*)orow + lane; float am = 0.f;
#pragma unroll
    for (int j = 0; j < 16; ++j) { const f32x4 gg = gr[64 * j]; v[j].x *= rstd * gg.x; v[j].y *= rstd * gg.y; v[j].z *= rstd * gg.z; v[j].w *= rstd * gg.w;
        am = fmaxf(fmaxf(am, fmaxf(fabsf(v[j].x), fabsf(v[j].y))), fmaxf(fabsf(v[j].z), fabsf(v[j].w)));
        if (N16 > 0) { v2u o; o.x = pk2(v[j].x, v[j].y); o.y = pk2(v[j].z, v[j].w); o8[64 * j] = o; } }
    am = fmaxf(wave_max(am), 1e-30f); const float qs = 127.0f / am;
    if (lane == 0) rs[0] = am * (1.0f / 127.0f);
    GAS unsigned char* q8 = (GAS unsigned char*)(o8base + tile8_off(m, 4 * lane, D)); const size_t qstep = tile8_off(0, 256, D);
#pragma unroll
    for (int j = 0; j < 16; ++j) { *(GAS unsigned*)q8 = pk4_i8(v[j].x * qs, v[j].y * qs, v[j].z * qs, v[j].w * qs); q8 += qstep; }
}
__device__ __forceinline__ void p0_colmax_item(const float* W, int N, unsigned* cmax, int k0, int n0, int ncol0, int lane) {
    const int c = lane & 15, kq = lane >> 4;
    f32x4 mx = (f32x4){0.f, 0.f, 0.f, 0.f};
    for (int sb = 0; sb < 8; ++sb) { const float* src = W + (size_t)(k0 + 64 * sb + 4 * kq) * N + n0 + 4 * c;
#pragma unroll
        for (int i = 0; i < 16; ++i) { const f32x4 t = *(const GAS f32x4*)(src + (size_t)((i & 3) + 16 * (i >> 2)) * N);
            mx.x = fmaxf(mx.x, fabsf(t.x)); mx.y = fmaxf(mx.y, fabsf(t.y)); mx.z = fmaxf(mx.z, fabsf(t.z)); mx.w = fmaxf(mx.w, fabsf(t.w)); } }
#pragma unroll
    for (int j = 0; j < 4; ++j) { float t = mx[j]; t = fmaxf(t, __shfl_xor(t, 16)); t = fmaxf(t, __shfl_xor(t, 32)); mx[j] = t; }
    if (kq == 0) {
#pragma unroll
        for (int j = 0; j < 4; ++j) atomicMax(cmax + (n0 - ncol0) + 4 * c + j, __float_as_uint(mx[j])); }
}
__device__ __forceinline__ void p0_quant_item(const float* W, int K, int N, unsigned char* Wq, int out_row0, LAS unsigned char* scr, int k0, int n0, const unsigned* cmax, float* cs, int lane) {
    const int c = lane & 15, kq = lane >> 4;
    const float* src = W + (size_t)(k0 + 4 * kq) * N + n0 + 4 * c;
    f32x4 v[16];
#pragma unroll
    for (int i = 0; i < 16; ++i) v[i] = *(const GAS f32x4*)(src + (size_t)((i & 3) + 16 * (i >> 2)) * N);
    float qs[4];
#pragma unroll
    for (int j = 0; j < 4; ++j) { const float am = fmaxf(__uint_as_float(cmax[out_row0 + 4 * c + j]), 1e-30f); qs[j] = 127.0f / am; if (k0 == 0 && kq == 0) cs[out_row0 + 4 * c + j] = am * (1.0f / 127.0f); }
#pragma unroll
    for (int mb = 0; mb < 4; ++mb)
#pragma unroll
        for (int j = 0; j < 4; ++j) *(LAS unsigned*)(scr + (4 * c + j) * 68 + 16 * mb + 4 * kq) = pk4_i8(qs[j] * v[4 * mb + 0][j], qs[j] * v[4 * mb + 1][j], qs[j] * v[4 * mb + 2][j], qs[j] * v[4 * mb + 3][j]);
    LDS_WAIT(); asm volatile("" ::: "memory");
#pragma unroll
    for (int r = 0; r < 4; ++r) { const int n = (lane >> 2) + 16 * r; const LAS unsigned* p = (const LAS unsigned*)(scr + n * 68 + 16 * (lane & 3));
        v4u o; o.x = p[0]; o.y = p[1]; o.z = p[2]; o.w = p[3];
        const int orow = out_row0 + n;
        *(GAS v4u*)(Wq + ((((size_t)(orow >> 8) * (size_t)(K >> 7) + (size_t)(k0 >> 7)) * 256 + (size_t)(orow & 255)) * 128 + (size_t)(k0 & 127) + 16 * (lane & 3))) = o; }
    LDS_WAIT(); asm volatile("" ::: "memory");
}
#ifndef REGQ
#define REGQ (IN_INT8 == 2)
#endif
template <int ROWS>
__device__ __forceinline__ void q_load(Frame& F, const float* W, int N, int n0, int k0, unsigned* cmax, unsigned (&d)[ROWS / 4]) {
    constexpr int RW = ROWS / 8, NB = RW < 16 ? RW : 16;
    int lane = F.lane; asm volatile("" : "+v"(lane));
    const GAS unsigned char* src = (const GAS unsigned char*)(W + (size_t)(k0 + F.wave * RW) * N + n0);
    const unsigned lo = 16u * (unsigned)lane, rstep = 4u * (unsigned)N;
    f32x4 mx = (f32x4){0.f, 0.f, 0.f, 0.f};
#pragma unroll
    for (int ib = 0; ib < RW; ib += NB) {
        f32x4 v[NB];
#pragma unroll
        for (int i = 0; i < NB; ++i) v[i] = LD_STREAM((const GAS f32x4*)(src + (size_t)(ib + i) * rstep + lo));
#pragma unroll
        for (int i = 0; i < NB; ++i) {
            mx.x = fmaxf(mx.x, fabsf(v[i].x)); mx.y = fmaxf(mx.y, fabsf(v[i].y)); mx.z = fmaxf(mx.z, fabsf(v[i].z)); mx.w = fmaxf(mx.w, fabsf(v[i].w));
            d[2 * (ib + i)] = pk2x(v[i].x, v[i].y); d[2 * (ib + i) + 1] = pk2x(v[i].z, v[i].w); }
    }
    LAS float* red = (LAS float*)(F.lds + RING_OFF);
    *(LAS f32x4*)(red + F.wave * 256 + 4 * lane) = mx;
    __syncthreads();
    if (F.tid < 256) { float m = red[F.tid];
#pragma unroll
        for (int w = 1; w < NWAVES; ++w) m = fmaxf(m, red[w * 256 + F.tid]);
        atomicMax(cmax + F.tid, __float_as_uint(m)); }
}
template <int ROWS>
__device__ __forceinline__ void q_store(Frame& F, unsigned char* Wq, int panel, int k0, const unsigned* cmax, float* cs, const unsigned (&d)[ROWS / 4]) {
    constexpr int RW = ROWS / 8;
    int lane = F.lane; asm volatile("" : "+v"(lane));
    const v4u cm = *(const GAS v4u*)(cmax + 4 * lane);
    float qs[4]; f32x4 sc;
#pragma unroll
    for (int j = 0; j < 4; ++j) { const float am = fmaxf(__uint_as_float(cm[j]), 1e-30f); qs[j] = 127.0f / am; sc[j] = am * (1.0f / 127.0f); }
    if (k0 == 0 && F.wave == 0) *(GAS f32x4*)(cs + 4 * lane) = sc;
    const int k = k0 + F.wave * RW;
    GAS unsigned char* o = (GAS unsigned char*)Wq + (((size_t)panel * (D / 128) + (size_t)(k >> 7)) * 256 + (size_t)(4 * lane)) * 128 + (size_t)(k & 127);
#define QV(i, j) (qs[j] * (((j) & 1) ? bfhi(d[2 * (i) + ((j) >> 1)]) : bflo(d[2 * (i) + ((j) >> 1)])))
#pragma unroll
    for (int j = 0; j < 4; ++j) {
        if constexpr (RW >= 16) {
#pragma unroll
            for (int g = 0; g < RW / 16; ++g) { v4u o4;
#pragma unroll
                for (int q = 0; q < 4; ++q) o4[q] = pk4_i8(QV(16 * g + 4 * q, j), QV(16 * g + 4 * q + 1, j), QV(16 * g + 4 * q + 2, j), QV(16 * g + 4 * q + 3, j));
                *(GAS v4u*)(o + j * 128 + 16 * g) = o4; }
        } else { v2u o2; o2.x = pk4_i8(QV(0, j), QV(1, j), QV(2, j), QV(3, j)); o2.y = pk4_i8(QV(4, j), QV(5, j), QV(6, j), QV(7, j)); *(GAS v2u*)(o + j * 128) = o2; }
    }
#undef QV
}
template <int ROWS>
__device__ __forceinline__ void q_rounds(Frame& F, const Args& A, const XcdBarrier& bar, int gp0, int ngp) {
    constexpr int KB = D / ROWS, PIN = INW / 256;
    const int NT = ngp * KB;
    for (int t0 = 0; t0 < NT; t0 += F.G) {
        const int t = t0 + F.vcu; const bool act = t < NT;
        const int gp = gp0 + t / KB, k0 = (t % KB) * ROWS; const bool isin = gp < PIN; const int panel = isin ? gp : gp - PIN;
        unsigned* cmax = (unsigned*)(F.ctl + (isin ? CW_CMAXIN : CW_CMAXUP)) + 256 * panel;
        unsigned d[ROWS / 4];
        if (act) q_load<ROWS>(F, isin ? A.in[I_WIN] : A.in[I_WUP], isin ? INW : DFF, 256 * panel, k0, cmax, d);
        if (N_LAUNCHES == 1) xcd_barrier(bar);
        if (act) q_store<ROWS>(F, isin ? F.ws + WS_W8 : F.ws + WS_WUP, panel, k0, cmax, (float*)(F.ws + (isin ? WS_CSIN : WS_CSUP)) + 256 * panel, d);
    }
}
__device__ __forceinline__ void p0_quant_rounds(Frame& F, const Args& A, const XcdBarrier& bar) {
    static_assert((INW + DFF) / 256 == 116 && (!REGQ || N_LAUNCHES == 1), "panel split below; the tiles cross a grid barrier");
    __syncthreads();
    q_rounds<512>(F, A, bar, 0, 96);
    q_rounds<256>(F, A, bar, 96, 16);
    q_rounds<64>(F, A, bar, 112, 4);
}
__device__ __forceinline__ void s5_pow(double lre, double lim, double dt, int n, double& re, double& im) {
    const double mag = exp((double)n * dt * lre), ang = (double)n * dt * lim; double sn, cs; sincos(ang, &sn, &cs); re = mag * cs; im = mag * sn;
}
__device__ __forceinline__ void s5_coef(double lre, double lim, double dt, double& re, double& im) {
    double are, aim; s5_pow(lre, lim, dt, 1, are, aim); const double nr = are - 1.0, ni = aim, den = lre * lre + lim * lim;
    re = (nr * lre + ni * lim) / den; im = (ni * lre - nr * lim) / den;
}
__device__ __forceinline__ void p0_s5_item(Frame& F, const Args& A, int item) {
    const int lane = F.lane, p = lane;
    bf16* KTAB = (bf16*)(F.ws + WS_KTAB); bf16* BMAT = (bf16*)(F.ws + WS_BMAT); bf16* CMAT = (bf16*)(F.ws + WS_CMAT); float* AT = (float*)(F.ws + WS_AT);
    const int kind = item >> 11, r = item & 2047, g = (kind < 3) ? (r >> 5) : r, n = r & 31;
    const double lre = (double)A.in[I_LRE][g * SP + p], lim = (double)A.in[I_LIM][g * SP + p], dt = exp((double)A.in[I_LOGDT][g]);
    if (kind == 3) { double re, im; s5_pow(lre, lim, dt, TC, re, im); AT[(g * SP + p) * 2] = (float)re; AT[(g * SP + p) * 2 + 1] = (float)im; return; }
    if (kind == 2) {
        double wr, wi; s5_pow(lre, lim, dt, n + 1, wr, wi); const float wrf = (float)wr, wif = (float)wi;
#pragma unroll
        for (int h = 0; h < SGD; ++h) { const float cr = A.in[I_CRE][(g * SGD + h) * SP + p], ci = A.in[I_CIM][(g * SGD + h) * SP + p];
            bf16* row = CMAT + ((size_t)g * 512 + n * 16 + h) * 128;
            row[p] = (bf16)(pk2x(cr * wrf - ci * wif, 0.f) & 0xffffu); row[64 + p] = (bf16)(pk2x(-(cr * wif + ci * wrf), 0.f) & 0xffffu); }
        return;
    }
    double cre, cim; s5_coef(lre, lim, dt, cre, cim);
    if (kind == 1) {
        double ar, ai; s5_pow(lre, lim, dt, TC - 1 - n, ar, ai); const float wr = (float)(ar * cre - ai * cim), wi = (float)(ar * cim + ai * cre);
        float vr[16], vi[16];
#pragma unroll
        for (int h = 0; h < SGD; ++h) { const float br = A.in[I_BRE][(g * SP + p) * SGD + h], bi = A.in[I_BIM][(g * SP + p) * SGD + h]; vr[h] = wr * br - wi * bi; vi[h] = wr * bi + wi * br; }
        v4u o; bf16* rr = BMAT + ((size_t)g * 128 + p) * 512 + n * 16; bf16* ri = BMAT + ((size_t)g * 128 + 64 + p) * 512 + n * 16;
        o.x = pk2x(vr[0], vr[1]); o.y = pk2x(vr[2], vr[3]); o.z = pk2x(vr[4], vr[5]); o.w = pk2x(vr[6], vr[7]); *(v4u*)rr = o;
        o.x = pk2x(vr[8], vr[9]); o.y = pk2x(vr[10], vr[11]); o.z = pk2x(vr[12], vr[13]); o.w = pk2x(vr[14], vr[15]); *(v4u*)(rr + 8) = o;
        o.x = pk2x(vi[0], vi[1]); o.y = pk2x(vi[2], vi[3]); o.z = pk2x(vi[4], vi[5]); o.w = pk2x(vi[6], vi[7]); *(v4u*)ri = o;
        o.x = pk2x(vi[8], vi[9]); o.y = pk2x(vi[10], vi[11]); o.z = pk2x(vi[12], vi[13]); o.w = pk2x(vi[14], vi[15]); *(v4u*)(ri + 8) = o;
        return;
    }
    double ar, ai; s5_pow(lre, lim, dt, n, ar, ai); const float wr = (float)(ar * cre - ai * cim), wi = (float)(ar * cim + ai * cre);
    float vr[16], vi[16];
#pragma unroll
    for (int h = 0; h < SGD; ++h) { const float br = A.in[I_BRE][(g * SP + p) * SGD + h], bi = A.in[I_BIM][(g * SP + p) * SGD + h]; vr[h] = wr * br - wi * bi; vi[h] = wr * bi + wi * br; }
    float crs[16], cis[16];
#pragma unroll
    for (int h = 0; h < SGD; ++h) { crs[h] = A.in[I_CRE][(g * SGD + h) * SP + p]; cis[h] = A.in[I_CIM][(g * SGD + h) * SP + p]; }
    __builtin_amdgcn_sched_barrier(0);
#pragma unroll
    for (int h = 0; h < SGD; ++h) { const float cr = crs[h], ci = cis[h];
        float t8[8], t4[4], t2[2], mine;
#pragma unroll
        for (int i = 0; i < 8; ++i) { const float a = cr * vr[2 * i] - ci * vi[2 * i], b = cr * vr[2 * i + 1] - ci * vi[2 * i + 1]; const bool up = lane & 1; t8[i] = (up ? b : a) + __shfl_xor(up ? a : b, 1); }
#pragma unroll
        for (int i = 0; i < 4; ++i) { const bool up = lane & 2; t4[i] = (up ? t8[2 * i + 1] : t8[2 * i]) + __shfl_xor(up ? t8[2 * i] : t8[2 * i + 1], 2); }
#pragma unroll
        for (int i = 0; i < 2; ++i) { const bool up = lane & 4; t2[i] = (up ? t4[2 * i + 1] : t4[2 * i]) + __shfl_xor(up ? t4[2 * i] : t4[2 * i + 1], 4); }
        { const bool up = lane & 8; mine = (up ? t2[1] : t2[0]) + __shfl_xor(up ? t2[0] : t2[1], 8); }
        mine += __shfl_xor(mine, 16); mine += __shfl_xor(mine, 32);
        if (lane < SGD) { if (n == 0 && lane == h) mine += A.in[I_DSKIP][g * SGD + h]; KTAB[(((size_t)g * TC + n) * SGD + h) * SGD + lane] = (bf16)(pk2x(mine, 0.f) & 0xffffu); } }
}
__device__ __forceinline__ void p0_prologue(Frame& F, const Args& A) {
    LAS unsigned char* scr = F.lds + RING_OFF + F.wave * 16384;
#ifndef P0_S5WAVE
#define P0_S5WAVE 0
#endif
    constexpr int NSW = P0_S5WAVE ? NWAVES - 1 : NWAVES;
    if (P0_S5WAVE && F.wave == NWAVES - 1) { for (int it = F.vcu; it < 3 * 2048 + SG; it += F.G) p0_s5_item(F, A, it); return; }
    const int gw = F.vcu * NSW + F.wave, NGW = F.G * NSW;
    if (!P0_S5WAVE) for (int it = gw; it < 3 * 2048 + SG; it += NGW) p0_s5_item(F, A, it);
    { bf16* Hh = (bf16*)(F.ws + WS_ARB); float* RS1 = (float*)(F.ws + WS_RS1);
      for (int m = gw; m < M; m += NGW) rms_row_to_bf16(A.in[I_X] + (size_t)m * D, A.in[I_NMIXPRE], Hh + (size_t)m * D, F.ws + WS_H8, m, RS1 + m, F.lane); }
    constexpr int I_1 = (D / 64) * (N16 / 64), I_2 = (AW / 64) * (D / 64), I_3 = (BW / 64) * (D / 64), I_4 = I_3, I_5 = (D / 64) * (D / 64), I_7 = (DFF / 64) * (D / 64);
    constexpr int NITEMS = I_1 + I_2 + I_3 + I_4 + I_5 + I_7;
    for (int it = gw; it < NITEMS; it += NGW) {
        int r = it;
        if (r < I_1) { const int nblk = N16 > 0 ? N16 / 64 : 1, kb = r / nblk, nb = r % nblk; p0_transpose_item(A.in[I_WIN], D, INW, (bf16*)(F.ws + WS_WIN), 64 * nb, scr, 64 * kb, win_col16(64 * nb), F.lane); continue; } r -= I_1;
        if (r < I_2) { const int nblk = D / 64, kb = r / nblk, nb = r % nblk; p0_transpose_item(A.in[I_WPROJ], AW, D, (bf16*)(F.ws + WS_WPROJ), 64 * nb, scr, 64 * kb, 64 * nb, F.lane); continue; } r -= I_2;
        if (r < I_3) { const int nblk = D / 64, kb = r / nblk, nb = r % nblk, n0 = 64 * nb; p0_transpose_item(A.in[I_WGLUA], BW, D, (bf16*)(F.ws + WS_WGLU), (n0 >> 7) * 256 + (n0 & 127), scr, 64 * kb, n0, F.lane); continue; } r -= I_3;
        if (r < I_4) { const int nblk = D / 64, kb = r / nblk, nb = r % nblk, n0 = 64 * nb; p0_transpose_item(A.in[I_WGLUB], BW, D, (bf16*)(F.ws + WS_WGLU), (n0 >> 7) * 256 + 128 + (n0 & 127), scr, 64 * kb, n0, F.lane); continue; } r -= I_4;
        if (r < I_5) { const int nblk = D / 64, kb = r / nblk, nb = r % nblk; p0_transpose_item(A.in[I_WOUT], D, D, (bf16*)(F.ws + WS_WOUT), 64 * nb, scr, 64 * kb, 64 * nb, F.lane); continue; } r -= I_5;
        { const int nblk = D / 64, kb = r / nblk, nb = r % nblk; p0_transpose_item(A.in[I_WDN], DFF, D, (bf16*)(F.ws + WS_WDN), 64 * nb, scr, 64 * kb, 64 * nb, F.lane); }
    }
    if (!REGQ) { unsigned* CMI = (unsigned*)(F.ctl + CW_CMAXIN); unsigned* CMU = (unsigned*)(F.ctl + CW_CMAXUP);
      constexpr int C_1 = (NG8 / 64) * (D / 512), C_2 = (DFF / 64) * (D / 512);
      for (int it = gw; it < C_1 + C_2; it += NGW) {
          if (it < C_1) { const int nb = it % (NG8 / 64), kb = it / (NG8 / 64), n0 = win_col8(64 * nb); p0_colmax_item(A.in[I_WIN], INW, CMI, 512 * kb, n0, n0 - 64 * nb, F.lane); }
          else { const int r = it - C_1, nb = r % (DFF / 64), kb = r / (DFF / 64); p0_colmax_item(A.in[I_WUP], DFF, CMU, 512 * kb, 64 * nb, 0, F.lane); } } }
}
__device__ __forceinline__ void p0_quantize(Frame& F, const Args& A) {
    LAS unsigned char* scr = F.lds + RING_OFF + F.wave * 16384;
    const int gw = F.vcu * NWAVES + F.wave, NGW = F.G * NWAVES;
    const unsigned* CMI = (const unsigned*)(F.ctl + CW_CMAXIN); const unsigned* CMU = (const unsigned*)(F.ctl + CW_CMAXUP);
    constexpr int Q_1 = (D / 128) * (NG8 / 64), Q_2 = (D / 128) * (DFF / 64);
    for (int it0 = gw; it0 < Q_1 + Q_2; it0 += NGW) { const int it = Q_1 + Q_2 - 1 - it0;
        if (it < Q_1) { const int nblk = NG8 / 64, kb2 = it / nblk, nb = it % nblk;
            p0_quant_item(A.in[I_WIN], D, INW, F.ws + WS_W8, 64 * nb, scr, 128 * kb2, win_col8(64 * nb), CMI, (float*)(F.ws + WS_CSIN), F.lane);
            p0_quant_item(A.in[I_WIN], D, INW, F.ws + WS_W8, 64 * nb, scr, 128 * kb2 + 64, win_col8(64 * nb), CMI, (float*)(F.ws + WS_CSIN), F.lane); }
        else { const int r = it - Q_1, nblk = DFF / 64, kb2 = r / nblk, nb = r % nblk;
            p0_quant_item(A.in[I_WUP], D, DFF, F.ws + WS_WUP, 64 * nb, scr, 128 * kb2, 64 * nb, CMU, (float*)(F.ws + WS_CSUP), F.lane);
            p0_quant_item(A.in[I_WUP], D, DFF, F.ws + WS_WUP, 64 * nb, scr, 128 * kb2 + 64, 64 * nb, CMU, (float*)(F.ws + WS_CSUP), F.lane); }
    }
}

constexpr int SPG_VNT_STRIDE = 136, SPG_BUF_BYTES = 128 * SPG_VNT_STRIDE * 2;
constexpr int DUMP_OFF = RING_BYTES - 2048;
__device__ __forceinline__ void l2_touch(Frame& F, const void* p) { __builtin_amdgcn_global_load_lds((const unsigned*)p, (LAS unsigned*)(F.lds + DUMP_OFF + F.wave * 256), 4, 0, 0); }
#ifndef SPG_H0
#define SPG_H0 9
#endif
__device__ __forceinline__ void spatial_unit(Frame& F, const Args& A, int unit) {
    const int c = unit >> 1, hh = unit & 1, lane = F.lane, w = F.wave, h0 = hh ? SPG_H0 : 0, nheads = hh ? AH - SPG_H0 : SPG_H0;
    const bf16* UA = (const bf16*)(F.ws + WS_UA); const bf16* VA = (const bf16*)(F.ws + WS_VA); bf16* SA = (bf16*)(F.ws + WS_ARB);
    const float* VST = (const float*)(F.ws + WS_PART);
    const size_t tok0 = (size_t)c * ACH;
    const int fr = lane & 15, fq = lane >> 4, trow = 16 * w + fr;
    const int sfill = 64 * (w & 1) + lane, c8b = 4 * (w >> 1);
    float mean, rstd;
    { const GAS f32x4* p = (const GAS f32x4*)(VST + (tok0 + sfill) * 64); float s1 = 0.f, s2 = 0.f;
#pragma unroll
      for (int j = 0; j < 16; ++j) { const f32x4 t = p[j]; s1 += t.x + t.z; s2 += t.y + t.w; }
      mean = s1 * (1.f / AW); const float var = fmaxf(s2 * (1.f / AW) - mean * mean, 0.f); rstd = 1.0f / sqrtf(var + NORM_EPS); }
    const bf16* vsrc = TILED_A ? VA + ((size_t)c * 16 * 128 + sfill) * 128 + 8 * c8b : VA + (tok0 + sfill) * AW + 8 * c8b; const size_t hstr = TILED_A ? (size_t)128 * 128 : (size_t)AHD;
    LAS float* gl = (LAS float*)(F.lds + 2 * SPG_BUF_BYTES); LAS float* bl = gl + 9 * AHD;
    if (F.tid < nheads * (AHD / 4)) { const f32x4 gv = ((const GAS f32x4*)(A.in[I_VNG] + h0 * AHD))[F.tid], bv = ((const GAS f32x4*)(A.in[I_VNB] + h0 * AHD))[F.tid]; ((LAS f32x4*)gl)[F.tid] = gv; ((LAS f32x4*)bl)[F.tid] = bv; }
    const int nks = (w + 2) >> 1;
    v4u vreg[4]; f32x4 wv[4][2]; v2u uu[8]; float bsp;
#define SPG_FETCH(hh_) do { const int hq = (hh_); \
        _Pragma("unroll") for (int i = 0; i < 4; ++i) vreg[i] = LD_STREAM((const GAS v4u*)(vsrc + hq * hstr + 8 * i)); \
        const float* Wrow = A.in[I_WSP] + ((size_t)hq * ACH + trow) * ACH + 8 * fq; \
        _Pragma("unroll") for (int ks = 0; ks < 4; ++ks) if (ks < nks) { wv[ks][0] = *(const GAS f32x4*)(Wrow + 32 * ks); wv[ks][1] = *(const GAS f32x4*)(Wrow + 32 * ks + 4); } \
        const bf16* urow = TILED_A ? UA + (((size_t)c * 16 + hq) * 128 + trow) * 128 + 4 * fq : UA + (tok0 + trow) * AW + hq * AHD + 4 * fq; \
        _Pragma("unroll") for (int n = 0; n < 8; ++n) uu[n] = LD_STREAM((const GAS v2u*)(urow + 16 * n)); \
        bsp = A.in[I_BSP][hq * ACH + trow]; } while (0)
    SPG_FETCH(h0);
    __syncthreads();
#pragma unroll 1
    for (int hi = 0; hi < nheads; ++hi) { const int h = h0 + hi;
        LAS bf16* vnT = (LAS bf16*)(F.lds + (hi & 1) * SPG_BUF_BYTES);
#pragma unroll
        for (int i = 0; i < 4; ++i) { const int c8 = c8b + i; const v4u x = vreg[i];
            const float e[8] = {bflo(x.x), bfhi(x.x), bflo(x.y), bfhi(x.y), bflo(x.z), bfhi(x.z), bflo(x.w), bfhi(x.w)};
            const f32x4 g0 = *(const LAS f32x4*)(gl + hi * AHD + 8 * c8), g1 = *(const LAS f32x4*)(gl + hi * AHD + 8 * c8 + 4), b0 = *(const LAS f32x4*)(bl + hi * AHD + 8 * c8), b1 = *(const LAS f32x4*)(bl + hi * AHD + 8 * c8 + 4);
            const float gg[8] = {g0.x, g0.y, g0.z, g0.w, g1.x, g1.y, g1.z, g1.w}, bb[8] = {b0.x, b0.y, b0.z, b0.w, b1.x, b1.y, b1.z, b1.w};
#pragma unroll
            for (int j = 0; j < 8; ++j) { const float y = (e[j] - mean) * rstd * gg[j] + bb[j]; vnT[(8 * c8 + j) * SPG_VNT_STRIDE + sfill] = (bf16)(pk2x(y, 0.f) & 0xffffu); } }
        v4u wb[4];
#pragma unroll
        for (int ks = 0; ks < 4; ++ks) if (ks < nks) { const int s0 = 32 * ks + 8 * fq;
            float wvv[8] = {wv[ks][0].x, wv[ks][0].y, wv[ks][0].z, wv[ks][0].w, wv[ks][1].x, wv[ks][1].y, wv[ks][1].z, wv[ks][1].w};
#pragma unroll
            for (int j = 0; j < 8; ++j) wvv[j] = (s0 + j <= trow) ? wvv[j] : 0.f;
            wb[ks].x = pk2x(wvv[0], wvv[1]); wb[ks].y = pk2x(wvv[2], wvv[3]); wb[ks].z = pk2x(wvv[4], wvv[5]); wb[ks].w = pk2x(wvv[6], wvv[7]); }
        v2u uc[8];
#pragma unroll
        for (int n = 0; n < 8; ++n) uc[n] = uu[n];
        const float bc = bsp; const int srow_t = (int)(tok0 + trow), scol = h * AHD + 4 * fq;
        __builtin_amdgcn_sched_barrier(0);
        if (hi + 1 < nheads) SPG_FETCH(h + 1);
        __syncthreads();
        f32x4 acc[8];
#pragma unroll
        for (int n = 0; n < 8; ++n) acc[n] = (f32x4){0.f, 0.f, 0.f, 0.f};
#pragma unroll
        for (int ks = 0; ks < 4; ++ks) if (ks < nks) { const int s0 = 32 * ks + 8 * fq; const bf16x8 bfrag = __builtin_bit_cast(bf16x8, wb[ks]);
#pragma unroll
            for (int n = 0; n < 8; ++n) { const bf16x8 afrag = *(const LAS bf16x8*)(vnT + (16 * n + fr) * SPG_VNT_STRIDE + s0);
                acc[n] = __builtin_amdgcn_mfma_f32_16x16x32_bf16(afrag, bfrag, acc[n], 0, 0, 0); } }
#pragma unroll
        for (int n = 0; n < 8; ++n) { const v2u u2 = uc[n]; v2u o;
            o.x = pk2x(bflo(u2.x) * (acc[n][0] + bc), bfhi(u2.x) * (acc[n][1] + bc)); o.y = pk2x(bflo(u2.y) * (acc[n][2] + bc), bfhi(u2.y) * (acc[n][3] + bc)); *(GAS v2u*)(SA + tile16_off(srow_t, scol + 16 * n, AW)) = o; }
    }
#undef SPG_FETCH
    __syncthreads();
}

constexpr int S5_KT_OFF = 0;
constexpr int S5_E_OFF = 17408;
constexpr int S5_S_OFF = S5_E_OFF + 128 * 65 * 4;
constexpr int S5_S_STRIDE = 136;
static_assert(S5_S_OFF + 128 * S5_S_STRIDE * 2 <= RING_BYTES - 2048, "S5 LDS");
#ifndef S5_PF
#define S5_PF 1
#endif
#ifndef S5_SB3
#define S5_SB3 0
#endif
__device__ __forceinline__ void s5_unit(Frame& F, int unit, int part = 3) {
    const int q = unit & 1, g = (unit >> 1) & 63, b = unit >> 7, tid = F.tid, lane = F.lane, w = F.wave, fr = lane & 15, fq = lane >> 4;
    const bf16* KTAB = (const bf16*)(F.ws + WS_KTAB) + (size_t)g * TC * 256; const bf16* BMAT = (const bf16*)(F.ws + WS_BMAT) + (size_t)g * 128 * 512;
    const bf16* CMAT = (const bf16*)(F.ws + WS_CMAT) + (size_t)g * 512 * 128; const float* AT = (const float*)(F.ws + WS_AT) + g * SP * 2;
    const bf16* XB = (const bf16*)(F.ws + WS_XB2) + ((size_t)g * NCH + (size_t)b * NCHB) * 512;
    bf16* ZB = (bf16*)(F.ws + WS_ZB);
    LAS unsigned char* kt = F.lds + S5_KT_OFF; LAS float* Eb = (LAS float*)(F.lds + S5_E_OFF); LAS bf16* Sb = (LAS bf16*)(F.lds + S5_S_OFF);
    if (S5_PF && (part & 1)) { l2_touch(F, (const unsigned char*)XB + (size_t)tid * 128); l2_touch(F, (const unsigned char*)XB + 65536 + (size_t)tid * 128); }
    if (tid < 32) *(LAS v4u*)(kt + tid * 16) = (v4u){0u, 0u, 0u, 0u};
#pragma unroll
    for (int i = 0; i < 2; ++i) { const int pc = tid + 512 * i; *(LAS v4u*)(kt + 512 + pc * 16) = *(const GAS v4u*)(KTAB + pc * 8); }
    if (part & 1) {
        bf16x8 af[16];
#pragma unroll
        for (int kk = 0; kk < 16; ++kk) af[kk] = *(const GAS bf16x8*)(BMAT + (size_t)(16 * w + fr) * 512 + 32 * kk + 8 * fq);
        float sre = 0.f, sim = 0.f; const float are = AT[2 * lane], aim = AT[2 * lane + 1];
        const int nblk = 2 * (q + 1);
        for (int blk = 0; blk < nblk; ++blk) {
#pragma unroll 1
            for (int nt = 0; nt < 4; ++nt) { const bf16* xr = XB + (size_t)(64 * blk + 16 * nt + fr) * 512 + 8 * fq; f32x4 acc = (f32x4){0.f, 0.f, 0.f, 0.f};
                { bf16x8 bfr[16];
#pragma unroll
                    for (int kk = 0; kk < 16; ++kk) bfr[kk] = *(const GAS bf16x8*)(xr + 32 * kk);
                    __builtin_amdgcn_sched_barrier(0);
#pragma unroll
                    for (int kk = 0; kk < 16; ++kk) acc = __builtin_amdgcn_mfma_f32_16x16x32_bf16(af[kk], bfr[kk], acc, 0, 0, 0); }
#pragma unroll
                for (int r = 0; r < 4; ++r) Eb[(16 * w + 4 * fq + r) * 65 + 16 * nt + fr] = acc[r]; }
            if (S5_PF && blk + 2 < nblk) l2_touch(F, (const unsigned char*)XB + (size_t)(blk + 2) * 65536 + (size_t)tid * 128);
            __syncthreads();
            if (w == 0) {
                const bool wr_s = 64 * blk >= 128 * q;
#pragma unroll 1
                for (int j0 = 0; j0 < 64; j0 += 16) { float er[16], ei[16];
#pragma unroll
                    for (int i = 0; i < 16; ++i) { er[i] = Eb[lane * 65 + j0 + i]; ei[i] = Eb[(64 + lane) * 65 + j0 + i]; }
                    LAS bf16* sp = Sb + (64 * blk + j0 - 128 * q) * S5_S_STRIDE + lane;
#pragma unroll
                    for (int i = 0; i < 16; ++i) {
                        if (wr_s) { sp[i * S5_S_STRIDE] = (bf16)(pk2x(sre, 0.f) & 0xffffu); sp[i * S5_S_STRIDE + 64] = (bf16)(pk2x(sim, 0.f) & 0xffffu); }
                        const float nr = are * sre - aim * sim + er[i], ni = are * sim + aim * sre + ei[i]; sre = nr; sim = ni; } }
            }
            __syncthreads();
        }
    }
#ifndef S5_V3
#define S5_V3 1
#endif
#if S5_V3
    if (part & 2) {
        const bf16* xr = XB + (size_t)(128 * q + 16 * w + fr) * 512 + 8 * fq;
        bf16x8 bf[16], sf[4], cfa[4], cfb[4];
#pragma unroll
        for (int kk = 0; kk < 16; ++kk) bf[kk] = *(const GAS bf16x8*)(xr + 32 * kk);
        const bf16* cmp = CMAT + (size_t)fr * 128 + 8 * fq;
#pragma unroll
        for (int kk = 0; kk < 4; ++kk) cfa[kk] = *(const GAS bf16x8*)(cmp + 32 * kk);
#pragma unroll
        for (int kk = 0; kk < 4; ++kk) sf[kk] = *(const LAS bf16x8*)(Sb + (16 * w + fr) * S5_S_STRIDE + 32 * kk + 8 * fq);
        const int ktl = 512 - (lane >> 5) * 512 + fr * 32 + (fq & 1) * 16;
        const size_t tok0 = (size_t)b * SEQ + (size_t)(128 * q + 16 * w + fr) * TC;
#pragma unroll
        for (int mt = 0; mt < 32; ++mt) {
            if (mt + 1 < 32) {
#pragma unroll
                for (int kk = 0; kk < 4; ++kk) cfb[kk] = *(const GAS bf16x8*)(cmp + (size_t)(16 * (mt + 1)) * 128 + 32 * kk); }
            f32x4 acc = (f32x4){0.f, 0.f, 0.f, 0.f};
#pragma unroll
            for (int kk = 0; kk <= mt / 2; ++kk) { const bf16x8 afrag = *(const LAS bf16x8*)(kt + ktl + (mt - 2 * kk) * 512); acc = __builtin_amdgcn_mfma_f32_16x16x32_bf16(afrag, bf[kk], acc, 0, 0, 0); }
#pragma unroll
            for (int kk = 0; kk < 4; ++kk) acc = __builtin_amdgcn_mfma_f32_16x16x32_bf16(cfa[kk], sf[kk], acc, 0, 0, 0);
            v2u o; o.x = pk2x(gelu_t(acc[0]), gelu_t(acc[1])); o.y = pk2x(gelu_t(acc[2]), gelu_t(acc[3]));
            *(GAS v2u*)(ZB + tile16_off((int)(tok0 + mt), g * SGD + 4 * fq, BW)) = o;
#pragma unroll
            for (int kk = 0; kk < 4; ++kk) cfa[kk] = cfb[kk];
        }
    }
#else
    const int mts[4] = {w, 15 - w, 16 + w, 31 - w};
    bf16x8 cf[4][4];
#pragma unroll
    for (int i = 0; i < 4; ++i)
#pragma unroll
        for (int kk = 0; kk < 4; ++kk) cf[i][kk] = *(const GAS bf16x8*)(CMAT + (size_t)(16 * mts[i] + fr) * 128 + 32 * kk + 8 * fq);
    const int ktl = 512 - (lane >> 5) * 512 + fr * 32 + (fq & 1) * 16;
#pragma unroll 1
    for (int nt = 0; nt < ((part & 2) ? 8 : 0); ++nt) {
        const bf16* xr = XB + (size_t)(128 * q + 16 * nt + fr) * 512 + 8 * fq;
        f32x4 acc[4];
#pragma unroll
        for (int i = 0; i < 4; ++i) acc[i] = (f32x4){0.f, 0.f, 0.f, 0.f};
        { bf16x8 bf[16];
#pragma unroll
            for (int kk = 0; kk < 16; ++kk) bf[kk] = *(const GAS bf16x8*)(xr + 32 * kk);
#if S5_SB3
            __builtin_amdgcn_sched_barrier(0);
#endif
#pragma unroll
            for (int kk = 0; kk < 16; ++kk) {
#pragma unroll
                for (int i = 0; i < 4; ++i) { const int d0 = mts[i] - 2 * kk;
                    if (d0 >= 0) { const bf16x8 afrag = *(const LAS bf16x8*)(kt + ktl + d0 * 512); acc[i] = __builtin_amdgcn_mfma_f32_16x16x32_bf16(afrag, bf[kk], acc[i], 0, 0, 0); } }
                asm volatile("" ::: "memory"); } }
#pragma unroll
        for (int kk = 0; kk < 4; ++kk) { const bf16x8 sfrag = *(const LAS bf16x8*)(Sb + (16 * nt + fr) * S5_S_STRIDE + 32 * kk + 8 * fq);
#pragma unroll
            for (int i = 0; i < 4; ++i) acc[i] = __builtin_amdgcn_mfma_f32_16x16x32_bf16(cf[i][kk], sfrag, acc[i], 0, 0, 0); }
#pragma unroll
        for (int i = 0; i < 4; ++i) { const size_t tok = (size_t)b * SEQ + (size_t)(128 * q + 16 * nt + fr) * TC + mts[i];
            v2u o; o.x = pk2x(gelu_t(acc[i][0]), gelu_t(acc[i][1])); o.y = pk2x(gelu_t(acc[i][2]), gelu_t(acc[i][3]));
            *(GAS v2u*)(ZB + tile16_off((int)tok, g * SGD + 4 * fq, BW)) = o; }
    }
#endif
    __syncthreads();
}

#ifndef X1_BF16
#define X1_BF16 1
#endif
__device__ __forceinline__ void n1_load(Frame& F, const Args& A, int m, f32x4 (&xv)[16], float& pv) {
    const int lane = F.lane; const GAS f32x4* xr = (const GAS f32x4*)(A.in[I_X] + (size_t)m * D) + lane;
    pv = ((const float*)(F.ws + WS_PART) + (size_t)m * 64)[lane];
#pragma unroll
    for (int j = 0; j < 16; ++j) xv[j] = LD_STREAM(xr + 64 * j);
}
__device__ __forceinline__ void n1_mix(Frame& F, int m, v2u (&mv)[16]) {
    const int lane = F.lane;
    const GAS bf16* mixp = (const GAS bf16*)((const bf16*)(F.ws + WS_ARB) + mix_off(m, 4 * lane)); const size_t mstep = mix_off(0, 256);
#pragma unroll
    for (int j = 0; j < 16; ++j) { mv[j] = LD_STREAM((const GAS v2u*)mixp); mixp += mstep; }
}
__device__ __forceinline__ void n1_proc(Frame& F, const Args& A, int m, f32x4 (&v)[16], v2u (&mv)[16], float pv) {
    const int lane = F.lane; const float rstd1 = 1.0f / sqrtf(wave_sum(pv) * (1.f / D) + NORM_EPS);
    const LAS f32x4* g1 = (const LAS f32x4*)(F.lds + RING_OFF) + lane; const LAS f32x4* g2 = (const LAS f32x4*)(F.lds + RING_OFF + D * 4) + lane;
    GAS f32x4* orow = (GAS f32x4*)(F.out + (size_t)m * D) + lane; GAS v2u* x1row = (GAS v2u*)(F.out + (size_t)m * D + D / 2) + lane;
    float s = 0.f;
#pragma unroll
    for (int j = 0; j < 16; ++j) { const f32x4 gg = g1[64 * j]; const v2u mm = mv[j];
        v[j].x += bflo(mm.x) * rstd1 * gg.x; v[j].y += bfhi(mm.x) * rstd1 * gg.y; v[j].z += bflo(mm.y) * rstd1 * gg.z; v[j].w += bfhi(mm.y) * rstd1 * gg.w;
        s += (v[j].x * v[j].x + v[j].y * v[j].y) + (v[j].z * v[j].z + v[j].w * v[j].w);
        if (X1_BF16) { v2u o; o.x = pk2x(v[j].x, v[j].y); o.y = pk2x(v[j].z, v[j].w); ST_STREAM(x1row + 64 * j, o); } else orow[64 * j] = v[j];
        asm volatile("" ::: "memory"); }
    const float rstd2 = 1.0f / sqrtf(wave_sum(s) * (1.f / D) + NORM_EPS);
    float am = 0.f;
#pragma unroll
    for (int j = 0; j < 16; ++j) { const f32x4 gg = g2[64 * j]; v[j].x *= rstd2 * gg.x; v[j].y *= rstd2 * gg.y; v[j].z *= rstd2 * gg.z; v[j].w *= rstd2 * gg.w;
        am = fmaxf(fmaxf(am, fmaxf(fabsf(v[j].x), fabsf(v[j].y))), fmaxf(fabsf(v[j].z), fabsf(v[j].w))); asm volatile("" ::: "memory"); }
    am = fmaxf(wave_max(am), 1e-30f); const float qs = 127.0f / am;
    if (lane == 0) ((float*)(F.ws + WS_RS2))[m] = am * (1.0f / 127.0f);
    GAS unsigned char* q8 = (GAS unsigned char*)(F.ws + WS_H2Q + tile8_off(m, 4 * lane, D)); const size_t qstep = tile8_off(0, 256, D);
#pragma unroll
    for (int j = 0; j < 16; ++j) { *(GAS unsigned*)q8 = pk4_i8(v[j].x * qs, v[j].y * qs, v[j].z * qs, v[j].w * qs); q8 += qstep; }
}
__device__ __forceinline__ void n1_phase(Frame& F, const Args& A) {
    const int gw = F.vcu * NWAVES + F.wave, NGW = F.G * NWAVES;
    for (int i = F.tid; i < D / 4; i += NWAVES * 64) { ((LAS f32x4*)(F.lds + RING_OFF))[i] = ((const GAS f32x4*)A.in[I_NMIXPOST])[i]; ((LAS f32x4*)(F.lds + RING_OFF + D * 4))[i] = ((const GAS f32x4*)A.in[I_NMLPPRE])[i]; }
    __syncthreads();
    f32x4 xa[16], xb[16]; v2u mv[16]; float pa = 0.f, pb = 0.f;
    if (gw < M) n1_load(F, A, gw, xa, pa);
    for (int m = gw; m < M; m += 2 * NGW) {
        const int m1 = m + NGW < M ? m + NGW : m, m2 = m + 2 * NGW < M ? m + 2 * NGW : m1;
        n1_mix(F, m, mv);
        n1_load(F, A, m1, xb, pb);
        n1_proc(F, A, m, xa, mv, pa);
        if (m + NGW < M) {
            n1_mix(F, m1, mv);
            n1_load(F, A, m2, xa, pa);
            n1_proc(F, A, m1, xb, mv, pb); }
    }
}
#if X1_BF16
typedef v2u x1v_t;
#else
typedef f32x4 x1v_t;
#endif
#ifndef ROWS_BATCH
#define ROWS_BATCH 1
#endif
__device__ __forceinline__ void n2_load(Frame& F, int m, x1v_t (&xv)[16], v2u (&fv)[16], float& pv) {
    const int lane = F.lane; const GAS x1v_t* xr = (const GAS x1v_t*)(F.out + (size_t)m * D + (X1_BF16 ? D / 2 : 0)) + lane;
    pv = ((const float*)(F.ws + WS_PART) + (size_t)m * 64)[lane];
#pragma unroll
    for (int j = 0; j < 16; ++j) xv[j] = LD_STREAM(xr + 64 * j);
    const GAS bf16* ffp = (const GAS bf16*)((const bf16*)(F.ws + WS_ARB) + mix_off(m, 4 * lane)); const size_t fstep = mix_off(0, 256);
#pragma unroll
    for (int j = 0; j < 16; ++j) { fv[j] = LD_STREAM((const GAS v2u*)ffp); ffp += fstep; }
}
__device__ __forceinline__ void n2_proc(Frame& F, const Args& A, int m, x1v_t (&v)[16], v2u (&fv)[16], float pv) {
    const int lane = F.lane; const float rstd = 1.0f / sqrtf(wave_sum(pv) * (1.f / D) + NORM_EPS);
    const LAS f32x4* g1 = (const LAS f32x4*)(F.lds + RING_OFF) + lane; GAS f32x4* orow = (GAS f32x4*)(F.out + (size_t)m * D) + lane;
#pragma unroll
    for (int j = 0; j < 16; ++j) { const f32x4 gg = g1[64 * j]; const v2u mm = fv[j]; f32x4 x;
#if X1_BF16
        x.x = bflo(v[j].x); x.y = bfhi(v[j].x); x.z = bflo(v[j].y); x.w = bfhi(v[j].y);
#else
        x = v[j];
#endif
        x.x += bflo(mm.x) * rstd * gg.x; x.y += bfhi(mm.x) * rstd * gg.y; x.z += bflo(mm.y) * rstd * gg.z; x.w += bfhi(mm.y) * rstd * gg.w; ST_STREAM(orow + 64 * j, x); }
}
__device__ __forceinline__ void n2_phase(Frame& F, const Args& A) {
    const int gw = F.vcu * NWAVES + F.wave, NGW = F.G * NWAVES;
    for (int i = F.tid; i < D / 4; i += NWAVES * 64) ((LAS f32x4*)(F.lds + RING_OFF))[i] = ((const GAS f32x4*)A.in[I_NMLPPOST])[i];
    __syncthreads();
    x1v_t xa[16], xb[16]; v2u fa[16], fb[16]; float pa = 0.f, pb = 0.f;
    if (gw < M) n2_load(F, gw, xa, fa, pa);
    for (int m = gw; m < M; m += 2 * NGW) {
        const int m1 = m + NGW < M ? m + NGW : m, m2 = m + 2 * NGW < M ? m + 2 * NGW : m1;
        n2_load(F, m1, xb, fb, pb);
        n2_proc(F, A, m, xa, fa, pa);
        if (m + NGW < M) {
            n2_load(F, m2, xa, fa, pa);
            n2_proc(F, A, m1, xb, fb, pb); }
    }
}

__global__ void __launch_bounds__(NWAVES * 64, 2) mk_fwd(Args args) {
    extern __shared__ __attribute__((aligned(16))) unsigned char lds[];
    Frame F;
    F.lds = (LAS unsigned char*)lds;
    F.MISC = (volatile LAS unsigned*)(F.lds + MISC_OFF);
    F.tid = threadIdx.x; F.lane = F.tid & 63; F.wave = __builtin_amdgcn_readfirstlane(F.tid >> 6);
    F.G = gridDim.x; { const int bx = blockIdx.x; F.vcu = (F.G % 8 == 0) ? (bx % 8) * (F.G / 8) + bx / 8 : bx; }
    F.ws = args.ws; F.out = args.out;
    F.ctl = (gu32*)(F.ws + WS_CTL);
    for (int u = F.tid; u < (LDS_BYTES - LDSCTL_OFF) / 4; u += NWAVES * 64) ((LAS unsigned*)(F.lds + LDSCTL_OFF))[u] = 0u;
    __syncthreads();
    XcdBarrier bar; bar.bar = (unsigned*)(F.ctl + CW_BAR); bar.x = 0; bar.st = nullptr;
    if (N_LAUNCHES == 1) bar = xcd_barrier_post((unsigned*)(F.ctl + CW_BAR), F.MISC + 8);
#define GRID_BAR() do { if (N_LAUNCHES == 1) xcd_barrier(bar); } while (0)
    const int lo = args.ph_lo, hi = args.ph_hi;
#ifndef PH_MASK
#define PH_MASK 0x3ff
#endif
#define IN(k) (((PH_MASK >> (k)) & 1) && lo <= (k) && (k) < hi)
#define BOTH(k) (IN(k) && IN((k) + 1))
#ifndef DUP_MASK
#define DUP_MASK 0
#endif
#define NREP(k) (((DUP_MASK >> (k)) & 1) ? 2 : 1)
    unsigned char* ws = F.ws;
    bf16* ARB = (bf16*)(ws + WS_ARB);

    if (IN(0)) {
_Pragma("unroll")
        for (int rep = 0; rep < NREP(0); ++rep) { p0_prologue(F, args); if (REGQ) p0_quant_rounds(F, args, bar); else { GRID_BAR(); p0_quantize(F, args); } if (BOTH(0) || rep + 1 < NREP(0)) GRID_BAR(); }
    }

    if (IN(1)) {
_Pragma("unroll")
      for (int rep = 0; rep < NREP(1); ++rep) {
        if (N16 > 0) { pg8::Gemm g{ARB, (const bf16*)(ws + WS_WIN), M, N16, D}; pg8::StaticOrder S; S.init(M, N16, F.G, (int)blockIdx.x);
          pg8::EpiIn E{(bf16*)(ws + WS_UA), (bf16*)(ws + WS_VA), (bf16*)(ws + WS_XB2), (bf16*)(ws + WS_GA), (bf16*)(ws + WS_GB), (float*)(ws + WS_PART), 8, 0, 8, nullptr, nullptr, TILED_A};
          pg8::gemm_phase<pg8::EpiIn, pg8::StaticOrder, PG8_ALIGN, PG8_SP2, false, 0, false, true>(F.lds + RING_OFF, g, S, E); }
        { pg8::Gemm g{(const bf16*)(ws + WS_H8), (const bf16*)(ws + WS_W8), M, NG8, D / 2}; pg8::StaticOrder S; S.init(M, NG8, F.G, (int)blockIdx.x);
          pg8::EpiIn E{(bf16*)(ws + WS_UA), (bf16*)(ws + WS_VA), (bf16*)(ws + WS_XB2), (bf16*)(ws + WS_GA), (bf16*)(ws + WS_GB), (float*)(ws + WS_PART), IN_INT8 == 2 ? 0 : 8, IN_INT8 == 2 ? 0 : 8, IN_INT8 == 2 ? 0 : IN_INT8 == 1 ? 8 : 12, (const float*)(ws + WS_RS1), (const float*)(ws + WS_CSIN), TILED_A};
          pg8::gemm_phase<pg8::EpiIn, pg8::StaticOrder, I8_ALIGN, I8_SP2, true, 0, TILED_A, true>(F.lds + RING_OFF, g, S, E); }
        if (BOTH(1) || rep + 1 < NREP(1)) GRID_BAR();
      }
    }

    if (IN(2)) {
_Pragma("unroll")
      for (int rep = 0; rep < NREP(2); ++rep) {
#ifndef SPG_REP
#define SPG_REP 1
#endif
#ifndef S5_REP
#define S5_REP 1
#endif
#ifndef S5_PART
#define S5_PART 3
#endif
_Pragma("unroll 1")
        for (int u = F.vcu; u < 256 * SPG_REP; u += F.G) { spatial_unit(F, args, u & 255); if (SPG_REP > 1) __syncthreads(); }
        __syncthreads();
_Pragma("unroll 1")
        for (int u = F.vcu; u < 256 * S5_REP; u += F.G) { s5_unit(F, u & 255, u < 256 ? 3 : S5_PART); if (S5_REP > 1) __syncthreads(); }
        if (BOTH(2) || rep + 1 < NREP(2)) GRID_BAR();
      }
    }

    if (IN(3)) {
_Pragma("unroll")
      for (int rep = 0; rep < NREP(3); ++rep) {
        pg8::Gemm g{(const bf16*)(ws + WS_ZB), (const bf16*)(ws + WS_WGLU), M, 2 * D, BW}; pg8::StaticOrder S; S.init(M, 2 * D, F.G, (int)blockIdx.x, P345_WGM);
        pg8::EpiGlu E{(bf16*)(ws + WS_GB), TILED_A};
        pg8::gemm_phase<pg8::EpiGlu, pg8::StaticOrder, PG8_ALIGN, PG8_SP2, false, 0, TILED_A, true>(F.lds + RING_OFF, g, S, E);
        if (BOTH(3) || rep + 1 < NREP(3)) GRID_BAR();
      }
    }

    if (IN(4)) {
_Pragma("unroll")
      for (int rep = 0; rep < NREP(4); ++rep) {
        pg8::Gemm g{ARB, (const bf16*)(ws + WS_WPROJ), M, D, AW}; pg8::StaticOrder S; S.init(M, D, F.G, (int)blockIdx.x, P345_WGM);
        pg8::EpiProj E{(bf16*)(ws + WS_GA), (const bf16*)(ws + WS_GB), TILED_A};
        pg8::gemm_phase<pg8::EpiProj, pg8::StaticOrder, PG8_ALIGN, PG8_SP2, false, 0, TILED_A, true>(F.lds + RING_OFF, g, S, E);
        if (BOTH(4) || rep + 1 < NREP(4)) GRID_BAR();
      }
    }

    if (IN(5)) {
_Pragma("unroll")
      for (int rep = 0; rep < NREP(5); ++rep) {
        pg8::Gemm g{(const bf16*)(ws + WS_GA), (const bf16*)(ws + WS_WOUT), M, D, D}; pg8::StaticOrder S; S.init(M, D, F.G, (int)blockIdx.x, P345_WGM);
        pg8::EpiStat E{ARB, (float*)(ws + WS_PART), TILED_MIX};
        pg8::gemm_phase<pg8::EpiStat, pg8::StaticOrder, PG8_ALIGN, PG8_SP2, false, 0, TILED_A, true>(F.lds + RING_OFF, g, S, E);
        if (BOTH(5) || rep + 1 < NREP(5)) GRID_BAR();
      }
    }

    if (IN(6)) {
_Pragma("unroll")
      for (int rep = 0; rep < NREP(6); ++rep) {
        n1_phase(F, args);
        if (BOTH(6) || rep + 1 < NREP(6)) GRID_BAR();
      }
    }

    if (IN(7)) {
_Pragma("unroll")
      for (int rep = 0; rep < NREP(7); ++rep) {
        pg8::Gemm g{(const bf16*)(ws + WS_H2Q), (const bf16*)(ws + WS_WUP), M, DFF, D / 2}; pg8::StaticOrder S; S.init(M, DFF, F.G, (int)blockIdx.x, P7_WGM);
        pg8::EpiUp E{(bf16*)(ws + WS_ARA), (const float*)(ws + WS_RS2), (const float*)(ws + WS_CSUP), TILED_HID};
        pg8::gemm_phase<pg8::EpiUp, pg8::StaticOrder, I8_ALIGN, I8_SP2, true, 0, TILED_A, true>(F.lds + RING_OFF, g, S, E);
        if (BOTH(7) || rep + 1 < NREP(7)) GRID_BAR();
      }
    }

    if (IN(8)) {
_Pragma("unroll")
      for (int rep = 0; rep < NREP(8); ++rep) {
        pg8::Gemm g{(const bf16*)(ws + WS_ARA), (const bf16*)(ws + WS_WDN), M, D, DFF}; pg8::StaticOrder S; S.init(M, D, F.G, (int)blockIdx.x, P8_WGM);
        pg8::EpiStat E{ARB, (float*)(ws + WS_PART), TILED_MIX};
        pg8::gemm_phase<pg8::EpiStat, pg8::StaticOrder, PG8_ALIGN, PG8_SP2, false, P8_AUXA, TILED_HID != 0, true>(F.lds + RING_OFF, g, S, E);
        if (BOTH(8) || rep + 1 < NREP(8)) GRID_BAR();
      }
    }

    if (IN(9)) {
_Pragma("unroll")
      for (int rep = 0; rep < NREP(9); ++rep) {
        n2_phase(F, args);
        if (rep + 1 < NREP(9)) GRID_BAR();
      }
    }
#undef IN
#undef BOTH
}

extern "C" void kernel_launch(void* const* d_in, const int* in_sizes, int n_in, void* d_out, int out_size, void* d_ws, size_t ws_size, hipStream_t stream) {
    static int grid = 0;
    if (grid == 0) {
        if (n_in != 24 || in_sizes[0] != M * D || out_size != M * D || ws_size < WS_END) { fprintf(stderr, "kernel_launch: unexpected shapes / workspace (n_in %d, ws %zu < %zu)\n", n_in, ws_size, (size_t)WS_END); grid = -1; return; }
        int dev = 0, cus = 0, per_cu = 0;
        if (hipGetDevice(&dev) != hipSuccess || hipDeviceGetAttribute(&cus, hipDeviceAttributeMultiprocessorCount, dev) != hipSuccess) { grid = -1; return; }
        if (hipFuncSetAttribute((const void*)mk_fwd, hipFuncAttributeMaxDynamicSharedMemorySize, LDS_BYTES) != hipSuccess) { grid = -1; return; }
        if (hipOccupancyMaxActiveBlocksPerMultiprocessor(&per_cu, (const void*)mk_fwd, NWAVES * 64, LDS_BYTES) != hipSuccess || per_cu < 1) { fprintf(stderr, "kernel_launch: occupancy query says %d\n", per_cu); }
        (void)hipGetLastError();
        grid = cus;
    }
    if (grid < 0) return;
    if (hipMemsetAsync((char*)d_ws + WS_CTL, 0, CTL_ZERO_BYTES, stream) != hipSuccess) return;
    Args a{};
    for (int i = 0; i < 24; ++i) a.in[i] = (const float*)d_in[i];
    a.out = (float*)d_out; a.ws = (unsigned char*)d_ws;
    if (N_LAUNCHES == 1) { a.ph_lo = 0; a.ph_hi = N_PHASES; hipLaunchKernelGGL(mk_fwd, dim3(grid), dim3(NWAVES * 64), LDS_BYTES, stream, a); }
    else for (int li = 0; li < N_PHASES; ++li) { a.ph_lo = li; a.ph_hi = li + 1; hipLaunchKernelGGL(mk_fwd, dim3(grid), dim3(NWAVES * 64), LDS_BYTES, stream, a); }
}
```

```cpp
#include <hip/hip_runtime.h>
#include <cstdio>
#include <cstdint>

#ifndef MK_N_LAUNCHES
#define MK_N_LAUNCHES 1
#endif
namespace pg8 {
#define PG8_LAS __attribute__((address_space(3)))
typedef unsigned short bf16_t;
typedef short bf16x8 __attribute__((ext_vector_type(8)));
typedef float f32x4 __attribute__((ext_vector_type(4)));
typedef unsigned u32x4 __attribute__((ext_vector_type(4)));
typedef int v4i_t __attribute__((ext_vector_type(4)));
typedef int v8i_t __attribute__((ext_vector_type(8)));
constexpr int BM = 256, BK = 64, HALF = 128, HTB = HALF * BK * 2  , STAGE_BYTES = 8 * HTB, NXCD = 8, WGM = 8;

__host__ __device__ __forceinline__ int lds_byte(int r, int c) { const int st = (r >> 4) * 2 + (c >> 5), rr = r & 15, cc = c & 31, ob = rr * 64 + cc * 2; return st * 1024 + (ob ^ (((ob >> 9) & 1) << 5)); }
__host__ __device__ __forceinline__ void stage_rc(int b, int& R, int& C) { const int st = b / 1024, sb = b % 1024, swz = sb ^ (((sb >> 9) & 1) << 5); R = (st >> 1) * 16 + swz / 64; C = (st & 1) * 32 + (swz % 64) / 2; }
__host__ __device__ __forceinline__ int perm32(int rho) { const int n = rho >> 4, i = rho & 15; return 8 * (i >> 2) + 4 * n + (i & 3); }

struct Unit { int pm, pn; };
struct Gemm { const bf16_t* A; const bf16_t* Bt; int M, N, K; };

struct StaticOrder {
    int nM, nN, nwg, G, c, wgm;
    __host__ __device__ void init(int M, int N, int G_, int c_, int wgm_ = WGM) { nM = M / BM; nN = N / BM; nwg = nM * nN; G = G_; c = c_; wgm = wgm_; }
    __host__ __device__ __forceinline__ bool next(int i, Unit& u) const {
        const long L = (long)i * G + c; if (L >= nwg) return false;
        int wgid = (int)L; { const int q = nwg / NXCD, r = nwg % NXCD, xcd = wgid % NXCD, off = wgid / NXCD; wgid = (xcd < r ? xcd * (q + 1) : r * (q + 1) + (xcd - r) * q) + off; }
        const int nig = wgm * nN, gid = wgid / nig, fm = gid * wgm, gsz = (nM - fm) < wgm ? (nM - fm) : wgm;
        u.pm = fm + ((wgid % nig) % gsz); u.pn = (wgid % nig) / gsz; return true;
    }
    __device__ __forceinline__ void a_ready(const Unit&) const {}
    __device__ __forceinline__ void done(const Unit&) const {}
};

__device__ __forceinline__ unsigned cvt_pk_bf16(float lo, float hi) { unsigned r; asm volatile("v_cvt_pk_bf16_f32 %0, %1, %2" : "=v"(r) : "v"(lo), "v"(hi)); return r; }
#ifndef MANT6
#define MANT6 0
#endif
__device__ __forceinline__ unsigned cvt_pk_op(float lo, float hi) {
#if MANT6
    unsigned a = __float_as_uint(lo), b = __float_as_uint(hi); a += 0xFFFFu + ((a >> 17) & 1u); b += 0xFFFFu + ((b >> 17) & 1u); return ((a >> 16) & 0xFFFEu) | (b & 0xFFFE0000u);
#else
    return cvt_pk_bf16(lo, hi);
#endif
}
typedef float f32x2 __attribute__((ext_vector_type(2)));
__device__ __forceinline__ f32x2 gelu_pk(f32x2 v) {
    const f32x2 av = __builtin_elementwise_abs(v), d = av * 0.2316418882f + 1.0f;
    f32x2 t; t.x = __builtin_amdgcn_rcpf(d.x); t.y = __builtin_amdgcn_rcpf(d.y);
    f32x2 q = t * 0.5307027145f + (-0.7265760135f); q = q * t + 0.7107068705f; q = q * t + (-0.142248368f); q = q * t + 0.127414796f; q = q * t;
    const f32x2 s = (v * v) * (-0.72134752044f);
    f32x2 e; e.x = __builtin_amdgcn_exp2f(s.x); e.y = __builtin_amdgcn_exp2f(s.y);
    const f32x2 m = v * (q * e), r = v - m;
    f32x2 o; o.x = v.x < 0.f ? m.x : r.x; o.y = v.y < 0.f ? m.y : r.y; return o;
}

typedef unsigned u32x2 __attribute__((ext_vector_type(2)));
#ifndef UP_NT
#define UP_NT 0
#endif
#if UP_NT
#define UP_STORE(p, v) __builtin_nontemporal_store((v), (p))
#else
#define UP_STORE(p, v) (*(p) = (v))
#endif
#ifndef EPI_NT
#define EPI_NT 0
#endif
#if EPI_NT
#define NT_STORE(p, v) __builtin_nontemporal_store((v), (p))
#else
#define NT_STORE(p, v) (*(p) = (v))
#endif
__device__ __forceinline__ float sigmoid_f(float x) { return __builtin_amdgcn_rcpf(1.0f + __builtin_amdgcn_exp2f(-1.4426950409f * x)); }
__device__ __forceinline__ float gelu_tanh_f(float x) { const float u = x * (1.0f + 0.044715f * x * x); return x * __builtin_amdgcn_rcpf(1.0f + __builtin_amdgcn_exp2f(-2.3022082f * u)); }
__device__ __forceinline__ float bf_lo(unsigned w) { return __uint_as_float(w << 16); }
__device__ __forceinline__ float bf_hi(unsigned w) { return __uint_as_float(w & 0xffff0000u); }
__device__ __forceinline__ u32x4 pack8(const f32x4& v0, const f32x4& v1) { u32x4 w; w.x = cvt_pk_op(v0[0], v0[1]); w.y = cvt_pk_op(v0[2], v0[3]); w.z = cvt_pk_op(v1[0], v1[1]); w.w = cvt_pk_op(v1[2], v1[3]); return w; }
__device__ __forceinline__ u32x4 pack8f(const f32x4& v0, const f32x4& v1) { u32x4 w; w.x = cvt_pk_bf16(v0[0], v0[1]); w.y = cvt_pk_bf16(v0[2], v0[3]); w.z = cvt_pk_bf16(v1[0], v1[1]); w.w = cvt_pk_bf16(v1[2], v1[3]); return w; }

__device__ __forceinline__ size_t t4096_off(bool tiled, int row, int c) { return tiled ? ((((size_t)(row >> 8) * 64 + (size_t)(c >> 6)) * 256 + (size_t)(row & 255)) * 64 + (size_t)(c & 63)) : ((size_t)row * 4096 + c); }
struct EpiIn {
    static constexpr bool PERM = true, AFTER_DRAIN = false;
    bf16_t *UA, *VA, *XB2, *GA, *GB; float* VST; int split, off_lo, off_hi; const float* rs; const float* cs; int ga_tiled;
    __device__ __forceinline__ void operator()(const f32x4 (&acc)[2][2][4][2], const Unit& u, int wr, int wc, int fr, int fq) const {
        const int row0 = u.pm * BM + wr * 64 + fr; const int pn = u.pn + (u.pn < split ? off_lo : off_hi);
        int mode, ldc, colt; bf16_t* base;
        if (pn < 8) { mode = 0; base = UA; ldc = 2048; colt = pn * 256; }
        else if (pn < 16) { mode = 0; base = VA; ldc = 2048; colt = (pn - 8) * 256; }
        else if (pn < 20) { mode = 1; base = XB2; ldc = 0; colt = (pn - 16) * 256; }
        else if (pn < 36) { mode = 2; base = GA; ldc = 4096; colt = (pn - 20) * 256; }
        else { mode = 2; base = GB; ldc = 4096; colt = (pn - 36) * 256; }
        const int col0 = colt + wc * 32 + 8 * fq; const bool vstat = (pn >= 8 && pn < 16); const bool q8 = (rs != nullptr);
        f32x4 csv[2][2];
        if (q8) {
#pragma unroll
            for (int bj = 0; bj < 2; ++bj) { const float* cp = cs + u.pn * BM + wc * 32 + 8 * fq + bj * HALF; csv[bj][0] = *(const f32x4*)cp; csv[bj][1] = *(const f32x4*)(cp + 4); } }
        float rsa[2][4];
#pragma unroll
        for (int ai = 0; ai < 2; ++ai)
#pragma unroll
            for (int m = 0; m < 4; ++m) rsa[ai][m] = q8 ? rs[row0 + ai * HALF + m * 16] : 1.0f;
        __builtin_amdgcn_sched_barrier(0);
#pragma unroll
        for (int ai = 0; ai < 2; ++ai)
#pragma unroll
            for (int m = 0; m < 4; ++m) { const int row = row0 + ai * HALF + m * 16; float s1 = 0.f, s2 = 0.f; const float rsv = rsa[ai][m];
#pragma unroll
                for (int bj = 0; bj < 2; ++bj) { f32x4 v0 = acc[ai][bj][m][0], v1 = acc[ai][bj][m][1]; const int c = col0 + bj * HALF;
                    if (q8) {
#pragma unroll
                        for (int j = 0; j < 4; ++j) { v0[j] = (float)__float_as_int(v0[j]) * (rsv * csv[bj][0][j]); v1[j] = (float)__float_as_int(v1[j]) * (rsv * csv[bj][1][j]); } }
                    if (mode == 0) {
#pragma unroll
                        for (int j = 0; j < 4; ++j) { v0[j] = gelu_tanh_f(v0[j]); v1[j] = gelu_tanh_f(v1[j]); }
                        if (vstat) { s1 += ((v0[0] + v0[1]) + (v0[2] + v0[3])) + ((v1[0] + v1[1]) + (v1[2] + v1[3]));
                            s2 += ((v0[0] * v0[0] + v0[1] * v0[1]) + (v0[2] * v0[2] + v0[3] * v0[3])) + ((v1[0] * v1[0] + v1[1] * v1[1]) + (v1[2] * v1[2] + v1[3] * v1[3])); } }
                    else if (mode == 2) {
#pragma unroll
                        for (int j = 0; j < 4; ++j) { v0[j] = sigmoid_f(v0[j]); v1[j] = sigmoid_f(v1[j]); } }
                    bf16_t* p;
                    if (mode == 1) p = base + ((((size_t)(c >> 4) * 512 + (size_t)(row >> 5)) * 32 + (size_t)(row & 31)) * 16 + (size_t)(c & 15));
                    else if (mode == 0 && ga_tiled) p = base + ((((size_t)(row >> 7) * 16 + (size_t)(c >> 7)) * 128 + (size_t)(row & 127)) * 128 + (size_t)(c & 127));
                    else if (mode == 2) p = base + t4096_off(ga_tiled != 0, row, c);
                    else p = base + (size_t)row * ldc + c;
                    NT_STORE((u32x4*)p, pack8(v0, v1)); }
                if (vstat) { s1 += __shfl_xor(s1, 16); s1 += __shfl_xor(s1, 32); s2 += __shfl_xor(s2, 16); s2 += __shfl_xor(s2, 32);
                    if (fq == 0) { f32x2 o; o.x = s1; o.y = s2; *(f32x2*)(VST + ((size_t)row * 32 + (pn - 8) * 4 + wc) * 2) = o; } } }
    }
};
#ifndef EPI_NT_LD
#define EPI_NT_LD 1
#endif
#if EPI_NT_LD
#define EPI_LD1(p) __builtin_nontemporal_load(p)
#else
#define EPI_LD1(p) (*(p))
#endif
struct EpiGlu {
    static constexpr bool PERM = true, AFTER_DRAIN = false;
    bf16_t* GBm; int gb_tiled;
    __device__ __forceinline__ void operator()(const f32x4 (&acc)[2][2][4][2], const Unit& u, int wr, int wc, int fr, int fq) const {
        const int row0 = u.pm * BM + wr * 64 + fr, oc0 = u.pn * 128 + wc * 32 + 8 * fq;
        u32x4 ga[2][4];
#pragma unroll
        for (int ai = 0; ai < 2; ++ai)
#pragma unroll
            for (int m = 0; m < 4; ++m) ga[ai][m] = EPI_LD1((const u32x4*)(GBm + t4096_off(gb_tiled != 0, row0 + ai * HALF + m * 16, oc0)));
        __builtin_amdgcn_sched_barrier(0);
#pragma unroll
        for (int ai = 0; ai < 2; ++ai)
#pragma unroll
            for (int m = 0; m < 4; ++m) { bf16_t* p = GBm + t4096_off(gb_tiled != 0, row0 + ai * HALF + m * 16, oc0); const u32x4 g = ga[ai][m];
                const f32x4 a0 = acc[ai][0][m][0], a1 = acc[ai][0][m][1], b0 = acc[ai][1][m][0], b1 = acc[ai][1][m][1]; f32x4 o0, o1;
                o0[0] = a0[0] * sigmoid_f(b0[0]) * bf_lo(g.x); o0[1] = a0[1] * sigmoid_f(b0[1]) * bf_hi(g.x); o0[2] = a0[2] * sigmoid_f(b0[2]) * bf_lo(g.y); o0[3] = a0[3] * sigmoid_f(b0[3]) * bf_hi(g.y);
                o1[0] = a1[0] * sigmoid_f(b1[0]) * bf_lo(g.z); o1[1] = a1[1] * sigmoid_f(b1[1]) * bf_hi(g.z); o1[2] = a1[2] * sigmoid_f(b1[2]) * bf_lo(g.w); o1[3] = a1[3] * sigmoid_f(b1[3]) * bf_hi(g.w);
                *(u32x4*)p = pack8(o0, o1); }
    }
};
struct EpiProj {
    static constexpr bool PERM = true, AFTER_DRAIN = false;
    bf16_t* GA; const bf16_t* GBm; int ga_tiled;
    __device__ __forceinline__ void operator()(const f32x4 (&acc)[2][2][4][2], const Unit& u, int wr, int wc, int fr, int fq) const {
        const int row0 = u.pm * BM + wr * 64 + fr, col0 = u.pn * BM + wc * 32 + 8 * fq;
#pragma unroll
        for (int ai = 0; ai < 2; ++ai) {
            u32x4 gav[4][2], gbv[4][2];
#pragma unroll
            for (int m = 0; m < 4; ++m)
#pragma unroll
                for (int bj = 0; bj < 2; ++bj) { const int rr = row0 + ai * HALF + m * 16, cc = col0 + bj * HALF;
                    const bf16_t* gap = ga_tiled ? GA + ((((size_t)(rr >> 8) * 64 + (size_t)(cc >> 6)) * 256 + (size_t)(rr & 255)) * 64 + (size_t)(cc & 63)) : GA + (size_t)rr * 4096 + cc;
                    gav[m][bj] = EPI_LD1((const u32x4*)gap); gbv[m][bj] = EPI_LD1((const u32x4*)(GBm + t4096_off(ga_tiled != 0, rr, cc))); }
            __builtin_amdgcn_sched_barrier(0);
#pragma unroll
            for (int m = 0; m < 4; ++m) { const size_t off = (size_t)(row0 + ai * HALF + m * 16) * 4096 + col0;
#pragma unroll
                for (int bj = 0; bj < 2; ++bj) { const int rr = row0 + ai * HALF + m * 16, cc = col0 + bj * HALF;
                    bf16_t* gap = ga_tiled ? GA + ((((size_t)(rr >> 8) * 64 + (size_t)(cc >> 6)) * 256 + (size_t)(rr & 255)) * 64 + (size_t)(cc & 63)) : GA + off + bj * HALF;
                    const u32x4 ga = gav[m][bj], gb = gbv[m][bj];
                    const f32x4 a0 = acc[ai][bj][m][0], a1 = acc[ai][bj][m][1]; f32x4 o0, o1;
                    o0[0] = a0[0] * bf_lo(ga.x) + bf_lo(gb.x); o0[1] = a0[1] * bf_hi(ga.x) + bf_hi(gb.x); o0[2] = a0[2] * bf_lo(ga.y) + bf_lo(gb.y); o0[3] = a0[3] * bf_hi(ga.y) + bf_hi(gb.y);
                    o1[0] = a1[0] * bf_lo(ga.z) + bf_lo(gb.z); o1[1] = a1[1] * bf_hi(ga.z) + bf_hi(gb.z); o1[2] = a1[2] * bf_lo(ga.w) + bf_lo(gb.w); o1[3] = a1[3] * bf_hi(ga.w) + bf_hi(gb.w);
                    *(u32x4*)gap = pack8(o0, o1); } } }
    }
};
struct EpiStat {
    static constexpr bool PERM = true, AFTER_DRAIN = false;
    bf16_t* O; float* part; int tiled;
    __device__ __forceinline__ void operator()(const f32x4 (&acc)[2][2][4][2], const Unit& u, int wr, int wc, int fr, int fq) const {
        const int row0 = u.pm * BM + wr * 64 + fr, col0 = u.pn * BM + wc * 32 + 8 * fq;
#pragma unroll
        for (int ai = 0; ai < 2; ++ai)
#pragma unroll
            for (int m = 0; m < 4; ++m) { const int row = row0 + ai * HALF + m * 16; float s = 0.f;
#pragma unroll
                for (int bj = 0; bj < 2; ++bj) { const f32x4 v0 = acc[ai][bj][m][0], v1 = acc[ai][bj][m][1];
                    s += (v0[0] * v0[0] + v0[1] * v0[1]) + (v0[2] * v0[2] + v0[3] * v0[3]) + (v1[0] * v1[0] + v1[1] * v1[1]) + (v1[2] * v1[2] + v1[3] * v1[3]);
                    *(u32x4*)(O + t4096_off(tiled != 0, row, col0 + bj * HALF)) = pack8f(v0, v1); }
                s += __shfl_xor(s, 16); s += __shfl_xor(s, 32);
                if (fq == 0) part[(size_t)row * 64 + u.pn * 4 + wc] = s; }
    }
};
struct EpiUp {
    static constexpr bool PERM = true, AFTER_DRAIN = false;
    bf16_t* H; const float* rs; const float* cs; int tiled;
    __device__ __forceinline__ void operator()(const f32x4 (&acc)[2][2][4][2], const Unit& u, int wr, int wc, int fr, int fq) const {
        const int row0 = u.pm * BM + wr * 64 + fr, col0 = u.pn * BM + wc * 32 + 8 * fq; const bool q8 = (rs != nullptr);
        f32x4 csv[2][2];
        if (q8) {
#pragma unroll
            for (int bj = 0; bj < 2; ++bj) { const float* cp = cs + col0 + bj * HALF; csv[bj][0] = *(const f32x4*)cp; csv[bj][1] = *(const f32x4*)(cp + 4); } }
        float rsa[2][4];
#pragma unroll
        for (int ai = 0; ai < 2; ++ai)
#pragma unroll
            for (int m = 0; m < 4; ++m) rsa[ai][m] = q8 ? rs[row0 + ai * HALF + m * 16] : 1.0f;
        __builtin_amdgcn_sched_barrier(0);
#pragma unroll
        for (int ai = 0; ai < 2; ++ai)
#pragma unroll
            for (int m = 0; m < 4; ++m) { const int row = row0 + ai * HALF + m * 16; const float rsv = rsa[ai][m];
                bf16_t* rowp = tiled ? H + (((size_t)u.pm * 256 + (size_t)(u.pn * 4 + (wc >> 1))) * 256 + (size_t)(row & 255)) * 64 + (wc & 1) * 32 + 8 * fq : H + (size_t)row * 16384 + col0;
#pragma unroll
                for (int bj = 0; bj < 2; ++bj) { f32x4 v0 = acc[ai][bj][m][0], v1 = acc[ai][bj][m][1];
                    if (q8) {
#pragma unroll
                        for (int j = 0; j < 4; ++j) { v0[j] = (float)__float_as_int(v0[j]) * (rsv * csv[bj][0][j]); v1[j] = (float)__float_as_int(v1[j]) * (rsv * csv[bj][1][j]); } }
#pragma unroll
                    for (int j = 0; j < 4; ++j) { const float a = fmaxf(v0[j], 0.f), b = fmaxf(v1[j], 0.f); v0[j] = a * a; v1[j] = b * b; }
                    UP_STORE((u32x4*)(rowp + (tiled ? bj * 2 * 256 * 64 : bj * HALF)), pack8(v0, v1)); } }
    }
};

template <class Epi, class Sched, bool ALIGN_EPI = false, bool SP2 = false, bool I8 = false, int AUXA = 0, bool TA = false, bool TB = false>
__device__ __forceinline__ void gemm_phase(PG8_LAS unsigned char* lds, const Gemm g, const Sched& S, const Epi& E) {
    const int tid = threadIdx.x, wid = __builtin_amdgcn_readfirstlane(tid >> 6), lane = tid & 63, wr = wid >> 2, wc = wid & 3, fr = lane & 15, fq = lane >> 4;
    const int K = g.K, nt = K / BK;
    unsigned voffA[2], voffB[2];
#pragma unroll
    for (int i = 0; i < 2; ++i) { int R, C; stage_rc(tid * 16 + i * 8192, R, C); const int Rb = Epi::PERM ? ((R & ~31) + perm32(R & 31)) : R;
        voffA[i] = (unsigned)(R * (TA ? BK : K) + C) * 2u; voffB[i] = (unsigned)(Rb * (TB ? BK : K) + C) * 2u; }
    const size_t kstepA = TA ? (size_t)BM * BK * 2 : (size_t)(BK * 2), kstepB = TB ? (size_t)BM * BK * 2 : (size_t)(BK * 2);
    const size_t hstepA = TA ? (size_t)HALF * BK * 2 : (size_t)HALF * K * 2, hstepB = TB ? (size_t)HALF * BK * 2 : (size_t)HALF * K * 2;
    const size_t hstep = (size_t)HALF * K * 2;
    const size_t tstep = 2 * hstep;
    const unsigned ldsw = (unsigned)wid * 1024u;
    const int aoff = lds_byte(wr * 64 + fr, fq * 8), boff = lds_byte(wc * 32 + fr, fq * 8);
#define PG8_SA(b, h) (((b) * 2 + (h)) * HTB)
#define PG8_SB(b, h) ((4 + (b) * 2 + (h)) * HTB)
#define PG8_STAGE(bufoff, gbase, voff) do { _Pragma("unroll") for (int _i = 0; _i < 2; ++_i) \
        __builtin_amdgcn_global_load_lds((const unsigned*)((const char*)(gbase) + (voff)[_i]), (PG8_LAS unsigned*)(lds + (bufoff) + ldsw + _i * 8192), 16, 0, 0); } while (0)
#define PG8_STAGEA(bufoff, gbase, voff) do { _Pragma("unroll") for (int _i = 0; _i < 2; ++_i) \
        __builtin_amdgcn_global_load_lds((const unsigned*)((const char*)(gbase) + (voff)[_i]), (PG8_LAS unsigned*)(lds + (bufoff) + ldsw + _i * 8192), 16, 0, AUXA); } while (0)
#define PG8_LDA(dst, b, h) do { _Pragma("unroll") for (int m = 0; m < 4; ++m) _Pragma("unroll") for (int k = 0; k < 2; ++k) dst[m][k] = *(const PG8_LAS bf16x8*)(lds + PG8_SA(b, h) + aoff + m * 2048 + k * 1024); } while (0)
#define PG8_LDB(dst, b, h) do { _Pragma("unroll") for (int n = 0; n < 2; ++n) _Pragma("unroll") for (int k = 0; k < 2; ++k) dst[n][k] = *(const PG8_LAS bf16x8*)(lds + PG8_SB(b, h) + boff + n * 2048 + k * 1024); } while (0)
#define PG8_MMA(ai, bj, At, Bt) do { __builtin_amdgcn_s_setprio(1); _Pragma("unroll") for (int m = 0; m < 4; ++m) _Pragma("unroll") for (int n = 0; n < 2; ++n) _Pragma("unroll") for (int k = 0; k < 2; ++k) { \
        if constexpr (I8) { acc[ai][bj][m][n] = __builtin_bit_cast(f32x4, __builtin_amdgcn_mfma_i32_16x16x64_i8(__builtin_bit_cast(v4i_t, Bt[n][k]), __builtin_bit_cast(v4i_t, At[m][k]), __builtin_bit_cast(v4i_t, acc[ai][bj][m][n]), 0, 0, 0)); } \
        else acc[ai][bj][m][n] = __builtin_amdgcn_mfma_f32_16x16x32_bf16(Bt[n][k], At[m][k], acc[ai][bj][m][n], 0, 0, 0); } __builtin_amdgcn_s_setprio(0); } while (0)
#define PG8_WAIT_V(n) asm volatile("s_waitcnt vmcnt(" #n ")" ::: "memory")
#define PG8_WAIT_L(n) asm volatile("s_waitcnt lgkmcnt(" #n ")" ::: "memory")
#define PG8_BAR __builtin_amdgcn_s_barrier()
#define PG8_SCHED __builtin_amdgcn_sched_barrier(0)
    Unit cur, nxt; int ui = 0;
    if (!S.next(0, cur)) return;
    f32x4 acc[2][2][4][2];
#pragma unroll
    for (int a = 0; a < 2; ++a)
#pragma unroll
        for (int b = 0; b < 2; ++b)
#pragma unroll
            for (int m = 0; m < 4; ++m)
#pragma unroll
                for (int n = 0; n < 2; ++n) acc[a][b][m][n] = (f32x4){0.f, 0.f, 0.f, 0.f};
    bf16x8 At[4][2], B0[2][2], B1[2][2];
    const char* cA = (const char*)g.A + (size_t)cur.pm * tstep; const char* cB = (const char*)g.Bt + (size_t)cur.pn * tstep;
    S.a_ready(cur);
    if constexpr (SP2) {
        PG8_STAGE(PG8_SB(0, 0), cB, voffB); PG8_STAGE(PG8_SB(0, 1), cB + hstepB, voffB); PG8_STAGEA(PG8_SA(0, 0), cA, voffA); PG8_STAGEA(PG8_SA(0, 1), cA + hstepA, voffA);
        if (wr == 1) PG8_BAR;
        PG8_WAIT_V(2); PG8_BAR;
        PG8_STAGE(PG8_SB(1, 0), cB + kstepB, voffB); PG8_STAGEA(PG8_SA(1, 0), cA + kstepA, voffA); PG8_STAGE(PG8_SB(1, 1), cB + hstepB + kstepB, voffB);
        PG8_WAIT_V(6); PG8_BAR;
    } else {
        PG8_STAGE(PG8_SB(0, 0), cB, voffB); PG8_STAGEA(PG8_SA(0, 0), cA, voffA); PG8_STAGE(PG8_SB(0, 1), cB + hstepB, voffB); PG8_STAGEA(PG8_SA(0, 1), cA + hstepA, voffA);
        if (wr == 1) PG8_BAR;
        PG8_WAIT_V(4); PG8_BAR;
        PG8_STAGE(PG8_SB(1, 0), cB + kstepB, voffB); PG8_STAGEA(PG8_SA(1, 0), cA + kstepA, voffA); PG8_STAGE(PG8_SB(1, 1), cB + hstepB + kstepB, voffB);
        PG8_WAIT_V(6); PG8_BAR;
    }
    for (;;) {
        const bool has_next = S.next(ui + 1, nxt);
        const char* nA = has_next ? (const char*)g.A + (size_t)nxt.pm * tstep : cA; const char* nB = has_next ? (const char*)g.Bt + (size_t)nxt.pn * tstep : cB;
        for (int t = 0; t < nt; t += 2) {
            const bool last = (t == nt - 2);
            const char* a1 = cA + (size_t)(t + 1) * kstepA;
            const char* a2 = last ? nA : cA + (size_t)(t + 2) * kstepA; const char* b2 = last ? nB : cB + (size_t)(t + 2) * kstepB;
            const char* a3 = a2 + kstepA; const char* b3 = b2 + kstepB;
            if (last && has_next) S.a_ready(nxt);
            if constexpr (SP2) {
            PG8_LDB(B0, 0, 0); PG8_LDB(B1, 0, 1); PG8_SCHED; PG8_LDA(At, 0, 0); PG8_STAGEA(PG8_SA(1, 1), a1 + hstepA, voffA);
            PG8_WAIT_V(8); PG8_WAIT_L(0); PG8_BAR; PG8_MMA(0, 0, At, B0); PG8_MMA(0, 1, At, B1); PG8_BAR; PG8_SCHED;
            PG8_LDA(At, 0, 1); PG8_STAGE(PG8_SB(0, 0), b2, voffB); PG8_STAGE(PG8_SB(0, 1), b2 + hstepB, voffB); PG8_STAGEA(PG8_SA(0, 0), a2, voffA);
            PG8_WAIT_V(8); PG8_WAIT_L(0); PG8_BAR; PG8_MMA(1, 0, At, B0); PG8_MMA(1, 1, At, B1); PG8_BAR; PG8_SCHED;
            PG8_LDB(B0, 1, 0); PG8_LDB(B1, 1, 1); PG8_SCHED; PG8_LDA(At, 1, 0); PG8_STAGEA(PG8_SA(0, 1), a2 + hstepA, voffA);
            PG8_WAIT_V(8); PG8_WAIT_L(0); PG8_BAR; PG8_MMA(0, 0, At, B0); PG8_MMA(0, 1, At, B1); PG8_BAR; PG8_SCHED;
            PG8_LDA(At, 1, 1); PG8_STAGE(PG8_SB(1, 0), b3, voffB); PG8_STAGE(PG8_SB(1, 1), b3 + hstepB, voffB); PG8_STAGEA(PG8_SA(1, 0), a3, voffA);
            PG8_WAIT_V(8); PG8_WAIT_L(0); PG8_BAR; PG8_MMA(1, 0, At, B0); PG8_MMA(1, 1, At, B1); PG8_BAR; PG8_SCHED;
            } else {
            PG8_LDB(B0, 0, 0); PG8_SCHED; PG8_LDA(At, 0, 0); PG8_STAGEA(PG8_SA(1, 1), a1 + hstepA, voffA);
            PG8_WAIT_L(8); PG8_BAR; PG8_WAIT_L(0); PG8_MMA(0, 0, At, B0); PG8_BAR; PG8_SCHED;
            PG8_LDB(B1, 0, 1); PG8_STAGE(PG8_SB(0, 0), b2, voffB);
            PG8_BAR; PG8_WAIT_L(0); PG8_MMA(0, 1, At, B1); PG8_BAR;
            PG8_LDA(At, 0, 1); PG8_STAGEA(PG8_SA(0, 0), a2, voffA);
            PG8_BAR; PG8_WAIT_L(0); PG8_MMA(1, 0, At, B0); PG8_BAR; PG8_SCHED;
            PG8_STAGE(PG8_SB(0, 1), b2 + hstepB, voffB);
            PG8_WAIT_V(6); PG8_BAR; PG8_MMA(1, 1, At, B1); PG8_BAR;
            PG8_LDB(B0, 1, 0); PG8_SCHED; PG8_LDA(At, 1, 0); PG8_STAGEA(PG8_SA(0, 1), a2 + hstepA, voffA);
            PG8_WAIT_L(8); PG8_BAR; PG8_WAIT_L(0); PG8_MMA(0, 0, At, B0); PG8_BAR; PG8_SCHED;
            PG8_LDB(B1, 1, 1); PG8_STAGE(PG8_SB(1, 0), b3, voffB);
            PG8_BAR; PG8_WAIT_L(0); PG8_MMA(0, 1, At, B1); PG8_BAR;
            PG8_LDA(At, 1, 1); PG8_STAGEA(PG8_SA(1, 0), a3, voffA);
            PG8_BAR; PG8_WAIT_L(0); PG8_MMA(1, 0, At, B0); PG8_BAR; PG8_SCHED;
            PG8_STAGE(PG8_SB(1, 1), b3 + hstepB, voffB);
            PG8_WAIT_V(6); PG8_BAR; PG8_MMA(1, 1, At, B1); PG8_BAR;
            }
        }
        if constexpr (ALIGN_EPI) { if (wr == 0) PG8_BAR; }
        if constexpr (!Epi::AFTER_DRAIN) { E(acc, cur, wr, wc, fr, fq); S.done(cur); }
        if (!has_next) break;
#pragma unroll
        for (int a = 0; a < 2; ++a)
#pragma unroll
            for (int b = 0; b < 2; ++b)
#pragma unroll
                for (int m = 0; m < 4; ++m)
#pragma unroll
                    for (int n = 0; n < 2; ++n) acc[a][b][m][n] = (f32x4){0.f, 0.f, 0.f, 0.f};
        cur = nxt; cA = nA; cB = nB; ++ui;
        if constexpr (ALIGN_EPI) { if (wr == 1) PG8_BAR; }
    }
    PG8_WAIT_V(0);
    if constexpr (!ALIGN_EPI) { if (wr == 0) PG8_BAR; }
    PG8_BAR;
    if constexpr (Epi::AFTER_DRAIN) { E.fused(acc, cur, wr, wc, fr, fq, lds, wid, lane); S.done(cur); }
#undef PG8_SA
#undef PG8_SB
#undef PG8_STAGE
#undef PG8_STAGEA
#undef PG8_LDA
#undef PG8_LDB
#undef PG8_MMA
#undef PG8_WAIT_V
#undef PG8_WAIT_L
#undef PG8_BAR
#undef PG8_SCHED
}
}
#ifndef TILED_A
#define TILED_A true
#endif
#ifndef TILED_HID
#define TILED_HID 1
#endif
#ifndef P8_AUXA
#define P8_AUXA 0
#endif
#ifndef P7_WGM
#define P7_WGM 8
#endif
#ifndef I8_SP2
#define I8_SP2 PG8_SP2
#endif
#ifndef I8_ALIGN
#define I8_ALIGN PG8_ALIGN
#endif
#ifndef P345_WGM
#define P345_WGM 8
#endif
#ifndef P8_WGM
#define P8_WGM 4
#endif
#ifndef PG8_SP2
#define PG8_SP2 true
#endif
#ifndef PG8_ALIGN
#define PG8_ALIGN true
#endif

constexpr int NWAVES = 8;
constexpr int N_LAUNCHES = MK_N_LAUNCHES;
constexpr int N_PHASES = 10;
constexpr int BATCH = 2, SEQ = 8192, D = 4096, M = BATCH * SEQ;
constexpr int AW = 2048, ACH = 128, AH = 16, AHD = 128;
constexpr int BW = 1024, SG = 64, SGD = 16, SP = 64;
constexpr int DFF = 16384, INW = 2 * AW + BW + 2 * D;
constexpr int TC = 32, NCHB = SEQ / TC, NCH = M / TC;
constexpr float NORM_EPS = 1e-6f;

constexpr size_t MiB = 1u << 20;
constexpr size_t WS_CTL = 0, CTL_ZERO_BYTES = 1 * MiB;
constexpr size_t WS_WIN = 1 * MiB, WS_WPROJ = 105 * MiB, WS_WGLU = 121 * MiB, WS_WOUT = 137 * MiB, WS_WUP = 169 * MiB, WS_WDN = 297 * MiB;
constexpr size_t WS_KTAB = 425 * MiB, WS_BMAT = 426 * MiB, WS_CMAT = 434 * MiB, WS_AT = 442 * MiB;
constexpr size_t WS_PART = 443 * MiB;
constexpr size_t WS_ARB = 448 * MiB;
constexpr size_t WS_ARA = 576 * MiB;
constexpr size_t WS_UA = WS_ARA, WS_VA = WS_ARA + 64 * MiB, WS_XB2 = WS_ARA + 128 * MiB, WS_ZB = WS_ARA + 160 * MiB, WS_GA = WS_ARA + 192 * MiB, WS_GB = WS_ARA + 320 * MiB;
#ifndef IN_INT8
#define IN_INT8 2
#endif
constexpr int NG8 = IN_INT8 == 2 ? INW : IN_INT8 == 1 ? 1024 + 2048 + 8192 : 2048 + 8192, N16 = INW - NG8;
__host__ __device__ constexpr int win_row16(int n) { return n < 2048 ? n : n - 2048; }
__host__ __device__ constexpr int win_row8(int n) { return n < 4096 ? n - 2048 : n - 3072; }
__host__ __device__ constexpr int win_col8(int r) { return IN_INT8 == 2 ? r : IN_INT8 == 1 ? r + 2048 : (r < 2048 ? r + 2048 : r + 3072); }
__host__ __device__ constexpr int win_col16(int r) { return r < 2048 ? r : r + 2048; }
constexpr size_t WS_H8 = WS_ARA + 448 * MiB;
constexpr size_t WS_W8 = WS_WIN + (size_t)N16 * D * 2;
constexpr size_t WS_H2Q = WS_WIN;
static_assert(WS_W8 + (size_t)NG8 * D <= WS_WPROJ && WS_H2Q + (size_t)M * D <= WS_WOUT, "int8 copies");
constexpr size_t WS_RS1 = WS_AT + 64 * 1024, WS_RS2 = WS_AT + 128 * 1024, WS_CSIN = WS_AT + 192 * 1024, WS_CSUP = WS_AT + 256 * 1024;
static_assert(WS_CSIN + (size_t)NG8 * 4 <= WS_CSUP && WS_CSUP + (size_t)DFF * 4 <= WS_PART, "scale arrays");
constexpr int CW_CMAXIN = 16384, CW_CMAXUP = 32768;
static_assert((CW_CMAXUP + DFF) * 4 <= (int)(1u << 20) && CW_CMAXIN + NG8 <= CW_CMAXUP, "CTL words inside the memset region");
constexpr size_t WS_END = 1088 * MiB;
static_assert(WS_WIN + (size_t)INW * D * 2 <= WS_WPROJ && WS_WPROJ + (size_t)D * AW * 2 <= WS_WGLU && WS_WGLU + (size_t)2 * D * BW * 2 <= WS_WOUT && WS_WOUT + (size_t)D * D * 2 <= WS_WUP &&
              WS_WUP + (size_t)DFF * D * 2 <= WS_WDN && WS_WDN + (size_t)D * DFF * 2 <= WS_KTAB, "weight map");
static_assert(WS_KTAB + (size_t)SG * TC * 256 * 2 <= WS_BMAT && WS_BMAT + (size_t)SG * 128 * 512 * 2 <= WS_CMAT && WS_CMAT + (size_t)SG * 512 * 128 * 2 <= WS_AT && WS_AT + (size_t)SG * SP * 8 <= WS_PART &&
              WS_PART + (size_t)M * 64 * 4 <= WS_ARB && WS_ARB + (size_t)M * D * 2 <= WS_ARA && WS_GB + (size_t)M * D * 2 <= WS_END && WS_ARA + (size_t)M * DFF * 2 <= WS_END, "activation map");
constexpr int CW_TMO = 0, CW_CODE = 1, CW_BAR = 4096;

constexpr int RING_OFF = 0, RING_BYTES = 131072;
constexpr int LDSCTL_OFF = RING_BYTES, MISC_OFF = LDSCTL_OFF + 320;
constexpr int LDS_BYTES = 147456;
static_assert(MISC_OFF + 128 <= LDS_BYTES, "LDS map");

#define GAS __attribute__((address_space(1)))
#define LAS __attribute__((address_space(3)))
typedef unsigned short bf16;
typedef unsigned v4u __attribute__((ext_vector_type(4)));
typedef unsigned v2u __attribute__((ext_vector_type(2)));
typedef float f32x4 __attribute__((ext_vector_type(4)));
typedef float f32x2 __attribute__((ext_vector_type(2)));
typedef short bf16x8 __attribute__((ext_vector_type(8)));
typedef GAS unsigned gu32;
#define RLX_AGENT __ATOMIC_RELAXED, __HIP_MEMORY_SCOPE_AGENT
#ifndef NT_STREAM
#define NT_STREAM 1
#endif
#if NT_STREAM
#define LD_STREAM(p) __builtin_nontemporal_load(p)
#define ST_STREAM(p, v) __builtin_nontemporal_store((v), (p))
#else
#define LD_STREAM(p) (*(p))
#define ST_STREAM(p, v) (*(p) = (v))
#endif
#define LDS_WAIT() asm volatile("s_waitcnt lgkmcnt(0)" ::: "memory")
#define VM_WAIT() asm volatile("s_waitcnt vmcnt(0)" ::: "memory")
__device__ __forceinline__ unsigned pk2(float lo, float hi) { return pg8::cvt_pk_op(lo, hi); }
__device__ __forceinline__ unsigned pk2x(float lo, float hi) { return pg8::cvt_pk_bf16(lo, hi); }
__device__ __forceinline__ float bflo(unsigned w) { return __uint_as_float(w << 16); }
__device__ __forceinline__ float bfhi(unsigned w) { return __uint_as_float(w & 0xffff0000u); }
__device__ __forceinline__ float gelu_t(float x) { return pg8::gelu_tanh_f(x); }

#define XB_TMO      128
#define XB_XCNT(j)  (256  + 64 * (j))
#define XB_XSUB(j)  (1280 + 64 * (j))
#define XB_XGEN(j)  (2304 + 64 * (j))
#define XB_TOP      3328
#define XB_TOPGEN   3392
#define XCD_BAR_WORDS 3456
#define XB_SPIN_CAP (1u << 18)

__device__ __forceinline__ unsigned xb_ld(unsigned* p)              { return __hip_atomic_load(p, __ATOMIC_RELAXED, __HIP_MEMORY_SCOPE_AGENT); }
__device__ __forceinline__ unsigned xb_add(unsigned* p, unsigned v) { return __hip_atomic_fetch_add(p, v, __ATOMIC_RELAXED, __HIP_MEMORY_SCOPE_AGENT); }
__device__ __forceinline__ unsigned xb_xcc_id() { return (unsigned)__builtin_amdgcn_s_getreg((3 << 11) | 20) & 0xFu; }
#define XB_SPIN(cond, bar) do { unsigned _sp = 0; while (cond) { __builtin_amdgcn_s_sleep(1); \
    if ((++_sp & 255u) == 0u) { if (xb_ld(&(bar)[XB_TMO])) break; if (_sp > XB_SPIN_CAP) { atomicAdd(&(bar)[XB_TMO], 1u); break; } } } } while (0)

struct XcdBarrier { unsigned* bar; unsigned x; volatile LAS unsigned* st; };

__device__ __forceinline__ XcdBarrier xcd_barrier_post(unsigned* bar, volatile LAS unsigned* st) {
    XcdBarrier b; b.bar = bar; b.x = xb_xcc_id(); b.st = st;
    if (threadIdx.x == 0) (void)xb_add(&bar[XB_XCNT(b.x)], 1u);
    return b;
}
__device__ __forceinline__ void xcd_barrier_complete(unsigned* bar, unsigned x, unsigned& nloc, unsigned& nx) {
    const unsigned G = gridDim.x * gridDim.y * gridDim.z;
    unsigned sum, cnt, mine, sp = 0u;
    for (;;) {
        sum = 0u; cnt = 0u; mine = 0u;
#pragma unroll
        for (unsigned j = 0; j < 16; ++j) { const unsigned c = xb_ld(&bar[XB_XCNT(j)]); sum += c; cnt += (c > 0u) ? 1u : 0u; mine = (j == x) ? c : mine; }
        if (sum == G) break;
        __builtin_amdgcn_s_sleep(1);
        if ((++sp & 255u) == 0u) { if (xb_ld(&bar[XB_TMO])) break; if (sp > XB_SPIN_CAP) { atomicAdd(&bar[XB_TMO], 1u); break; } }
    }
    nloc = mine > 0u ? mine : 1u; nx = cnt > 0u ? cnt : 1u;
}
__device__ __forceinline__ void xcd_barrier(const XcdBarrier& b) {
    asm volatile("s_waitcnt vmcnt(0)" ::: "memory");
    __syncthreads();
    if (threadIdx.x == 0) {
        unsigned* bar = b.bar;
        __builtin_amdgcn_s_waitcnt(0);
        unsigned nloc = b.st[0], nx = b.st[1];
        if (nloc == 0u) { xcd_barrier_complete(bar, b.x, nloc, nx); b.st[0] = nloc; b.st[1] = nx; }
        const unsigned old = xb_add(&bar[XB_XSUB(b.x)], 1u);
        const unsigned gen = old / nloc;
        if (old + 1u == (gen + 1u) * nloc) {
            __builtin_amdgcn_fence(__ATOMIC_RELEASE, "agent");
            asm volatile("s_waitcnt vmcnt(0)" ::: "memory");
            const unsigned og = xb_add(&bar[XB_TOP], 1u);
            const unsigned tg = og / nx;
            if (og + 1u == (tg + 1u) * nx) xb_add(&bar[XB_TOPGEN], 1u);
            else XB_SPIN(xb_ld(&bar[XB_TOPGEN]) == tg, bar);
            __builtin_amdgcn_fence(__ATOMIC_ACQUIRE, "agent");
            xb_add(&bar[XB_XGEN(b.x)], 1u);
            asm volatile("s_waitcnt vmcnt(0)" ::: "memory");
        } else {
            XB_SPIN(xb_ld(&bar[XB_XGEN(b.x)]) == gen, bar);
            __builtin_amdgcn_fence(__ATOMIC_ACQUIRE, "agent");
            asm volatile("s_waitcnt vmcnt(0)" ::: "memory");
        }
    }
    __syncthreads();
}

struct Args { const float* in[24]; float* out; unsigned char* ws; int ph_lo, ph_hi; };
struct Frame {
    LAS unsigned char* lds;
    volatile LAS unsigned* MISC;
    gu32* ctl;
    int tid, lane, wave;
    int vcu, G;
    float* out; unsigned char* ws;
};
enum { I_X = 0, I_NMIXPRE, I_WIN, I_VNG, I_VNB, I_WSP, I_BSP, I_WPROJ, I_LRE, I_LIM, I_LOGDT, I_BRE, I_BIM, I_CRE, I_CIM, I_DSKIP, I_WGLUA, I_WGLUB, I_WOUT, I_NMIXPOST, I_NMLPPRE, I_WUP, I_WDN, I_NMLPPOST };

__device__ __forceinline__ float wave_sum(float v) {
#pragma unroll
    for (int o = 1; o < 64; o <<= 1) v += __shfl_xor(v, o);
    return v;
}

__device__ __forceinline__ void p0_transpose_item(const float* W, int K, int N, bf16* WT, int out_row0, LAS unsigned char* scr, int k0, int n0, int lane) {
    const int c = lane & 15, kq = lane >> 4;
    const float* src = W + (size_t)(k0 + 4 * kq) * N + n0 + 4 * c;
    f32x4 v[16];
#pragma unroll
    for (int i = 0; i < 16; ++i) v[i] = LD_STREAM((const GAS f32x4*)(src + (size_t)((i & 3) + 16 * (i >> 2)) * N));
#pragma unroll
    for (int mb = 0; mb < 4; ++mb)
#pragma unroll
        for (int j = 0; j < 4; ++j) { v2u o; o.x = pk2(v[4 * mb + 0][j], v[4 * mb + 1][j]); o.y = pk2(v[4 * mb + 2][j], v[4 * mb + 3][j]);
            *(LAS v2u*)(scr + (4 * c + j) * 136 + (16 * mb + 4 * kq) * 2) = o; }
    LDS_WAIT(); asm volatile("" ::: "memory");
#pragma unroll
    for (int r = 0; r < 8; ++r) { const int n = (lane >> 3) + 8 * r; const LAS unsigned char* p = scr + n * 136 + (lane & 7) * 16;
        const v2u x = *(const LAS v2u*)p, y = *(const LAS v2u*)(p + 8); v4u o; o.x = x.x; o.y = x.y; o.z = y.x; o.w = y.y;
        const int orow = out_row0 + n;
        *(GAS v4u*)(WT + ((((size_t)(orow >> 8) * (size_t)(K >> 6) + (size_t)(k0 >> 6)) * 256 + (size_t)(orow & 255)) * 64 + 8 * (lane & 7))) = o; }
    LDS_WAIT(); asm volatile("" ::: "memory");
}
__device__ __forceinline__ size_t tile16_off(int row, int col, int ncols) { return TILED_A ? ((((size_t)(row >> 8) * (size_t)(ncols >> 6) + (size_t)(col >> 6)) * 256 + (size_t)(row & 255)) * 64 + (size_t)(col & 63)) : ((size_t)row * ncols + col); }
__device__ __forceinline__ size_t tile8_off(int row, int kb, int nbytes) { return TILED_A ? ((((size_t)(row >> 8) * (size_t)(nbytes >> 7) + (size_t)(kb >> 7)) * 256 + (size_t)(row & 255)) * 128 + (size_t)(kb & 127)) : ((size_t)row * nbytes + kb); }
#ifndef TILED_MIX
#define TILED_MIX 0
#endif
__device__ __forceinline__ size_t mix_off(int row, int col) { return TILED_MIX ? ((((size_t)(row >> 8) * 64 + (size_t)(col >> 6)) * 256 + (size_t)(row & 255)) * 64 + (size_t)(col & 63)) : ((size_t)row * D + col); }
__device__ __forceinline__ float wave_max(float v) {
#pragma unroll
    for (int o = 1; o < 64; o <<= 1) v = fmaxf(v, __shfl_xor(v, o));
    return v;
}
__device__ __forceinline__ unsigned pk4_i8(float a, float b, float c, float d) {
    const int qa = (int)__builtin_rintf(fminf(fmaxf(a, -127.f), 127.f)), qb = (int)__builtin_rintf(fminf(fmaxf(b, -127.f), 127.f)), qc = (int)__builtin_rintf(fminf(fmaxf(c, -127.f), 127.f)), qd = (int)__builtin_rintf(fminf(fmaxf(d, -127.f), 127.f));
    return ((unsigned)qa & 0xffu) | (((unsigned)qb & 0xffu) << 8) | (((unsigned)qc & 0xffu) << 16) | ((unsigned)qd << 24);
}
__device__ __forceinline__ void rms_row_to_bf16(const float* xrow, const float* g, bf16* orow, unsigned char* o8base, int m, float* rs, int lane) {
    const GAS f32x4* xr = (const GAS f32x4*)xrow + lane; const GAS f32x4* gr = (const GAS f32x4*)g + lane;
    f32x4 v[16]; float s = 0.f;
#pragma unroll
    for (int j = 0; j < 16; ++j) { v[j] = LD_STREAM(xr + 64 * j); s += (v[j].x * v[j].x + v[j].y * v[j].y) + (v[j].z * v[j].z + v[j].w * v[j].w); }
    const float rstd = 1.0f / sqrtf(wave_sum(s) * (1.f / D) + NORM_EPS);
    GAS v2u* o8 = (GAS v2u*)orow + lane; float am = 0.f;
#pragma unroll
    for (int j = 0; j < 16; ++j) { const f32x4 gg = gr[64 * j]; v[j].x *= rstd * gg.x; v[j].y *= rstd * gg.y; v[j].z *= rstd * gg.z; v[j].w *= rstd * gg.w;
        am = fmaxf(fmaxf(am, fmaxf(fabsf(v[j].x), fabsf(v[j].y))), fmaxf(fabsf(v[j].z), fabsf(v[j].w)));
        if (N16 > 0) { v2u o; o.x = pk2(v[j].x, v[j].y); o.y = pk2(v[j].z, v[j].w); o8[64 * j] = o; } }
    am = fmaxf(wave_max(am), 1e-30f); const float qs = 127.0f / am;
    if (lane == 0) rs[0] = am * (1.0f / 127.0f);
    GAS unsigned char* q8 = (GAS unsigned char*)(o8base + tile8_off(m, 4 * lane, D)); const size_t qstep = tile8_off(0, 256, D);
#pragma unroll
    for (int j = 0; j < 16; ++j) { *(GAS unsigned*)q8 = pk4_i8(v[j].x * qs, v[j].y * qs, v[j].z * qs, v[j].w * qs); q8 += qstep; }
}
__device__ __forceinline__ void p0_colmax_item(const float* W, int N, unsigned* cmax, int k0, int n0, int ncol0, int lane) {
    const int c = lane & 15, kq = lane >> 4;
    f32x4 mx = (f32x4){0.f, 0.f, 0.f, 0.f};
    for (int sb = 0; sb < 8; ++sb) { const float* src = W + (size_t)(k0 + 64 * sb + 4 * kq) * N + n0 + 4 * c;
#pragma unroll
        for (int i = 0; i < 16; ++i) { const f32x4 t = *(const GAS f32x4*)(src + (size_t)((i & 3) + 16 * (i >> 2)) * N);
            mx.x = fmaxf(mx.x, fabsf(t.x)); mx.y = fmaxf(mx.y, fabsf(t.y)); mx.z = fmaxf(mx.z, fabsf(t.z)); mx.w = fmaxf(mx.w, fabsf(t.w)); } }
#pragma unroll
    for (int j = 0; j < 4; ++j) { float t = mx[j]; t = fmaxf(t, __shfl_xor(t, 16)); t = fmaxf(t, __shfl_xor(t, 32)); mx[j] = t; }
    if (kq == 0) {
#pragma unroll
        for (int j = 0; j < 4; ++j) atomicMax(cmax + (n0 - ncol0) + 4 * c + j, __float_as_uint(mx[j])); }
}
__device__ __forceinline__ void p0_quant_item(const float* W, int K, int N, unsigned char* Wq, int out_row0, LAS unsigned char* scr, int k0, int n0, const unsigned* cmax, float* cs, int lane) {
    const int c = lane & 15, kq = lane >> 4;
    const float* src = W + (size_t)(k0 + 4 * kq) * N + n0 + 4 * c;
    f32x4 v[16];
#pragma unroll
    for (int i = 0; i < 16; ++i) v[i] = *(const GAS f32x4*)(src + (size_t)((i & 3) + 16 * (i >> 2)) * N);
    float qs[4];
#pragma unroll
    for (int j = 0; j < 4; ++j) { const float am = fmaxf(__uint_as_float(cmax[out_row0 + 4 * c + j]), 1e-30f); qs[j] = 127.0f / am; if (k0 == 0 && kq == 0) cs[out_row0 + 4 * c + j] = am * (1.0f / 127.0f); }
#pragma unroll
    for (int mb = 0; mb < 4; ++mb)
#pragma unroll
        for (int j = 0; j < 4; ++j) *(LAS unsigned*)(scr + (4 * c + j) * 68 + 16 * mb + 4 * kq) = pk4_i8(qs[j] * v[4 * mb + 0][j], qs[j] * v[4 * mb + 1][j], qs[j] * v[4 * mb + 2][j], qs[j] * v[4 * mb + 3][j]);
    LDS_WAIT(); asm volatile("" ::: "memory");
#pragma unroll
    for (int r = 0; r < 4; ++r) { const int n = (lane >> 2) + 16 * r; const LAS unsigned* p = (const LAS unsigned*)(scr + n * 68 + 16 * (lane & 3));
        v4u o; o.x = p[0]; o.y = p[1]; o.z = p[2]; o.w = p[3];
        const int orow = out_row0 + n;
        *(GAS v4u*)(Wq + ((((size_t)(orow >> 8) * (size_t)(K >> 7) + (size_t)(k0 >> 7)) * 256 + (size_t)(orow & 255)) * 128 + (size_t)(k0 & 127) + 16 * (lane & 3))) = o; }
    LDS_WAIT(); asm volatile("" ::: "memory");
}
#ifndef REGQ
#define REGQ (IN_INT8 == 2)
#endif
template <int ROWS>
__device__ __forceinline__ void q_load(Frame& F, const float* W, int N, int n0, int k0, unsigned* cmax, unsigned (&d)[ROWS / 4]) {
    constexpr int RW = ROWS / 8, NB = RW < 16 ? RW : 16;
    int lane = F.lane; asm volatile("" : "+v"(lane));
    const GAS unsigned char* src = (const GAS unsigned char*)(W + (size_t)(k0 + F.wave * RW) * N + n0);
    const unsigned lo = 16u * (unsigned)lane, rstep = 4u * (unsigned)N;
    f32x4 mx = (f32x4){0.f, 0.f, 0.f, 0.f};
#pragma unroll
    for (int ib = 0; ib < RW; ib += NB) {
        f32x4 v[NB];
#pragma unroll
        for (int i = 0; i < NB; ++i) v[i] = LD_STREAM((const GAS f32x4*)(src + (size_t)(ib + i) * rstep + lo));
#pragma unroll
        for (int i = 0; i < NB; ++i) {
            mx.x = fmaxf(mx.x, fabsf(v[i].x)); mx.y = fmaxf(mx.y, fabsf(v[i].y)); mx.z = fmaxf(mx.z, fabsf(v[i].z)); mx.w = fmaxf(mx.w, fabsf(v[i].w));
            d[2 * (ib + i)] = pk2x(v[i].x, v[i].y); d[2 * (ib + i) + 1] = pk2x(v[i].z, v[i].w); }
    }
    LAS float* red = (LAS float*)(F.lds + RING_OFF);
    *(LAS f32x4*)(red + F.wave * 256 + 4 * lane) = mx;
    __syncthreads();
    if (F.tid < 256) { float m = red[F.tid];
#pragma unroll
        for (int w = 1; w < NWAVES; ++w) m = fmaxf(m, red[w * 256 + F.tid]);
        atomicMax(cmax + F.tid, __float_as_uint(m)); }
}
template <int ROWS>
__device__ __forceinline__ void q_store(Frame& F, unsigned char* Wq, int panel, int k0, const unsigned* cmax, float* cs, const unsigned (&d)[ROWS / 4]) {
    constexpr int RW = ROWS / 8;
    int lane = F.lane; asm volatile("" : "+v"(lane));
    const v4u cm = *(const GAS v4u*)(cmax + 4 * lane);
    float qs[4]; f32x4 sc;
#pragma unroll
    for (int j = 0; j < 4; ++j) { const float am = fmaxf(__uint_as_float(cm[j]), 1e-30f); qs[j] = 127.0f / am; sc[j] = am * (1.0f / 127.0f); }
    if (k0 == 0 && F.wave == 0) *(GAS f32x4*)(cs + 4 * lane) = sc;
    const int k = k0 + F.wave * RW;
    GAS unsigned char* o = (GAS unsigned char*)Wq + (((size_t)panel * (D / 128) + (size_t)(k >> 7)) * 256 + (size_t)(4 * lane)) * 128 + (size_t)(k & 127);
#define QV(i, j) (qs[j] * (((j) & 1) ? bfhi(d[2 * (i) + ((j) >> 1)]) : bflo(d[2 * (i) + ((j) >> 1)])))
#pragma unroll
    for (int j = 0; j < 4; ++j) {
        if constexpr (RW >= 16) {
#pragma unroll
            for (int g = 0; g < RW / 16; ++g) { v4u o4;
#pragma unroll
                for (int q = 0; q < 4; ++q) o4[q] = pk4_i8(QV(16 * g + 4 * q, j), QV(16 * g + 4 * q + 1, j), QV(16 * g + 4 * q + 2, j), QV(16 * g + 4 * q + 3, j));
                *(GAS v4u*)(o + j * 128 + 16 * g) = o4; }
        } else { v2u o2; o2.x = pk4_i8(QV(0, j), QV(1, j), QV(2, j), QV(3, j)); o2.y = pk4_i8(QV(4, j), QV(5, j), QV(6, j), QV(7, j)); *(GAS v2u*)(o + j * 128) = o2; }
    }
#undef QV
}
template <int ROWS>
__device__ __forceinline__ void q_rounds(Frame& F, const Args& A, const XcdBarrier& bar, int gp0, int ngp) {
    constexpr int KB = D / ROWS, PIN = INW / 256;
    const int NT = ngp * KB;
    for (int t0 = 0; t0 < NT; t0 += F.G) {
        const int t = t0 + F.vcu; const bool act = t < NT;
        const int gp = gp0 + t / KB, k0 = (t % KB) * ROWS; const bool isin = gp < PIN; const int panel = isin ? gp : gp - PIN;
        unsigned* cmax = (unsigned*)(F.ctl + (isin ? CW_CMAXIN : CW_CMAXUP)) + 256 * panel;
        unsigned d[ROWS / 4];
        if (act) q_load<ROWS>(F, isin ? A.in[I_WIN] : A.in[I_WUP], isin ? INW : DFF, 256 * panel, k0, cmax, d);
        if (N_LAUNCHES == 1) xcd_barrier(bar);
        if (act) q_store<ROWS>(F, isin ? F.ws + WS_W8 : F.ws + WS_WUP, panel, k0, cmax, (float*)(F.ws + (isin ? WS_CSIN : WS_CSUP)) + 256 * panel, d);
    }
}
__device__ __forceinline__ void p0_quant_rounds(Frame& F, const Args& A, const XcdBarrier& bar) {
    static_assert((INW + DFF) / 256 == 116 && (!REGQ || N_LAUNCHES == 1), "panel split below; the tiles cross a grid barrier");
    __syncthreads();
    q_rounds<512>(F, A, bar, 0, 96);
    q_rounds<256>(F, A, bar, 96, 16);
    q_rounds<64>(F, A, bar, 112, 4);
}
__device__ __forceinline__ void s5_pow(double lre, double lim, double dt, int n, double& re, double& im) {
    const double mag = exp((double)n * dt * lre), ang = (double)n * dt * lim; double sn, cs; sincos(ang, &sn, &cs); re = mag * cs; im = mag * sn;
}
__device__ __forceinline__ void s5_coef(double lre, double lim, double dt, double& re, double& im) {
    double are, aim; s5_pow(lre, lim, dt, 1, are, aim); const double nr = are - 1.0, ni = aim, den = lre * lre + lim * lim;
    re = (nr * lre + ni * lim) / den; im = (ni * lre - nr * lim) / den;
}
__device__ __forceinline__ void p0_s5_item(Frame& F, const Args& A, int item) {
    const int lane = F.lane, p = lane;
    bf16* KTAB = (bf16*)(F.ws + WS_KTAB); bf16* BMAT = (bf16*)(F.ws + WS_BMAT); bf16* CMAT = (bf16*)(F.ws + WS_CMAT); float* AT = (float*)(F.ws + WS_AT);
    const int kind = item >> 11, r = item & 2047, g = (kind < 3) ? (r >> 5) : r, n = r & 31;
    const double lre = (double)A.in[I_LRE][g * SP + p], lim = (double)A.in[I_LIM][g * SP + p], dt = exp((double)A.in[I_LOGDT][g]);
    if (kind == 3) { double re, im; s5_pow(lre, lim, dt, TC, re, im); AT[(g * SP + p) * 2] = (float)re; AT[(g * SP + p) * 2 + 1] = (float)im; return; }
    if (kind == 2) {
        double wr, wi; s5_pow(lre, lim, dt, n + 1, wr, wi); const float wrf = (float)wr, wif = (float)wi;
#pragma unroll
        for (int h = 0; h < SGD; ++h) { const float cr = A.in[I_CRE][(g * SGD + h) * SP + p], ci = A.in[I_CIM][(g * SGD + h) * SP + p];
            bf16* row = CMAT + ((size_t)g * 512 + n * 16 + h) * 128;
            row[p] = (bf16)(pk2x(cr * wrf - ci * wif, 0.f) & 0xffffu); row[64 + p] = (bf16)(pk2x(-(cr * wif + ci * wrf), 0.f) & 0xffffu); }
        return;
    }
    double cre, cim; s5_coef(lre, lim, dt, cre, cim);
    if (kind == 1) {
        double ar, ai; s5_pow(lre, lim, dt, TC - 1 - n, ar, ai); const float wr = (float)(ar * cre - ai * cim), wi = (float)(ar * cim + ai * cre);
        float vr[16], vi[16];
#pragma unroll
        for (int h = 0; h < SGD; ++h) { const float br = A.in[I_BRE][(g * SP + p) * SGD + h], bi = A.in[I_BIM][(g * SP + p) * SGD + h]; vr[h] = wr * br - wi * bi; vi[h] = wr * bi + wi * br; }
        v4u o; bf16* rr = BMAT + ((size_t)g * 128 + p) * 512 + n * 16; bf16* ri = BMAT + ((size_t)g * 128 + 64 + p) * 512 + n * 16;
        o.x = pk2x(vr[0], vr[1]); o.y = pk2x(vr[2], vr[3]); o.z = pk2x(vr[4], vr[5]); o.w = pk2x(vr[6], vr[7]); *(v4u*)rr = o;
        o.x = pk2x(vr[8], vr[9]); o.y = pk2x(vr[10], vr[11]); o.z = pk2x(vr[12], vr[13]); o.w = pk2x(vr[14], vr[15]); *(v4u*)(rr + 8) = o;
        o.x = pk2x(vi[0], vi[1]); o.y = pk2x(vi[2], vi[3]); o.z = pk2x(vi[4], vi[5]); o.w = pk2x(vi[6], vi[7]); *(v4u*)ri = o;
        o.x = pk2x(vi[8], vi[9]); o.y = pk2x(vi[10], vi[11]); o.z = pk2x(vi[12], vi[13]); o.w = pk2x(vi[14], vi[15]); *(v4u*)(ri + 8) = o;
        return;
    }
    double ar, ai; s5_pow(lre, lim, dt, n, ar, ai); const float wr = (float)(ar * cre - ai * cim), wi = (float)(ar * cim + ai * cre);
    float vr[16], vi[16];
#pragma unroll
    for (int h = 0; h < SGD; ++h) { const float br = A.in[I_BRE][(g * SP + p) * SGD + h], bi = A.in[I_BIM][(g * SP + p) * SGD + h]; vr[h] = wr * br - wi * bi; vi[h] = wr * bi + wi * br; }
    float crs[16], cis[16];
#pragma unroll
    for (int h = 0; h < SGD; ++h) { crs[h] = A.in[I_CRE][(g * SGD + h) * SP + p]; cis[h] = A.in[I_CIM][(g * SGD + h) * SP + p]; }
    __builtin_amdgcn_sched_barrier(0);
#pragma unroll
    for (int h = 0; h < SGD; ++h) { const float cr = crs[h], ci = cis[h];
        float t8[8], t4[4], t2[2], mine;
#pragma unroll
        for (int i = 0; i < 8; ++i) { const float a = cr * vr[2 * i] - ci * vi[2 * i], b = cr * vr[2 * i + 1] - ci * vi[2 * i + 1]; const bool up = lane & 1; t8[i] = (up ? b : a) + __shfl_xor(up ? a : b, 1); }
#pragma unroll
        for (int i = 0; i < 4; ++i) { const bool up = lane & 2; t4[i] = (up ? t8[2 * i + 1] : t8[2 * i]) + __shfl_xor(up ? t8[2 * i] : t8[2 * i + 1], 2); }
#pragma unroll
        for (int i = 0; i < 2; ++i) { const bool up = lane & 4; t2[i] = (up ? t4[2 * i + 1] : t4[2 * i]) + __shfl_xor(up ? t4[2 * i] : t4[2 * i + 1], 4); }
        { const bool up = lane & 8; mine = (up ? t2[1] : t2[0]) + __shfl_xor(up ? t2[0] : t2[1], 8); }
        mine += __shfl_xor(mine, 16); mine += __shfl_xor(mine, 32);
        if (lane < SGD) { if (n == 0 && lane == h) mine += A.in[I_DSKIP][g * SGD + h]; KTAB[(((size_t)g * TC + n) * SGD + h) * SGD + lane] = (bf16)(pk2x(mine, 0.f) & 0xffffu); } }
}
__device__ __forceinline__ void p0_prologue(Frame& F, const Args& A) {
    LAS unsigned char* scr = F.lds + RING_OFF + F.wave * 16384;
#ifndef P0_S5WAVE
#define P0_S5WAVE 0
#endif
    constexpr int NSW = P0_S5WAVE ? NWAVES - 1 : NWAVES;
    if (P0_S5WAVE && F.wave == NWAVES - 1) { for (int it = F.vcu; it < 3 * 2048 + SG; it += F.G) p0_s5_item(F, A, it); return; }
    const int gw = F.vcu * NSW + F.wave, NGW = F.G * NSW;
    if (!P0_S5WAVE) for (int it = gw; it < 3 * 2048 + SG; it += NGW) p0_s5_item(F, A, it);
    { bf16* Hh = (bf16*)(F.ws + WS_ARB); float* RS1 = (float*)(F.ws + WS_RS1);
      for (int m = gw; m < M; m += NGW) rms_row_to_bf16(A.in[I_X] + (size_t)m * D, A.in[I_NMIXPRE], Hh + (size_t)m * D, F.ws + WS_H8, m, RS1 + m, F.lane); }
    constexpr int I_1 = (D / 64) * (N16 / 64), I_2 = (AW / 64) * (D / 64), I_3 = (BW / 64) * (D / 64), I_4 = I_3, I_5 = (D / 64) * (D / 64), I_7 = (DFF / 64) * (D / 64);
    constexpr int NITEMS = I_1 + I_2 + I_3 + I_4 + I_5 + I_7;
    for (int it = gw; it < NITEMS; it += NGW) {
        int r = it;
        if (r < I_1) { const int nblk = N16 > 0 ? N16 / 64 : 1, kb = r / nblk, nb = r % nblk; p0_transpose_item(A.in[I_WIN], D, INW, (bf16*)(F.ws + WS_WIN), 64 * nb, scr, 64 * kb, win_col16(64 * nb), F.lane); continue; } r -= I_1;
        if (r < I_2) { const int nblk = D / 64, kb = r / nblk, nb = r % nblk; p0_transpose_item(A.in[I_WPROJ], AW, D, (bf16*)(F.ws + WS_WPROJ), 64 * nb, scr, 64 * kb, 64 * nb, F.lane); continue; } r -= I_2;
        if (r < I_3) { const int nblk = D / 64, kb = r / nblk, nb = r % nblk, n0 = 64 * nb; p0_transpose_item(A.in[I_WGLUA], BW, D, (bf16*)(F.ws + WS_WGLU), (n0 >> 7) * 256 + (n0 & 127), scr, 64 * kb, n0, F.lane); continue; } r -= I_3;
        if (r < I_4) { const int nblk = D / 64, kb = r / nblk, nb = r % nblk, n0 = 64 * nb; p0_transpose_item(A.in[I_WGLUB], BW, D, (bf16*)(F.ws + WS_WGLU), (n0 >> 7) * 256 + 128 + (n0 & 127), scr, 64 * kb, n0, F.lane); continue; } r -= I_4;
        if (r < I_5) { const int nblk = D / 64, kb = r / nblk, nb = r % nblk; p0_transpose_item(A.in[I_WOUT], D, D, (bf16*)(F.ws + WS_WOUT), 64 * nb, scr, 64 * kb, 64 * nb, F.lane); continue; } r -= I_5;
        { const int nblk = D / 64, kb = r / nblk, nb = r % nblk; p0_transpose_item(A.in[I_WDN], DFF, D, (bf16*)(F.ws + WS_WDN), 64 * nb, scr, 64 * kb, 64 * nb, F.lane); }
    }
    if (!REGQ) { unsigned* CMI = (unsigned*)(F.ctl + CW_CMAXIN); unsigned* CMU = (unsigned*)(F.ctl + CW_CMAXUP);
      constexpr int C_1 = (NG8 / 64) * (D / 512), C_2 = (DFF / 64) * (D / 512);
      for (int it = gw; it < C_1 + C_2; it += NGW) {
          if (it < C_1) { const int nb = it % (NG8 / 64), kb = it / (NG8 / 64), n0 = win_col8(64 * nb); p0_colmax_item(A.in[I_WIN], INW, CMI, 512 * kb, n0, n0 - 64 * nb, F.lane); }
          else { const int r = it - C_1, nb = r % (DFF / 64), kb = r / (DFF / 64); p0_colmax_item(A.in[I_WUP], DFF, CMU, 512 * kb, 64 * nb, 0, F.lane); } } }
}
__device__ __forceinline__ void p0_quantize(Frame& F, const Args& A) {
    LAS unsigned char* scr = F.lds + RING_OFF + F.wave * 16384;
    const int gw = F.vcu * NWAVES + F.wave, NGW = F.G * NWAVES;
    const unsigned* CMI = (const unsigned*)(F.ctl + CW_CMAXIN); const unsigned* CMU = (const unsigned*)(F.ctl + CW_CMAXUP);
    constexpr int Q_1 = (D / 128) * (NG8 / 64), Q_2 = (D / 128) * (DFF / 64);
    for (int it0 = gw; it0 < Q_1 + Q_2; it0 += NGW) { const int it = Q_1 + Q_2 - 1 - it0;
        if (it < Q_1) { const int nblk = NG8 / 64, kb2 = it / nblk, nb = it % nblk;
            p0_quant_item(A.in[I_WIN], D, INW, F.ws + WS_W8, 64 * nb, scr, 128 * kb2, win_col8(64 * nb), CMI, (float*)(F.ws + WS_CSIN), F.lane);
            p0_quant_item(A.in[I_WIN], D, INW, F.ws + WS_W8, 64 * nb, scr, 128 * kb2 + 64, win_col8(64 * nb), CMI, (float*)(F.ws + WS_CSIN), F.lane); }
        else { const int r = it - Q_1, nblk = DFF / 64, kb2 = r / nblk, nb = r % nblk;
            p0_quant_item(A.in[I_WUP], D, DFF, F.ws + WS_WUP, 64 * nb, scr, 128 * kb2, 64 * nb, CMU, (float*)(F.ws + WS_CSUP), F.lane);
            p0_quant_item(A.in[I_WUP], D, DFF, F.ws + WS_WUP, 64 * nb, scr, 128 * kb2 + 64, 64 * nb, CMU, (float*)(F.ws + WS_CSUP), F.lane); }
    }
}

constexpr int SPG_VNT_STRIDE = 136, SPG_BUF_BYTES = 128 * SPG_VNT_STRIDE * 2;
constexpr int DUMP_OFF = RING_BYTES - 2048;
__device__ __forceinline__ void l2_touch(Frame& F, const void* p) { __builtin_amdgcn_global_load_lds((const unsigned*)p, (LAS unsigned*)(F.lds + DUMP_OFF + F.wave * 256), 4, 0, 0); }
#ifndef SPG_H0
#define SPG_H0 9
#endif
__device__ __forceinline__ void spatial_unit(Frame& F, const Args& A, int unit) {
    const int c = unit >> 1, hh = unit & 1, lane = F.lane, w = F.wave, h0 = hh ? SPG_H0 : 0, nheads = hh ? AH - SPG_H0 : SPG_H0;
    const bf16* UA = (const bf16*)(F.ws + WS_UA); const bf16* VA = (const bf16*)(F.ws + WS_VA); bf16* SA = (bf16*)(F.ws + WS_ARB);
    const float* VST = (const float*)(F.ws + WS_PART);
    const size_t tok0 = (size_t)c * ACH;
    const int fr = lane & 15, fq = lane >> 4, trow = 16 * w + fr;
    const int sfill = 64 * (w & 1) + lane, c8b = 4 * (w >> 1);
    float mean, rstd;
    { const GAS f32x4* p = (const GAS f32x4*)(VST + (tok0 + sfill) * 64); float s1 = 0.f, s2 = 0.f;
#pragma unroll
      for (int j = 0; j < 16; ++j) { const f32x4 t = p[j]; s1 += t.x + t.z; s2 += t.y + t.w; }
      mean = s1 * (1.f / AW); const float var = fmaxf(s2 * (1.f / AW) - mean * mean, 0.f); rstd = 1.0f / sqrtf(var + NORM_EPS); }
    const bf16* vsrc = TILED_A ? VA + ((size_t)c * 16 * 128 + sfill) * 128 + 8 * c8b : VA + (tok0 + sfill) * AW + 8 * c8b; const size_t hstr = TILED_A ? (size_t)128 * 128 : (size_t)AHD;
    LAS float* gl = (LAS float*)(F.lds + 2 * SPG_BUF_BYTES); LAS float* bl = gl + 9 * AHD;
    if (F.tid < nheads * (AHD / 4)) { const f32x4 gv = ((const GAS f32x4*)(A.in[I_VNG] + h0 * AHD))[F.tid], bv = ((const GAS f32x4*)(A.in[I_VNB] + h0 * AHD))[F.tid]; ((LAS f32x4*)gl)[F.tid] = gv; ((LAS f32x4*)bl)[F.tid] = bv; }
    const int nks = (w + 2) >> 1;
    v4u vreg[4]; f32x4 wv[4][2]; v2u uu[8]; float bsp;
#define SPG_FETCH(hh_) do { const int hq = (hh_); \
        _Pragma("unroll") for (int i = 0; i < 4; ++i) vreg[i] = LD_STREAM((const GAS v4u*)(vsrc + hq * hstr + 8 * i)); \
        const float* Wrow = A.in[I_WSP] + ((size_t)hq * ACH + trow) * ACH + 8 * fq; \
        _Pragma("unroll") for (int ks = 0; ks < 4; ++ks) if (ks < nks) { wv[ks][0] = *(const GAS f32x4*)(Wrow + 32 * ks); wv[ks][1] = *(const GAS f32x4*)(Wrow + 32 * ks + 4); } \
        const bf16* urow = TILED_A ? UA + (((size_t)c * 16 + hq) * 128 + trow) * 128 + 4 * fq : UA + (tok0 + trow) * AW + hq * AHD + 4 * fq; \
        _Pragma("unroll") for (int n = 0; n < 8; ++n) uu[n] = LD_STREAM((const GAS v2u*)(urow + 16 * n)); \
        bsp = A.in[I_BSP][hq * ACH + trow]; } while (0)
    SPG_FETCH(h0);
    __syncthreads();
#pragma unroll 1
    for (int hi = 0; hi < nheads; ++hi) { const int h = h0 + hi;
        LAS bf16* vnT = (LAS bf16*)(F.lds + (hi & 1) * SPG_BUF_BYTES);
#pragma unroll
        for (int i = 0; i < 4; ++i) { const int c8 = c8b + i; const v4u x = vreg[i];
            const float e[8] = {bflo(x.x), bfhi(x.x), bflo(x.y), bfhi(x.y), bflo(x.z), bfhi(x.z), bflo(x.w), bfhi(x.w)};
            const f32x4 g0 = *(const LAS f32x4*)(gl + hi * AHD + 8 * c8), g1 = *(const LAS f32x4*)(gl + hi * AHD + 8 * c8 + 4), b0 = *(const LAS f32x4*)(bl + hi * AHD + 8 * c8), b1 = *(const LAS f32x4*)(bl + hi * AHD + 8 * c8 + 4);
            const float gg[8] = {g0.x, g0.y, g0.z, g0.w, g1.x, g1.y, g1.z, g1.w}, bb[8] = {b0.x, b0.y, b0.z, b0.w, b1.x, b1.y, b1.z, b1.w};
#pragma unroll
            for (int j = 0; j < 8; ++j) { const float y = (e[j] - mean) * rstd * gg[j] + bb[j]; vnT[(8 * c8 + j) * SPG_VNT_STRIDE + sfill] = (bf16)(pk2x(y, 0.f) & 0xffffu); } }
        v4u wb[4];
#pragma unroll
        for (int ks = 0; ks < 4; ++ks) if (ks < nks) { const int s0 = 32 * ks + 8 * fq;
            float wvv[8] = {wv[ks][0].x, wv[ks][0].y, wv[ks][0].z, wv[ks][0].w, wv[ks][1].x, wv[ks][1].y, wv[ks][1].z, wv[ks][1].w};
#pragma unroll
            for (int j = 0; j < 8; ++j) wvv[j] = (s0 + j <= trow) ? wvv[j] : 0.f;
            wb[ks].x = pk2x(wvv[0], wvv[1]); wb[ks].y = pk2x(wvv[2], wvv[3]); wb[ks].z = pk2x(wvv[4], wvv[5]); wb[ks].w = pk2x(wvv[6], wvv[7]); }
        v2u uc[8];
#pragma unroll
        for (int n = 0; n < 8; ++n) uc[n] = uu[n];
        const float bc = bsp; const int srow_t = (int)(tok0 + trow), scol = h * AHD + 4 * fq;
        __builtin_amdgcn_sched_barrier(0);
        if (hi + 1 < nheads) SPG_FETCH(h + 1);
        __syncthreads();
        f32x4 acc[8];
#pragma unroll
        for (int n = 0; n < 8; ++n) acc[n] = (f32x4){0.f, 0.f, 0.f, 0.f};
#pragma unroll
        for (int ks = 0; ks < 4; ++ks) if (ks < nks) { const int s0 = 32 * ks + 8 * fq; const bf16x8 bfrag = __builtin_bit_cast(bf16x8, wb[ks]);
#pragma unroll
            for (int n = 0; n < 8; ++n) { const bf16x8 afrag = *(const LAS bf16x8*)(vnT + (16 * n + fr) * SPG_VNT_STRIDE + s0);
                acc[n] = __builtin_amdgcn_mfma_f32_16x16x32_bf16(afrag, bfrag, acc[n], 0, 0, 0); } }
#pragma unroll
        for (int n = 0; n < 8; ++n) { const v2u u2 = uc[n]; v2u o;
            o.x = pk2x(bflo(u2.x) * (acc[n][0] + bc), bfhi(u2.x) * (acc[n][1] + bc)); o.y = pk2x(bflo(u2.y) * (acc[n][2] + bc), bfhi(u2.y) * (acc[n][3] + bc)); *(GAS v2u*)(SA + tile16_off(srow_t, scol + 16 * n, AW)) = o; }
    }
#undef SPG_FETCH
    __syncthreads();
}

constexpr int S5_KT_OFF = 0;
constexpr int S5_E_OFF = 17408;
constexpr int S5_S_OFF = S5_E_OFF + 128 * 65 * 4;
constexpr int S5_S_STRIDE = 136;
static_assert(S5_S_OFF + 128 * S5_S_STRIDE * 2 <= RING_BYTES - 2048, "S5 LDS");
#ifndef S5_PF
#define S5_PF 1
#endif
#ifndef S5_SB3
#define S5_SB3 0
#endif
__device__ __forceinline__ void s5_unit(Frame& F, int unit, int part = 3) {
    const int q = unit & 1, g = (unit >> 1) & 63, b = unit >> 7, tid = F.tid, lane = F.lane, w = F.wave, fr = lane & 15, fq = lane >> 4;
    const bf16* KTAB = (const bf16*)(F.ws + WS_KTAB) + (size_t)g * TC * 256; const bf16* BMAT = (const bf16*)(F.ws + WS_BMAT) + (size_t)g * 128 * 512;
    const bf16* CMAT = (const bf16*)(F.ws + WS_CMAT) + (size_t)g * 512 * 128; const float* AT = (const float*)(F.ws + WS_AT) + g * SP * 2;
    const bf16* XB = (const bf16*)(F.ws + WS_XB2) + ((size_t)g * NCH + (size_t)b * NCHB) * 512;
    bf16* ZB = (bf16*)(F.ws + WS_ZB);
    LAS unsigned char* kt = F.lds + S5_KT_OFF; LAS float* Eb = (LAS float*)(F.lds + S5_E_OFF); LAS bf16* Sb = (LAS bf16*)(F.lds + S5_S_OFF);
    if (S5_PF && (part & 1)) { l2_touch(F, (const unsigned char*)XB + (size_t)tid * 128); l2_touch(F, (const unsigned char*)XB + 65536 + (size_t)tid * 128); }
    if (tid < 32) *(LAS v4u*)(kt + tid * 16) = (v4u){0u, 0u, 0u, 0u};
#pragma unroll
    for (int i = 0; i < 2; ++i) { const int pc = tid + 512 * i; *(LAS v4u*)(kt + 512 + pc * 16) = *(const GAS v4u*)(KTAB + pc * 8); }
    if (part & 1) {
        bf16x8 af[16];
#pragma unroll
        for (int kk = 0; kk < 16; ++kk) af[kk] = *(const GAS bf16x8*)(BMAT + (size_t)(16 * w + fr) * 512 + 32 * kk + 8 * fq);
        float sre = 0.f, sim = 0.f; const float are = AT[2 * lane], aim = AT[2 * lane + 1];
        const int nblk = 2 * (q + 1);
        bf16x8 ba[16], bb[16];
        { const bf16* xr = XB + (size_t)fr * 512 + 8 * fq;
#pragma unroll
          for (int kk = 0; kk < 16; ++kk) ba[kk] = *(const GAS bf16x8*)(xr + 32 * kk); }
        for (int blk = 0; blk < nblk; ++blk) {
#pragma unroll
            for (int nt = 0; nt < 4; ++nt) {
                { int tn = 4 * blk + nt + 1; tn = tn < 4 * nblk ? tn : 4 * nblk - 1;
                  const bf16* xn = XB + (size_t)(16 * tn + fr) * 512 + 8 * fq;
#pragma unroll
                  for (int kk = 0; kk < 16; ++kk) { if (nt & 1) ba[kk] = *(const GAS bf16x8*)(xn + 32 * kk); else bb[kk] = *(const GAS bf16x8*)(xn + 32 * kk); } }
                __builtin_amdgcn_sched_barrier(0);
                f32x4 acc = (f32x4){0.f, 0.f, 0.f, 0.f};
#pragma unroll
                for (int kk = 0; kk < 16; ++kk) acc = __builtin_amdgcn_mfma_f32_16x16x32_bf16(af[kk], (nt & 1) ? bb[kk] : ba[kk], acc, 0, 0, 0);
#pragma unroll
                for (int r = 0; r < 4; ++r) Eb[(16 * w + 4 * fq + r) * 65 + 16 * nt + fr] = acc[r];
                __builtin_amdgcn_sched_barrier(0); }
            if (S5_PF && blk + 2 < nblk) l2_touch(F, (const unsigned char*)XB + (size_t)(blk + 2) * 65536 + (size_t)tid * 128);
            __syncthreads();
            if (w == 0) {
                const bool wr_s = 64 * blk >= 128 * q;
#pragma unroll 1
                for (int j0 = 0; j0 < 64; j0 += 16) { float er[16], ei[16];
#pragma unroll
                    for (int i = 0; i < 16; ++i) { er[i] = Eb[lane * 65 + j0 + i]; ei[i] = Eb[(64 + lane) * 65 + j0 + i]; }
                    LAS bf16* sp = Sb + (64 * blk + j0 - 128 * q) * S5_S_STRIDE + lane;
#pragma unroll
                    for (int i = 0; i < 16; ++i) {
                        if (wr_s) { sp[i * S5_S_STRIDE] = (bf16)(pk2x(sre, 0.f) & 0xffffu); sp[i * S5_S_STRIDE + 64] = (bf16)(pk2x(sim, 0.f) & 0xffffu); }
                        const float nr = are * sre - aim * sim + er[i], ni = are * sim + aim * sre + ei[i]; sre = nr; sim = ni; } }
            }
            __syncthreads();
        }
    }
#ifndef S5_V3
#define S5_V3 1
#endif
#if S5_V3
    if (part & 2) {
        const bf16* xr = XB + (size_t)(128 * q + 16 * w + fr) * 512 + 8 * fq;
        bf16x8 bf[16], sf[4], cfa[4], cfb[4];
#pragma unroll
        for (int kk = 0; kk < 16; ++kk) bf[kk] = *(const GAS bf16x8*)(xr + 32 * kk);
        const bf16* cmp = CMAT + (size_t)fr * 128 + 8 * fq;
#pragma unroll
        for (int kk = 0; kk < 4; ++kk) cfa[kk] = *(const GAS bf16x8*)(cmp + 32 * kk);
#pragma unroll
        for (int kk = 0; kk < 4; ++kk) sf[kk] = *(const LAS bf16x8*)(Sb + (16 * w + fr) * S5_S_STRIDE + 32 * kk + 8 * fq);
        const int ktl = 512 - (lane >> 5) * 512 + fr * 32 + (fq & 1) * 16;
        const size_t tok0 = (size_t)b * SEQ + (size_t)(128 * q + 16 * w + fr) * TC;
#pragma unroll
        for (int mt = 0; mt < 32; ++mt) {
            if (mt + 1 < 32) {
#pragma unroll
                for (int kk = 0; kk < 4; ++kk) cfb[kk] = *(const GAS bf16x8*)(cmp + (size_t)(16 * (mt + 1)) * 128 + 32 * kk); }
            f32x4 acc = (f32x4){0.f, 0.f, 0.f, 0.f};
#pragma unroll
            for (int kk = 0; kk <= mt / 2; ++kk) { const bf16x8 afrag = *(const LAS bf16x8*)(kt + ktl + (mt - 2 * kk) * 512); acc = __builtin_amdgcn_mfma_f32_16x16x32_bf16(afrag, bf[kk], acc, 0, 0, 0); }
#pragma unroll
            for (int kk = 0; kk < 4; ++kk) acc = __builtin_amdgcn_mfma_f32_16x16x32_bf16(cfa[kk], sf[kk], acc, 0, 0, 0);
            v2u o; o.x = pk2x(gelu_t(acc[0]), gelu_t(acc[1])); o.y = pk2x(gelu_t(acc[2]), gelu_t(acc[3]));
            *(GAS v2u*)(ZB + tile16_off((int)(tok0 + mt), g * SGD + 4 * fq, BW)) = o;
#pragma unroll
            for (int kk = 0; kk < 4; ++kk) cfa[kk] = cfb[kk];
        }
    }
#else
    const int mts[4] = {w, 15 - w, 16 + w, 31 - w};
    bf16x8 cf[4][4];
#pragma unroll
    for (int i = 0; i < 4; ++i)
#pragma unroll
        for (int kk = 0; kk < 4; ++kk) cf[i][kk] = *(const GAS bf16x8*)(CMAT + (size_t)(16 * mts[i] + fr) * 128 + 32 * kk + 8 * fq);
    const int ktl = 512 - (lane >> 5) * 512 + fr * 32 + (fq & 1) * 16;
#pragma unroll 1
    for (int nt = 0; nt < ((part & 2) ? 8 : 0); ++nt) {
        const bf16* xr = XB + (size_t)(128 * q + 16 * nt + fr) * 512 + 8 * fq;
        f32x4 acc[4];
#pragma unroll
        for (int i = 0; i < 4; ++i) acc[i] = (f32x4){0.f, 0.f, 0.f, 0.f};
        { bf16x8 bf[16];
#pragma unroll
            for (int kk = 0; kk < 16; ++kk) bf[kk] = *(const GAS bf16x8*)(xr + 32 * kk);
#if S5_SB3
            __builtin_amdgcn_sched_barrier(0);
#endif
#pragma unroll
            for (int kk = 0; kk < 16; ++kk) {
#pragma unroll
                for (int i = 0; i < 4; ++i) { const int d0 = mts[i] - 2 * kk;
                    if (d0 >= 0) { const bf16x8 afrag = *(const LAS bf16x8*)(kt + ktl + d0 * 512); acc[i] = __builtin_amdgcn_mfma_f32_16x16x32_bf16(afrag, bf[kk], acc[i], 0, 0, 0); } }
                asm volatile("" ::: "memory"); } }
#pragma unroll
        for (int kk = 0; kk < 4; ++kk) { const bf16x8 sfrag = *(const LAS bf16x8*)(Sb + (16 * nt + fr) * S5_S_STRIDE + 32 * kk + 8 * fq);
#pragma unroll
            for (int i = 0; i < 4; ++i) acc[i] = __builtin_amdgcn_mfma_f32_16x16x32_bf16(cf[i][kk], sfrag, acc[i], 0, 0, 0); }
#pragma unroll
        for (int i = 0; i < 4; ++i) { const size_t tok = (size_t)b * SEQ + (size_t)(128 * q + 16 * nt + fr) * TC + mts[i];
            v2u o; o.x = pk2x(gelu_t(acc[i][0]), gelu_t(acc[i][1])); o.y = pk2x(gelu_t(acc[i][2]), gelu_t(acc[i][3]));
            *(GAS v2u*)(ZB + tile16_off((int)tok, g * SGD + 4 * fq, BW)) = o; }
    }
#endif
    __syncthreads();
}

#ifndef X1_BF16
#define X1_BF16 1
#endif
__device__ __forceinline__ void n1_load(Frame& F, const Args& A, int m, f32x4 (&xv)[16], float& pv) {
    const int lane = F.lane; const GAS f32x4* xr = (const GAS f32x4*)(A.in[I_X] + (size_t)m * D) + lane;
    pv = ((const float*)(F.ws + WS_PART) + (size_t)m * 64)[lane];
#pragma unroll
    for (int j = 0; j < 16; ++j) xv[j] = LD_STREAM(xr + 64 * j);
}
__device__ __forceinline__ void n1_mix(Frame& F, int m, v2u (&mv)[16]) {
    const int lane = F.lane;
    const GAS bf16* mixp = (const GAS bf16*)((const bf16*)(F.ws + WS_ARB) + mix_off(m, 4 * lane)); const size_t mstep = mix_off(0, 256);
#pragma unroll
    for (int j = 0; j < 16; ++j) { mv[j] = LD_STREAM((const GAS v2u*)mixp); mixp += mstep; }
}
__device__ __forceinline__ void n1_proc(Frame& F, const Args& A, int m, f32x4 (&v)[16], v2u (&mv)[16], float pv) {
    const int lane = F.lane; const float rstd1 = 1.0f / sqrtf(wave_sum(pv) * (1.f / D) + NORM_EPS);
    const LAS f32x4* g1 = (const LAS f32x4*)(F.lds + RING_OFF) + lane; const LAS f32x4* g2 = (const LAS f32x4*)(F.lds + RING_OFF + D * 4) + lane;
    GAS f32x4* orow = (GAS f32x4*)(F.out + (size_t)m * D) + lane; GAS v2u* x1row = (GAS v2u*)(F.out + (size_t)m * D + D / 2) + lane;
    float s = 0.f;
#pragma unroll
    for (int j = 0; j < 16; ++j) { const f32x4 gg = g1[64 * j]; const v2u mm = mv[j];
        v[j].x += bflo(mm.x) * rstd1 * gg.x; v[j].y += bfhi(mm.x) * rstd1 * gg.y; v[j].z += bflo(mm.y) * rstd1 * gg.z; v[j].w += bfhi(mm.y) * rstd1 * gg.w;
        s += (v[j].x * v[j].x + v[j].y * v[j].y) + (v[j].z * v[j].z + v[j].w * v[j].w);
        if (X1_BF16) { v2u o; o.x = pk2x(v[j].x, v[j].y); o.y = pk2x(v[j].z, v[j].w); ST_STREAM(x1row + 64 * j, o); } else orow[64 * j] = v[j];
        asm volatile("" ::: "memory"); }
    const float rstd2 = 1.0f / sqrtf(wave_sum(s) * (1.f / D) + NORM_EPS);
    float am = 0.f;
#pragma unroll
    for (int j = 0; j < 16; ++j) { const f32x4 gg = g2[64 * j]; v[j].x *= rstd2 * gg.x; v[j].y *= rstd2 * gg.y; v[j].z *= rstd2 * gg.z; v[j].w *= rstd2 * gg.w;
        am = fmaxf(fmaxf(am, fmaxf(fabsf(v[j].x), fabsf(v[j].y))), fmaxf(fabsf(v[j].z), fabsf(v[j].w))); asm volatile("" ::: "memory"); }
    am = fmaxf(wave_max(am), 1e-30f); const float qs = 127.0f / am;
    if (lane == 0) ((float*)(F.ws + WS_RS2))[m] = am * (1.0f / 127.0f);
    GAS unsigned char* q8 = (GAS unsigned char*)(F.ws + WS_H2Q + tile8_off(m, 4 * lane, D)); const size_t qstep = tile8_off(0, 256, D);
#pragma unroll
    for (int j = 0; j < 16; ++j) { *(GAS unsigned*)q8 = pk4_i8(v[j].x * qs, v[j].y * qs, v[j].z * qs, v[j].w * qs); q8 += qstep; }
}
__device__ __forceinline__ void n1_phase(Frame& F, const Args& A) {
    const int gw = F.vcu * NWAVES + F.wave, NGW = F.G * NWAVES;
    for (int i = F.tid; i < D / 4; i += NWAVES * 64) { ((LAS f32x4*)(F.lds + RING_OFF))[i] = ((const GAS f32x4*)A.in[I_NMIXPOST])[i]; ((LAS f32x4*)(F.lds + RING_OFF + D * 4))[i] = ((const GAS f32x4*)A.in[I_NMLPPRE])[i]; }
    __syncthreads();
    f32x4 xa[16], xb[16]; v2u mv[16]; float pa = 0.f, pb = 0.f;
    if (gw < M) n1_load(F, A, gw, xa, pa);
    for (int m = gw; m < M; m += 2 * NGW) {
        const int m1 = m + NGW < M ? m + NGW : m, m2 = m + 2 * NGW < M ? m + 2 * NGW : m1;
        n1_mix(F, m, mv);
        n1_load(F, A, m1, xb, pb);
        n1_proc(F, A, m, xa, mv, pa);
        if (m + NGW < M) {
            n1_mix(F, m1, mv);
            n1_load(F, A, m2, xa, pa);
            n1_proc(F, A, m1, xb, mv, pb); }
    }
}
#if X1_BF16
typedef v2u x1v_t;
#else
typedef f32x4 x1v_t;
#endif
#ifndef ROWS_BATCH
#define ROWS_BATCH 1
#endif
__device__ __forceinline__ void n2_load(Frame& F, int m, x1v_t (&xv)[16], v2u (&fv)[16], float& pv) {
    const int lane = F.lane; const GAS x1v_t* xr = (const GAS x1v_t*)(F.out + (size_t)m * D + (X1_BF16 ? D / 2 : 0)) + lane;
    pv = ((const float*)(F.ws + WS_PART) + (size_t)m * 64)[lane];
#pragma unroll
    for (int j = 0; j < 16; ++j) xv[j] = LD_STREAM(xr + 64 * j);
    const GAS bf16* ffp = (const GAS bf16*)((const bf16*)(F.ws + WS_ARB) + mix_off(m, 4 * lane)); const size_t fstep = mix_off(0, 256);
#pragma unroll
    for (int j = 0; j < 16; ++j) { fv[j] = LD_STREAM((const GAS v2u*)ffp); ffp += fstep; }
}
__device__ __forceinline__ void n2_proc(Frame& F, const Args& A, int m, x1v_t (&v)[16], v2u (&fv)[16], float pv) {
    const int lane = F.lane; const float rstd = 1.0f / sqrtf(wave_sum(pv) * (1.f / D) + NORM_EPS);
    const LAS f32x4* g1 = (const LAS f32x4*)(F.lds + RING_OFF) + lane; GAS f32x4* orow = (GAS f32x4*)(F.out + (size_t)m * D) + lane;
#pragma unroll
    for (int j = 0; j < 16; ++j) { const f32x4 gg = g1[64 * j]; const v2u mm = fv[j]; f32x4 x;
#if X1_BF16
        x.x = bflo(v[j].x); x.y = bfhi(v[j].x); x.z = bflo(v[j].y); x.w = bfhi(v[j].y);
#else
        x = v[j];
#endif
        x.x += bflo(mm.x) * rstd * gg.x; x.y += bfhi(mm.x) * rstd * gg.y; x.z += bflo(mm.y) * rstd * gg.z; x.w += bfhi(mm.y) * rstd * gg.w; ST_STREAM(orow + 64 * j, x); }
}
__device__ __forceinline__ void n2_phase(Frame& F, const Args& A) {
    const int gw = F.vcu * NWAVES + F.wave, NGW = F.G * NWAVES;
    for (int i = F.tid; i < D / 4; i += NWAVES * 64) ((LAS f32x4*)(F.lds + RING_OFF))[i] = ((const GAS f32x4*)A.in[I_NMLPPOST])[i];
    __syncthreads();
    x1v_t xa[16], xb[16]; v2u fa[16], fb[16]; float pa = 0.f, pb = 0.f;
    if (gw < M) n2_load(F, gw, xa, fa, pa);
    for (int m = gw; m < M; m += 2 * NGW) {
        const int m1 = m + NGW < M ? m + NGW : m, m2 = m + 2 * NGW < M ? m + 2 * NGW : m1;
        n2_load(F, m1, xb, fb, pb);
        n2_proc(F, A, m, xa, fa, pa);
        if (m + NGW < M) {
            n2_load(F, m2, xa, fa, pa);
            n2_proc(F, A, m1, xb, fb, pb); }
    }
}

__global__ void __launch_bounds__(NWAVES * 64, 2) mk_fwd(Args args) {
    extern __shared__ __attribute__((aligned(16))) unsigned char lds[];
    Frame F;
    F.lds = (LAS unsigned char*)lds;
    F.MISC = (volatile LAS unsigned*)(F.lds + MISC_OFF);
    F.tid = threadIdx.x; F.lane = F.tid & 63; F.wave = __builtin_amdgcn_readfirstlane(F.tid >> 6);
    F.G = gridDim.x; { const int bx = blockIdx.x; F.vcu = (F.G % 8 == 0) ? (bx % 8) * (F.G / 8) + bx / 8 : bx; }
    F.ws = args.ws; F.out = args.out;
    F.ctl = (gu32*)(F.ws + WS_CTL);
    for (int u = F.tid; u < (LDS_BYTES - LDSCTL_OFF) / 4; u += NWAVES * 64) ((LAS unsigned*)(F.lds + LDSCTL_OFF))[u] = 0u;
    __syncthreads();
    XcdBarrier bar; bar.bar = (unsigned*)(F.ctl + CW_BAR); bar.x = 0; bar.st = nullptr;
    if (N_LAUNCHES == 1) bar = xcd_barrier_post((unsigned*)(F.ctl + CW_BAR), F.MISC + 8);
#define GRID_BAR() do { if (N_LAUNCHES == 1) xcd_barrier(bar); } while (0)
    const int lo = args.ph_lo, hi = args.ph_hi;
#ifndef PH_MASK
#define PH_MASK 0x3ff
#endif
#define IN(k) (((PH_MASK >> (k)) & 1) && lo <= (k) && (k) < hi)
#define BOTH(k) (IN(k) && IN((k) + 1))
#ifndef DUP_MASK
#define DUP_MASK 0
#endif
#define NREP(k) (((DUP_MASK >> (k)) & 1) ? 2 : 1)
    unsigned char* ws = F.ws;
    bf16* ARB = (bf16*)(ws + WS_ARB);

    if (IN(0)) {
_Pragma("unroll")
        for (int rep = 0; rep < NREP(0); ++rep) { p0_prologue(F, args); if (REGQ) p0_quant_rounds(F, args, bar); else { GRID_BAR(); p0_quantize(F, args); } if (BOTH(0) || rep + 1 < NREP(0)) GRID_BAR(); }
    }

    if (IN(1)) {
_Pragma("unroll")
      for (int rep = 0; rep < NREP(1); ++rep) {
        if (N16 > 0) { pg8::Gemm g{ARB, (const bf16*)(ws + WS_WIN), M, N16, D}; pg8::StaticOrder S; S.init(M, N16, F.G, (int)blockIdx.x);
          pg8::EpiIn E{(bf16*)(ws + WS_UA), (bf16*)(ws + WS_VA), (bf16*)(ws + WS_XB2), (bf16*)(ws + WS_GA), (bf16*)(ws + WS_GB), (float*)(ws + WS_PART), 8, 0, 8, nullptr, nullptr, TILED_A};
          pg8::gemm_phase<pg8::EpiIn, pg8::StaticOrder, PG8_ALIGN, PG8_SP2, false, 0, false, true>(F.lds + RING_OFF, g, S, E); }
        { pg8::Gemm g{(const bf16*)(ws + WS_H8), (const bf16*)(ws + WS_W8), M, NG8, D / 2}; pg8::StaticOrder S; S.init(M, NG8, F.G, (int)blockIdx.x);
          pg8::EpiIn E{(bf16*)(ws + WS_UA), (bf16*)(ws + WS_VA), (bf16*)(ws + WS_XB2), (bf16*)(ws + WS_GA), (bf16*)(ws + WS_GB), (float*)(ws + WS_PART), IN_INT8 == 2 ? 0 : 8, IN_INT8 == 2 ? 0 : 8, IN_INT8 == 2 ? 0 : IN_INT8 == 1 ? 8 : 12, (const float*)(ws + WS_RS1), (const float*)(ws + WS_CSIN), TILED_A};
          pg8::gemm_phase<pg8::EpiIn, pg8::StaticOrder, I8_ALIGN, I8_SP2, true, 0, TILED_A, true>(F.lds + RING_OFF, g, S, E); }
        if (BOTH(1) || rep + 1 < NREP(1)) GRID_BAR();
      }
    }

    if (IN(2)) {
_Pragma("unroll")
      for (int rep = 0; rep < NREP(2); ++rep) {
#ifndef SPG_REP
#define SPG_REP 1
#endif
#ifndef S5_REP
#define S5_REP 1
#endif
#ifndef S5_PART
#define S5_PART 3
#endif
_Pragma("unroll 1")
        for (int u = F.vcu; u < 256 * SPG_REP; u += F.G) { spatial_unit(F, args, u & 255); if (SPG_REP > 1) __syncthreads(); }
        __syncthreads();
_Pragma("unroll 1")
        for (int u = F.vcu; u < 256 * S5_REP; u += F.G) { s5_unit(F, u & 255, u < 256 ? 3 : S5_PART); if (S5_REP > 1) __syncthreads(); }
        if (BOTH(2) || rep + 1 < NREP(2)) GRID_BAR();
      }
    }

    if (IN(3)) {
_Pragma("unroll")
      for (int rep = 0; rep < NREP(3); ++rep) {
        pg8::Gemm g{(const bf16*)(ws + WS_ZB), (const bf16*)(ws + WS_WGLU), M, 2 * D, BW}; pg8::StaticOrder S; S.init(M, 2 * D, F.G, (int)blockIdx.x, P345_WGM);
        pg8::EpiGlu E{(bf16*)(ws + WS_GB), TILED_A};
        pg8::gemm_phase<pg8::EpiGlu, pg8::StaticOrder, PG8_ALIGN, PG8_SP2, false, 0, TILED_A, true>(F.lds + RING_OFF, g, S, E);
        if (BOTH(3) || rep + 1 < NREP(3)) GRID_BAR();
      }
    }

    if (IN(4)) {
_Pragma("unroll")
      for (int rep = 0; rep < NREP(4); ++rep) {
        pg8::Gemm g{ARB, (const bf16*)(ws + WS_WPROJ), M, D, AW}; pg8::StaticOrder S; S.init(M, D, F.G, (int)blockIdx.x, P345_WGM);
        pg8::EpiProj E{(bf16*)(ws + WS_GA), (const bf16*)(ws + WS_GB), TILED_A};
        pg8::gemm_phase<pg8::EpiProj, pg8::StaticOrder, PG8_ALIGN, PG8_SP2, false, 0, TILED_A, true>(F.lds + RING_OFF, g, S, E);
        if (BOTH(4) || rep + 1 < NREP(4)) GRID_BAR();
      }
    }

    if (IN(5)) {
_Pragma("unroll")
      for (int rep = 0; rep < NREP(5); ++rep) {
        pg8::Gemm g{(const bf16*)(ws + WS_GA), (const bf16*)(ws + WS_WOUT), M, D, D}; pg8::StaticOrder S; S.init(M, D, F.G, (int)blockIdx.x, P345_WGM);
        pg8::EpiStat E{ARB, (float*)(ws + WS_PART), TILED_MIX};
        pg8::gemm_phase<pg8::EpiStat, pg8::StaticOrder, PG8_ALIGN, PG8_SP2, false, 0, TILED_A, true>(F.lds + RING_OFF, g, S, E);
        if (BOTH(5) || rep + 1 < NREP(5)) GRID_BAR();
      }
    }

    if (IN(6)) {
_Pragma("unroll")
      for (int rep = 0; rep < NREP(6); ++rep) {
        n1_phase(F, args);
        if (BOTH(6) || rep + 1 < NREP(6)) GRID_BAR();
      }
    }

    if (IN(7)) {
_Pragma("unroll")
      for (int rep = 0; rep < NREP(7); ++rep) {
        pg8::Gemm g{(const bf16*)(ws + WS_H2Q), (const bf16*)(ws + WS_WUP), M, DFF, D / 2}; pg8::StaticOrder S; S.init(M, DFF, F.G, (int)blockIdx.x, P7_WGM);
        pg8::EpiUp E{(bf16*)(ws + WS_ARA), (const float*)(ws + WS_RS2), (const float*)(ws + WS_CSUP), TILED_HID};
        pg8::gemm_phase<pg8::EpiUp, pg8::StaticOrder, I8_ALIGN, I8_SP2, true, 0, TILED_A, true>(F.lds + RING_OFF, g, S, E);
        if (BOTH(7) || rep + 1 < NREP(7)) GRID_BAR();
      }
    }

    if (IN(8)) {
_Pragma("unroll")
      for (int rep = 0; rep < NREP(8); ++rep) {
        pg8::Gemm g{(const bf16*)(ws + WS_ARA), (const bf16*)(ws + WS_WDN), M, D, DFF}; pg8::StaticOrder S; S.init(M, D, F.G, (int)blockIdx.x, P8_WGM);
        pg8::EpiStat E{ARB, (float*)(ws + WS_PART), TILED_MIX};
        pg8::gemm_phase<pg8::EpiStat, pg8::StaticOrder, PG8_ALIGN, PG8_SP2, false, P8_AUXA, TILED_HID != 0, true>(F.lds + RING_OFF, g, S, E);
        if (BOTH(8) || rep + 1 < NREP(8)) GRID_BAR();
      }
    }

    if (IN(9)) {
_Pragma("unroll")
      for (int rep = 0; rep < NREP(9); ++rep) {
        n2_phase(F, args);
        if (rep + 1 < NREP(9)) GRID_BAR();
      }
    }
#undef IN
#undef BOTH
}

extern "C" void kernel_launch(void* const* d_in, const int* in_sizes, int n_in, void* d_out, int out_size, void* d_ws, size_t ws_size, hipStream_t stream) {
    static int grid = 0;
    if (grid == 0) {
        if (n_in != 24 || in_sizes[0] != M * D || out_size != M * D || ws_size < WS_END) { fprintf(stderr, "kernel_launch: unexpected shapes / workspace (n_in %d, ws %zu < %zu)\n", n_in, ws_size, (size_t)WS_END); grid = -1; return; }
        int dev = 0, cus = 0, per_cu = 0;
        if (hipGetDevice(&dev) != hipSuccess || hipDeviceGetAttribute(&cus, hipDeviceAttributeMultiprocessorCount, dev) != hipSuccess) { grid = -1; return; }
        if (hipFuncSetAttribute((const void*)mk_fwd, hipFuncAttributeMaxDynamicSharedMemorySize, LDS_BYTES) != hipSuccess) { grid = -1; return; }
        if (hipOccupancyMaxActiveBlocksPerMultiprocessor(&per_cu, (const void*)mk_fwd, NWAVES * 64, LDS_BYTES) != hipSuccess || per_cu < 1) { fprintf(stderr, "kernel_launch: occupancy query says %d\n", per_cu); }
        (void)hipGetLastError();
        grid = cus;
    }
    if (grid < 0) return;
    if (hipMemsetAsync((char*)d_ws + WS_CTL, 0, CTL_ZERO_BYTES, stream) != hipSuccess) return;
    Args a{};
    for (int i = 0; i < 24; ++i) a.in[i] = (const float*)d_in[i];
    a.out = (float*)d_out; a.ws = (unsigned char*)d_ws;
    if (N_LAUNCHES == 1) { a.ph_lo = 0; a.ph_hi = N_PHASES; hipLaunchKernelGGL(mk_fwd, dim3(grid), dim3(NWAVES * 64), LDS_BYTES, stream, a); }
    else for (int li = 0; li < N_PHASES; ++li) { a.ph_lo = li; a.ph_hi = li + 1; hipLaunchKernelGGL(mk_fwd, dim3(grid), dim3(NWAVES * 64), LDS_BYTES, stream, a); }
}
```

```cpp
#include <hip/hip_runtime.h>
#include <cstdio>
#include <cstdint>

#ifndef MK_N_LAUNCHES
#define MK_N_LAUNCHES 1
#endif
namespace pg8 {
#define PG8_LAS __attribute__((address_space(3)))
typedef unsigned short bf16_t;
typedef short bf16x8 __attribute__((ext_vector_type(8)));
typedef float f32x4 __attribute__((ext_vector_type(4)));
typedef unsigned u32x4 __attribute__((ext_vector_type(4)));
typedef int v4i_t __attribute__((ext_vector_type(4)));
typedef int v8i_t __attribute__((ext_vector_type(8)));
constexpr int BM = 256, BK = 64, HALF = 128, HTB = HALF * BK * 2  , STAGE_BYTES = 8 * HTB, NXCD = 8, WGM = 8;

__host__ __device__ __forceinline__ int lds_byte(int r, int c) { const int st = (r >> 4) * 2 + (c >> 5), rr = r & 15, cc = c & 31, ob = rr * 64 + cc * 2; return st * 1024 + (ob ^ (((ob >> 9) & 1) << 5)); }
__host__ __device__ __forceinline__ void stage_rc(int b, int& R, int& C) { const int st = b / 1024, sb = b % 1024, swz = sb ^ (((sb >> 9) & 1) << 5); R = (st >> 1) * 16 + swz / 64; C = (st & 1) * 32 + (swz % 64) / 2; }
__host__ __device__ __forceinline__ int perm32(int rho) { const int n = rho >> 4, i = rho & 15; return 8 * (i >> 2) + 4 * n + (i & 3); }

struct Unit { int pm, pn; };
struct Gemm { const bf16_t* A; const bf16_t* Bt; int M, N, K; };

struct StaticOrder {
    int nM, nN, nwg, G, c, wgm;
    __host__ __device__ void init(int M, int N, int G_, int c_, int wgm_ = WGM) { nM = M / BM; nN = N / BM; nwg = nM * nN; G = G_; c = c_; wgm = wgm_; }
    __host__ __device__ __forceinline__ bool next(int i, Unit& u) const {
        const long L = (long)i * G + c; if (L >= nwg) return false;
        int wgid = (int)L; { const int q = nwg / NXCD, r = nwg % NXCD, xcd = wgid % NXCD, off = wgid / NXCD; wgid = (xcd < r ? xcd * (q + 1) : r * (q + 1) + (xcd - r) * q) + off; }
        const int nig = wgm * nN, gid = wgid / nig, fm = gid * wgm, gsz = (nM - fm) < wgm ? (nM - fm) : wgm;
        u.pm = fm + ((wgid % nig) % gsz); u.pn = (wgid % nig) / gsz; return true;
    }
    __device__ __forceinline__ void a_ready(const Unit&) const {}
    __device__ __forceinline__ void done(const Unit&) const {}
};

__device__ __forceinline__ unsigned cvt_pk_bf16(float lo, float hi) { unsigned r; asm volatile("v_cvt_pk_bf16_f32 %0, %1, %2" : "=v"(r) : "v"(lo), "v"(hi)); return r; }
#ifndef MANT6
#define MANT6 0
#endif
__device__ __forceinline__ unsigned cvt_pk_op(float lo, float hi) {
#if MANT6
    unsigned a = __float_as_uint(lo), b = __float_as_uint(hi); a += 0xFFFFu + ((a >> 17) & 1u); b += 0xFFFFu + ((b >> 17) & 1u); return ((a >> 16) & 0xFFFEu) | (b & 0xFFFE0000u);
#else
    return cvt_pk_bf16(lo, hi);
#endif
}
typedef float f32x2 __attribute__((ext_vector_type(2)));
__device__ __forceinline__ f32x2 gelu_pk(f32x2 v) {
    const f32x2 av = __builtin_elementwise_abs(v), d = av * 0.2316418882f + 1.0f;
    f32x2 t; t.x = __builtin_amdgcn_rcpf(d.x); t.y = __builtin_amdgcn_rcpf(d.y);
    f32x2 q = t * 0.5307027145f + (-0.7265760135f); q = q * t + 0.7107068705f; q = q * t + (-0.142248368f); q = q * t + 0.127414796f; q = q * t;
    const f32x2 s = (v * v) * (-0.72134752044f);
    f32x2 e; e.x = __builtin_amdgcn_exp2f(s.x); e.y = __builtin_amdgcn_exp2f(s.y);
    const f32x2 m = v * (q * e), r = v - m;
    f32x2 o; o.x = v.x < 0.f ? m.x : r.x; o.y = v.y < 0.f ? m.y : r.y; return o;
}

typedef unsigned u32x2 __attribute__((ext_vector_type(2)));
#ifndef UP_NT
#define UP_NT 0
#endif
#if UP_NT
#define UP_STORE(p, v) __builtin_nontemporal_store((v), (p))
#else
#define UP_STORE(p, v) (*(p) = (v))
#endif
#ifndef EPI_NT
#define EPI_NT 0
#endif
#if EPI_NT
#define NT_STORE(p, v) __builtin_nontemporal_store((v), (p))
#else
#define NT_STORE(p, v) (*(p) = (v))
#endif
__device__ __forceinline__ float sigmoid_f(float x) { return __builtin_amdgcn_rcpf(1.0f + __builtin_amdgcn_exp2f(-1.4426950409f * x)); }
__device__ __forceinline__ float gelu_tanh_f(float x) { const float u = x * (1.0f + 0.044715f * x * x); return x * __builtin_amdgcn_rcpf(1.0f + __builtin_amdgcn_exp2f(-2.3022082f * u)); }
__device__ __forceinline__ float bf_lo(unsigned w) { return __uint_as_float(w << 16); }
__device__ __forceinline__ float bf_hi(unsigned w) { return __uint_as_float(w & 0xffff0000u); }
__device__ __forceinline__ u32x4 pack8(const f32x4& v0, const f32x4& v1) { u32x4 w; w.x = cvt_pk_op(v0[0], v0[1]); w.y = cvt_pk_op(v0[2], v0[3]); w.z = cvt_pk_op(v1[0], v1[1]); w.w = cvt_pk_op(v1[2], v1[3]); return w; }
__device__ __forceinline__ u32x4 pack8f(const f32x4& v0, const f32x4& v1) { u32x4 w; w.x = cvt_pk_bf16(v0[0], v0[1]); w.y = cvt_pk_bf16(v0[2], v0[3]); w.z = cvt_pk_bf16(v1[0], v1[1]); w.w = cvt_pk_bf16(v1[2], v1[3]); return w; }

__device__ __forceinline__ size_t t4096_off(bool tiled, int row, int c) { return tiled ? ((((size_t)(row >> 8) * 64 + (size_t)(c >> 6)) * 256 + (size_t)(row & 255)) * 64 + (size_t)(c & 63)) : ((size_t)row * 4096 + c); }
struct EpiIn {
    static constexpr bool PERM = true, AFTER_DRAIN = false;
    bf16_t *UA, *VA, *XB2, *GA, *GB; float* VST; int split, off_lo, off_hi; const float* rs; const float* cs; int ga_tiled;
    __device__ __forceinline__ void operator()(const f32x4 (&acc)[2][2][4][2], const Unit& u, int wr, int wc, int fr, int fq) const {
        const int row0 = u.pm * BM + wr * 64 + fr; const int pn = u.pn + (u.pn < split ? off_lo : off_hi);
        int mode, ldc, colt; bf16_t* base;
        if (pn < 8) { mode = 0; base = UA; ldc = 2048; colt = pn * 256; }
        else if (pn < 16) { mode = 0; base = VA; ldc = 2048; colt = (pn - 8) * 256; }
        else if (pn < 20) { mode = 1; base = XB2; ldc = 0; colt = (pn - 16) * 256; }
        else if (pn < 36) { mode = 2; base = GA; ldc = 4096; colt = (pn - 20) * 256; }
        else { mode = 2; base = GB; ldc = 4096; colt = (pn - 36) * 256; }
        const int col0 = colt + wc * 32 + 8 * fq; const bool vstat = (pn >= 8 && pn < 16); const bool q8 = (rs != nullptr);
        f32x4 csv[2][2];
        if (q8) {
#pragma unroll
            for (int bj = 0; bj < 2; ++bj) { const float* cp = cs + u.pn * BM + wc * 32 + 8 * fq + bj * HALF; csv[bj][0] = *(const f32x4*)cp; csv[bj][1] = *(const f32x4*)(cp + 4); } }
        float rsa[2][4];
#pragma unroll
        for (int ai = 0; ai < 2; ++ai)
#pragma unroll
            for (int m = 0; m < 4; ++m) rsa[ai][m] = q8 ? rs[row0 + ai * HALF + m * 16] : 1.0f;
        __builtin_amdgcn_sched_barrier(0);
#pragma unroll
        for (int ai = 0; ai < 2; ++ai)
#pragma unroll
            for (int m = 0; m < 4; ++m) { const int row = row0 + ai * HALF + m * 16; float s1 = 0.f, s2 = 0.f; const float rsv = rsa[ai][m];
#pragma unroll
                for (int bj = 0; bj < 2; ++bj) { f32x4 v0 = acc[ai][bj][m][0], v1 = acc[ai][bj][m][1]; const int c = col0 + bj * HALF;
                    if (q8) {
#pragma unroll
                        for (int j = 0; j < 4; ++j) { v0[j] = (float)__float_as_int(v0[j]) * (rsv * csv[bj][0][j]); v1[j] = (float)__float_as_int(v1[j]) * (rsv * csv[bj][1][j]); } }
                    if (mode == 0) {
#pragma unroll
                        for (int j = 0; j < 4; ++j) { v0[j] = gelu_tanh_f(v0[j]); v1[j] = gelu_tanh_f(v1[j]); }
                        if (vstat) { s1 += ((v0[0] + v0[1]) + (v0[2] + v0[3])) + ((v1[0] + v1[1]) + (v1[2] + v1[3]));
                            s2 += ((v0[0] * v0[0] + v0[1] * v0[1]) + (v0[2] * v0[2] + v0[3] * v0[3])) + ((v1[0] * v1[0] + v1[1] * v1[1]) + (v1[2] * v1[2] + v1[3] * v1[3])); } }
                    else if (mode == 2) {
#pragma unroll
                        for (int j = 0; j < 4; ++j) { v0[j] = sigmoid_f(v0[j]); v1[j] = sigmoid_f(v1[j]); } }
                    bf16_t* p;
                    if (mode == 1) p = base + ((((size_t)(c >> 4) * 512 + (size_t)(row >> 5)) * 32 + (size_t)(row & 31)) * 16 + (size_t)(c & 15));
                    else if (mode == 0 && ga_tiled) p = base + ((((size_t)(row >> 7) * 16 + (size_t)(c >> 7)) * 128 + (size_t)(row & 127)) * 128 + (size_t)(c & 127));
                    else if (mode == 2) p = base + t4096_off(ga_tiled != 0, row, c);
                    else p = base + (size_t)row * ldc + c;
                    NT_STORE((u32x4*)p, pack8(v0, v1)); }
                if (vstat) { s1 += __shfl_xor(s1, 16); s1 += __shfl_xor(s1, 32); s2 += __shfl_xor(s2, 16); s2 += __shfl_xor(s2, 32);
                    if (fq == 0) { f32x2 o; o.x = s1; o.y = s2; *(f32x2*)(VST + ((size_t)row * 32 + (pn - 8) * 4 + wc) * 2) = o; } } }
    }
};
#ifndef EPI_NT_LD
#define EPI_NT_LD 1
#endif
#if EPI_NT_LD
#define EPI_LD1(p) __builtin_nontemporal_load(p)
#else
#define EPI_LD1(p) (*(p))
#endif
struct EpiGlu {
    static constexpr bool PERM = true, AFTER_DRAIN = false;
    bf16_t* GBm; int gb_tiled;
    __device__ __forceinline__ void operator()(const f32x4 (&acc)[2][2][4][2], const Unit& u, int wr, int wc, int fr, int fq) const {
        const int row0 = u.pm * BM + wr * 64 + fr, oc0 = u.pn * 128 + wc * 32 + 8 * fq;
        u32x4 ga[2][4];
#pragma unroll
        for (int ai = 0; ai < 2; ++ai)
#pragma unroll
            for (int m = 0; m < 4; ++m) ga[ai][m] = EPI_LD1((const u32x4*)(GBm + t4096_off(gb_tiled != 0, row0 + ai * HALF + m * 16, oc0)));
        __builtin_amdgcn_sched_barrier(0);
#pragma unroll
        for (int ai = 0; ai < 2; ++ai)
#pragma unroll
            for (int m = 0; m < 4; ++m) { bf16_t* p = GBm + t4096_off(gb_tiled != 0, row0 + ai * HALF + m * 16, oc0); const u32x4 g = ga[ai][m];
                const f32x4 a0 = acc[ai][0][m][0], a1 = acc[ai][0][m][1], b0 = acc[ai][1][m][0], b1 = acc[ai][1][m][1]; f32x4 o0, o1;
                o0[0] = a0[0] * sigmoid_f(b0[0]) * bf_lo(g.x); o0[1] = a0[1] * sigmoid_f(b0[1]) * bf_hi(g.x); o0[2] = a0[2] * sigmoid_f(b0[2]) * bf_lo(g.y); o0[3] = a0[3] * sigmoid_f(b0[3]) * bf_hi(g.y);
                o1[0] = a1[0] * sigmoid_f(b1[0]) * bf_lo(g.z); o1[1] = a1[1] * sigmoid_f(b1[1]) * bf_hi(g.z); o1[2] = a1[2] * sigmoid_f(b1[2]) * bf_lo(g.w); o1[3] = a1[3] * sigmoid_f(b1[3]) * bf_hi(g.w);
                *(u32x4*)p = pack8(o0, o1); }
    }
};
struct EpiProj {
    static constexpr bool PERM = true, AFTER_DRAIN = false;
    bf16_t* GA; const bf16_t* GBm; int ga_tiled;
    __device__ __forceinline__ void operator()(const f32x4 (&acc)[2][2][4][2], const Unit& u, int wr, int wc, int fr, int fq) const {
        const int row0 = u.pm * BM + wr * 64 + fr, col0 = u.pn * BM + wc * 32 + 8 * fq;
#pragma unroll
        for (int ai = 0; ai < 2; ++ai) {
            u32x4 gav[4][2], gbv[4][2];
#pragma unroll
            for (int m = 0; m < 4; ++m)
#pragma unroll
                for (int bj = 0; bj < 2; ++bj) { const int rr = row0 + ai * HALF + m * 16, cc = col0 + bj * HALF;
                    const bf16_t* gap = ga_tiled ? GA + ((((size_t)(rr >> 8) * 64 + (size_t)(cc >> 6)) * 256 + (size_t)(rr & 255)) * 64 + (size_t)(cc & 63)) : GA + (size_t)rr * 4096 + cc;
                    gav[m][bj] = EPI_LD1((const u32x4*)gap); gbv[m][bj] = EPI_LD1((const u32x4*)(GBm + t4096_off(ga_tiled != 0, rr, cc))); }
            __builtin_amdgcn_sched_barrier(0);
#pragma unroll
            for (int m = 0; m < 4; ++m) { const size_t off = (size_t)(row0 + ai * HALF + m * 16) * 4096 + col0;
#pragma unroll
                for (int bj = 0; bj < 2; ++bj) { const int rr = row0 + ai * HALF + m * 16, cc = col0 + bj * HALF;
                    bf16_t* gap = ga_tiled ? GA + ((((size_t)(rr >> 8) * 64 + (size_t)(cc >> 6)) * 256 + (size_t)(rr & 255)) * 64 + (size_t)(cc & 63)) : GA + off + bj * HALF;
                    const u32x4 ga = gav[m][bj], gb = gbv[m][bj];
                    const f32x4 a0 = acc[ai][bj][m][0], a1 = acc[ai][bj][m][1]; f32x4 o0, o1;
                    o0[0] = a0[0] * bf_lo(ga.x) + bf_lo(gb.x); o0[1] = a0[1] * bf_hi(ga.x) + bf_hi(gb.x); o0[2] = a0[2] * bf_lo(ga.y) + bf_lo(gb.y); o0[3] = a0[3] * bf_hi(ga.y) + bf_hi(gb.y);
                    o1[0] = a1[0] * bf_lo(ga.z) + bf_lo(gb.z); o1[1] = a1[1] * bf_hi(ga.z) + bf_hi(gb.z); o1[2] = a1[2] * bf_lo(ga.w) + bf_lo(gb.w); o1[3] = a1[3] * bf_hi(ga.w) + bf_hi(gb.w);
                    *(u32x4*)gap = pack8(o0, o1); } } }
    }
};
struct EpiStat {
    static constexpr bool PERM = true, AFTER_DRAIN = false;
    bf16_t* O; float* part; int tiled;
    __device__ __forceinline__ void operator()(const f32x4 (&acc)[2][2][4][2], const Unit& u, int wr, int wc, int fr, int fq) const {
        const int row0 = u.pm * BM + wr * 64 + fr, col0 = u.pn * BM + wc * 32 + 8 * fq;
#pragma unroll
        for (int ai = 0; ai < 2; ++ai)
#pragma unroll
            for (int m = 0; m < 4; ++m) { const int row = row0 + ai * HALF + m * 16; float s = 0.f;
#pragma unroll
                for (int bj = 0; bj < 2; ++bj) { const f32x4 v0 = acc[ai][bj][m][0], v1 = acc[ai][bj][m][1];
                    s += (v0[0] * v0[0] + v0[1] * v0[1]) + (v0[2] * v0[2] + v0[3] * v0[3]) + (v1[0] * v1[0] + v1[1] * v1[1]) + (v1[2] * v1[2] + v1[3] * v1[3]);
                    *(u32x4*)(O + t4096_off(tiled != 0, row, col0 + bj * HALF)) = pack8f(v0, v1); }
                s += __shfl_xor(s, 16); s += __shfl_xor(s, 32);
                if (fq == 0) part[(size_t)row * 64 + u.pn * 4 + wc] = s; }
    }
};
struct EpiUp {
    static constexpr bool PERM = true, AFTER_DRAIN = false;
    bf16_t* H; const float* rs; const float* cs; int tiled;
    __device__ __forceinline__ void operator()(const f32x4 (&acc)[2][2][4][2], const Unit& u, int wr, int wc, int fr, int fq) const {
        const int row0 = u.pm * BM + wr * 64 + fr, col0 = u.pn * BM + wc * 32 + 8 * fq; const bool q8 = (rs != nullptr);
        f32x4 csv[2][2];
        if (q8) {
#pragma unroll
            for (int bj = 0; bj < 2; ++bj) { const float* cp = cs + col0 + bj * HALF; csv[bj][0] = *(const f32x4*)cp; csv[bj][1] = *(const f32x4*)(cp + 4); } }
        float rsa[2][4];
#pragma unroll
        for (int ai = 0; ai < 2; ++ai)
#pragma unroll
            for (int m = 0; m < 4; ++m) rsa[ai][m] = q8 ? rs[row0 + ai * HALF + m * 16] : 1.0f;
        __builtin_amdgcn_sched_barrier(0);
#pragma unroll
        for (int ai = 0; ai < 2; ++ai)
#pragma unroll
            for (int m = 0; m < 4; ++m) { const int row = row0 + ai * HALF + m * 16; const float rsv = rsa[ai][m];
                bf16_t* rowp = tiled ? H + (((size_t)u.pm * 256 + (size_t)(u.pn * 4 + (wc >> 1))) * 256 + (size_t)(row & 255)) * 64 + (wc & 1) * 32 + 8 * fq : H + (size_t)row * 16384 + col0;
#pragma unroll
                for (int bj = 0; bj < 2; ++bj) { f32x4 v0 = acc[ai][bj][m][0], v1 = acc[ai][bj][m][1];
                    if (q8) {
#pragma unroll
                        for (int j = 0; j < 4; ++j) { v0[j] = (float)__float_as_int(v0[j]) * (rsv * csv[bj][0][j]); v1[j] = (float)__float_as_int(v1[j]) * (rsv * csv[bj][1][j]); } }
#pragma unroll
                    for (int j = 0; j < 4; ++j) { const float a = fmaxf(v0[j], 0.f), b = fmaxf(v1[j], 0.f); v0[j] = a * a; v1[j] = b * b; }
                    UP_STORE((u32x4*)(rowp + (tiled ? bj * 2 * 256 * 64 : bj * HALF)), pack8(v0, v1)); } }
    }
};

template <class Epi, class Sched, bool ALIGN_EPI = false, bool SP2 = false, bool I8 = false, int AUXA = 0, bool TA = false, bool TB = false>
__device__ __forceinline__ void gemm_phase(PG8_LAS unsigned char* lds, const Gemm g, const Sched& S, const Epi& E) {
    const int tid = threadIdx.x, wid = __builtin_amdgcn_readfirstlane(tid >> 6), lane = tid & 63, wr = wid >> 2, wc = wid & 3, fr = lane & 15, fq = lane >> 4;
    const int K = g.K, nt = K / BK;
    unsigned voffA[2], voffB[2];
#pragma unroll
    for (int i = 0; i < 2; ++i) { int R, C; stage_rc(tid * 16 + i * 8192, R, C); const int Rb = Epi::PERM ? ((R & ~31) + perm32(R & 31)) : R;
        voffA[i] = (unsigned)(R * (TA ? BK : K) + C) * 2u; voffB[i] = (unsigned)(Rb * (TB ? BK : K) + C) * 2u; }
    const size_t kstepA = TA ? (size_t)BM * BK * 2 : (size_t)(BK * 2), kstepB = TB ? (size_t)BM * BK * 2 : (size_t)(BK * 2);
    const size_t hstepA = TA ? (size_t)HALF * BK * 2 : (size_t)HALF * K * 2, hstepB = TB ? (size_t)HALF * BK * 2 : (size_t)HALF * K * 2;
    const size_t hstep = (size_t)HALF * K * 2;
    const size_t tstep = 2 * hstep;
    const unsigned ldsw = (unsigned)wid * 1024u;
    const int aoff = lds_byte(wr * 64 + fr, fq * 8), boff = lds_byte(wc * 32 + fr, fq * 8);
#define PG8_SA(b, h) (((b) * 2 + (h)) * HTB)
#define PG8_SB(b, h) ((4 + (b) * 2 + (h)) * HTB)
#define PG8_STAGE(bufoff, gbase, voff) do { _Pragma("unroll") for (int _i = 0; _i < 2; ++_i) \
        __builtin_amdgcn_global_load_lds((const unsigned*)((const char*)(gbase) + (voff)[_i]), (PG8_LAS unsigned*)(lds + (bufoff) + ldsw + _i * 8192), 16, 0, 0); } while (0)
#define PG8_STAGEA(bufoff, gbase, voff) do { _Pragma("unroll") for (int _i = 0; _i < 2; ++_i) \
        __builtin_amdgcn_global_load_lds((const unsigned*)((const char*)(gbase) + (voff)[_i]), (PG8_LAS unsigned*)(lds + (bufoff) + ldsw + _i * 8192), 16, 0, AUXA); } while (0)
#define PG8_LDA(dst, b, h) do { _Pragma("unroll") for (int m = 0; m < 4; ++m) _Pragma("unroll") for (int k = 0; k < 2; ++k) dst[m][k] = *(const PG8_LAS bf16x8*)(lds + PG8_SA(b, h) + aoff + m * 2048 + k * 1024); } while (0)
#define PG8_LDB(dst, b, h) do { _Pragma("unroll") for (int n = 0; n < 2; ++n) _Pragma("unroll") for (int k = 0; k < 2; ++k) dst[n][k] = *(const PG8_LAS bf16x8*)(lds + PG8_SB(b, h) + boff + n * 2048 + k * 1024); } while (0)
#define PG8_MMA(ai, bj, At, Bt) do { __builtin_amdgcn_s_setprio(1); _Pragma("unroll") for (int m = 0; m < 4; ++m) _Pragma("unroll") for (int n = 0; n < 2; ++n) _Pragma("unroll") for (int k = 0; k < 2; ++k) { \
        if constexpr (I8) { acc[ai][bj][m][n] = __builtin_bit_cast(f32x4, __builtin_amdgcn_mfma_i32_16x16x64_i8(__builtin_bit_cast(v4i_t, Bt[n][k]), __builtin_bit_cast(v4i_t, At[m][k]), __builtin_bit_cast(v4i_t, acc[ai][bj][m][n]), 0, 0, 0)); } \
        else acc[ai][bj][m][n] = __builtin_amdgcn_mfma_f32_16x16x32_bf16(Bt[n][k], At[m][k], acc[ai][bj][m][n], 0, 0, 0); } __builtin_amdgcn_s_setprio(0); } while (0)
#define PG8_WAIT_V(n) asm volatile("s_waitcnt vmcnt(" #n ")" ::: "memory")
#define PG8_WAIT_L(n) asm volatile("s_waitcnt lgkmcnt(" #n ")" ::: "memory")
#define PG8_BAR __builtin_amdgcn_s_barrier()
#define PG8_SCHED __builtin_amdgcn_sched_barrier(0)
    Unit cur, nxt; int ui = 0;
    if (!S.next(0, cur)) return;
    f32x4 acc[2][2][4][2];
#pragma unroll
    for (int a = 0; a < 2; ++a)
#pragma unroll
        for (int b = 0; b < 2; ++b)
#pragma unroll
            for (int m = 0; m < 4; ++m)
#pragma unroll
                for (int n = 0; n < 2; ++n) acc[a][b][m][n] = (f32x4){0.f, 0.f, 0.f, 0.f};
    bf16x8 At[4][2], B0[2][2], B1[2][2];
    const char* cA = (const char*)g.A + (size_t)cur.pm * tstep; const char* cB = (const char*)g.Bt + (size_t)cur.pn * tstep;
    S.a_ready(cur);
    if constexpr (SP2) {
        PG8_STAGE(PG8_SB(0, 0), cB, voffB); PG8_STAGE(PG8_SB(0, 1), cB + hstepB, voffB); PG8_STAGEA(PG8_SA(0, 0), cA, voffA); PG8_STAGEA(PG8_SA(0, 1), cA + hstepA, voffA);
        if (wr == 1) PG8_BAR;
        PG8_WAIT_V(2); PG8_BAR;
        PG8_STAGE(PG8_SB(1, 0), cB + kstepB, voffB); PG8_STAGEA(PG8_SA(1, 0), cA + kstepA, voffA); PG8_STAGE(PG8_SB(1, 1), cB + hstepB + kstepB, voffB);
        PG8_WAIT_V(6); PG8_BAR;
    } else {
        PG8_STAGE(PG8_SB(0, 0), cB, voffB); PG8_STAGEA(PG8_SA(0, 0), cA, voffA); PG8_STAGE(PG8_SB(0, 1), cB + hstepB, voffB); PG8_STAGEA(PG8_SA(0, 1), cA + hstepA, voffA);
        if (wr == 1) PG8_BAR;
        PG8_WAIT_V(4); PG8_BAR;
        PG8_STAGE(PG8_SB(1, 0), cB + kstepB, voffB); PG8_STAGEA(PG8_SA(1, 0), cA + kstepA, voffA); PG8_STAGE(PG8_SB(1, 1), cB + hstepB + kstepB, voffB);
        PG8_WAIT_V(6); PG8_BAR;
    }
    for (;;) {
        const bool has_next = S.next(ui + 1, nxt);
        const char* nA = has_next ? (const char*)g.A + (size_t)nxt.pm * tstep : cA; const char* nB = has_next ? (const char*)g.Bt + (size_t)nxt.pn * tstep : cB;
        for (int t = 0; t < nt; t += 2) {
            const bool last = (t == nt - 2);
            const char* a1 = cA + (size_t)(t + 1) * kstepA;
            const char* a2 = last ? nA : cA + (size_t)(t + 2) * kstepA; const char* b2 = last ? nB : cB + (size_t)(t + 2) * kstepB;
            const char* a3 = a2 + kstepA; const char* b3 = b2 + kstepB;
            if (last && has_next) S.a_ready(nxt);
            if constexpr (SP2) {
            PG8_LDB(B0, 0, 0); PG8_LDB(B1, 0, 1); PG8_SCHED; PG8_LDA(At, 0, 0); PG8_STAGEA(PG8_SA(1, 1), a1 + hstepA, voffA);
            PG8_WAIT_V(8); PG8_WAIT_L(0); PG8_BAR; PG8_MMA(0, 0, At, B0); PG8_MMA(0, 1, At, B1); PG8_BAR; PG8_SCHED;
            PG8_LDA(At, 0, 1); PG8_STAGE(PG8_SB(0, 0), b2, voffB); PG8_STAGE(PG8_SB(0, 1), b2 + hstepB, voffB); PG8_STAGEA(PG8_SA(0, 0), a2, voffA);
            PG8_WAIT_V(8); PG8_WAIT_L(0); PG8_BAR; PG8_MMA(1, 0, At, B0); PG8_MMA(1, 1, At, B1); PG8_BAR; PG8_SCHED;
            PG8_LDB(B0, 1, 0); PG8_LDB(B1, 1, 1); PG8_SCHED; PG8_LDA(At, 1, 0); PG8_STAGEA(PG8_SA(0, 1), a2 + hstepA, voffA);
            PG8_WAIT_V(8); PG8_WAIT_L(0); PG8_BAR; PG8_MMA(0, 0, At, B0); PG8_MMA(0, 1, At, B1); PG8_BAR; PG8_SCHED;
            PG8_LDA(At, 1, 1); PG8_STAGE(PG8_SB(1, 0), b3, voffB); PG8_STAGE(PG8_SB(1, 1), b3 + hstepB, voffB); PG8_STAGEA(PG8_SA(1, 0), a3, voffA);
            PG8_WAIT_V(8); PG8_WAIT_L(0); PG8_BAR; PG8_MMA(1, 0, At, B0); PG8_MMA(1, 1, At, B1); PG8_BAR; PG8_SCHED;
            } else {
            PG8_LDB(B0, 0, 0); PG8_SCHED; PG8_LDA(At, 0, 0); PG8_STAGEA(PG8_SA(1, 1), a1 + hstepA, voffA);
            PG8_WAIT_L(8); PG8_BAR; PG8_WAIT_L(0); PG8_MMA(0, 0, At, B0); PG8_BAR; PG8_SCHED;
            PG8_LDB(B1, 0, 1); PG8_STAGE(PG8_SB(0, 0), b2, voffB);
            PG8_BAR; PG8_WAIT_L(0); PG8_MMA(0, 1, At, B1); PG8_BAR;
            PG8_LDA(At, 0, 1); PG8_STAGEA(PG8_SA(0, 0), a2, voffA);
            PG8_BAR; PG8_WAIT_L(0); PG8_MMA(1, 0, At, B0); PG8_BAR; PG8_SCHED;
            PG8_STAGE(PG8_SB(0, 1), b2 + hstepB, voffB);
            PG8_WAIT_V(6); PG8_BAR; PG8_MMA(1, 1, At, B1); PG8_BAR;
            PG8_LDB(B0, 1, 0); PG8_SCHED; PG8_LDA(At, 1, 0); PG8_STAGEA(PG8_SA(0, 1), a2 + hstepA, voffA);
            PG8_WAIT_L(8); PG8_BAR; PG8_WAIT_L(0); PG8_MMA(0, 0, At, B0); PG8_BAR; PG8_SCHED;
            PG8_LDB(B1, 1, 1); PG8_STAGE(PG8_SB(1, 0), b3, voffB);
            PG8_BAR; PG8_WAIT_L(0); PG8_MMA(0, 1, At, B1); PG8_BAR;
            PG8_LDA(At, 1, 1); PG8_STAGEA(PG8_SA(1, 0), a3, voffA);
            PG8_BAR; PG8_WAIT_L(0); PG8_MMA(1, 0, At, B0); PG8_BAR; PG8_SCHED;
            PG8_STAGE(PG8_SB(1, 1), b3 + hstepB, voffB);
            PG8_WAIT_V(6); PG8_BAR; PG8_MMA(1, 1, At, B1); PG8_BAR;
            }
        }
        if constexpr (ALIGN_EPI) { if (wr == 0) PG8_BAR; }
        if constexpr (!Epi::AFTER_DRAIN) { E(acc, cur, wr, wc, fr, fq); S.done(cur); }
        if (!has_next) break;
#pragma unroll
        for (int a = 0; a < 2; ++a)
#pragma unroll
            for (int b = 0; b < 2; ++b)
#pragma unroll
                for (int m = 0; m < 4; ++m)
#pragma unroll
                    for (int n = 0; n < 2; ++n) acc[a][b][m][n] = (f32x4){0.f, 0.f, 0.f, 0.f};
        cur = nxt; cA = nA; cB = nB; ++ui;
        if constexpr (ALIGN_EPI) { if (wr == 1) PG8_BAR; }
    }
    PG8_WAIT_V(0);
    if constexpr (!ALIGN_EPI) { if (wr == 0) PG8_BAR; }
    PG8_BAR;
    if constexpr (Epi::AFTER_DRAIN) { E.fused(acc, cur, wr, wc, fr, fq, lds, wid, lane); S.done(cur); }
#undef PG8_SA
#undef PG8_SB
#undef PG8_STAGE
#undef PG8_STAGEA
#undef PG8_LDA
#undef PG8_LDB
#undef PG8_MMA
#undef PG8_WAIT_V
#undef PG8_WAIT_L
#undef PG8_BAR
#undef PG8_SCHED
}
}
#ifndef TILED_A
#define TILED_A true
#endif
#ifndef TILED_HID
#define TILED_HID 1
#endif
#ifndef P8_AUXA
#define P8_AUXA 0
#endif
#ifndef P7_WGM
#define P7_WGM 8
#endif
#ifndef I8_SP2
#define I8_SP2 PG8_SP2
#endif
#ifndef I8_ALIGN
#define I8_ALIGN PG8_ALIGN
#endif
#ifndef P345_WGM
#define P345_WGM 8
#endif
#ifndef P8_WGM
#define P8_WGM 4
#endif
#ifndef PG8_SP2
#define PG8_SP2 true
#endif
#ifndef PG8_ALIGN
#define PG8_ALIGN true
#endif

constexpr int NWAVES = 8;
constexpr int N_LAUNCHES = MK_N_LAUNCHES;
constexpr int N_PHASES = 10;
constexpr int BATCH = 2, SEQ = 8192, D = 4096, M = BATCH * SEQ;
constexpr int AW = 2048, ACH = 128, AH = 16, AHD = 128;
constexpr int BW = 1024, SG = 64, SGD = 16, SP = 64;
constexpr int DFF = 16384, INW = 2 * AW + BW + 2 * D;
constexpr int TC = 32, NCHB = SEQ / TC, NCH = M / TC;
constexpr float NORM_EPS = 1e-6f;

constexpr size_t MiB = 1u << 20;
constexpr size_t WS_CTL = 0, CTL_ZERO_BYTES = 1 * MiB;
constexpr size_t WS_WIN = 1 * MiB, WS_WPROJ = 105 * MiB, WS_WGLU = 121 * MiB, WS_WOUT = 137 * MiB, WS_WUP = 169 * MiB, WS_WDN = 297 * MiB;
constexpr size_t WS_KTAB = 425 * MiB, WS_BMAT = 426 * MiB, WS_CMAT = 434 * MiB, WS_AT = 442 * MiB;
constexpr size_t WS_PART = 443 * MiB;
constexpr size_t WS_ARB = 448 * MiB;
constexpr size_t WS_ARA = 576 * MiB;
constexpr size_t WS_UA = WS_ARA, WS_VA = WS_ARA + 64 * MiB, WS_XB2 = WS_ARA + 128 * MiB, WS_ZB = WS_ARA + 160 * MiB, WS_GA = WS_ARA + 192 * MiB, WS_GB = WS_ARA + 320 * MiB;
#ifndef IN_INT8
#define IN_INT8 2
#endif
constexpr int NG8 = IN_INT8 == 2 ? INW : IN_INT8 == 1 ? 1024 + 2048 + 8192 : 2048 + 8192, N16 = INW - NG8;
__host__ __device__ constexpr int win_row16(int n) { return n < 2048 ? n : n - 2048; }
__host__ __device__ constexpr int win_row8(int n) { return n < 4096 ? n - 2048 : n - 3072; }
__host__ __device__ constexpr int win_col8(int r) { return IN_INT8 == 2 ? r : IN_INT8 == 1 ? r + 2048 : (r < 2048 ? r + 2048 : r + 3072); }
__host__ __device__ constexpr int win_col16(int r) { return r < 2048 ? r : r + 2048; }
constexpr size_t WS_H8 = WS_ARA + 448 * MiB;
constexpr size_t WS_W8 = WS_WIN + (size_t)N16 * D * 2;
constexpr size_t WS_H2Q = WS_WIN;
static_assert(WS_W8 + (size_t)NG8 * D <= WS_WPROJ && WS_H2Q + (size_t)M * D <= WS_WOUT, "int8 copies");
constexpr size_t WS_RS1 = WS_AT + 64 * 1024, WS_RS2 = WS_AT + 128 * 1024, WS_CSIN = WS_AT + 192 * 1024, WS_CSUP = WS_AT + 256 * 1024;
static_assert(WS_CSIN + (size_t)NG8 * 4 <= WS_CSUP && WS_CSUP + (size_t)DFF * 4 <= WS_PART, "scale arrays");
constexpr int CW_CMAXIN = 16384, CW_CMAXUP = 32768;
static_assert((CW_CMAXUP + DFF) * 4 <= (int)(1u << 20) && CW_CMAXIN + NG8 <= CW_CMAXUP, "CTL words inside the memset region");
constexpr size_t WS_END = 1088 * MiB;
static_assert(WS_WIN + (size_t)INW * D * 2 <= WS_WPROJ && WS_WPROJ + (size_t)D * AW * 2 <= WS_WGLU && WS_WGLU + (size_t)2 * D * BW * 2 <= WS_WOUT && WS_WOUT + (size_t)D * D * 2 <= WS_WUP &&
              WS_WUP + (size_t)DFF * D * 2 <= WS_WDN && WS_WDN + (size_t)D * DFF * 2 <= WS_KTAB, "weight map");
static_assert(WS_KTAB + (size_t)SG * TC * 256 * 2 <= WS_BMAT && WS_BMAT + (size_t)SG * 128 * 512 * 2 <= WS_CMAT && WS_CMAT + (size_t)SG * 512 * 128 * 2 <= WS_AT && WS_AT + (size_t)SG * SP * 8 <= WS_PART &&
              WS_PART + (size_t)M * 64 * 4 <= WS_ARB && WS_ARB + (size_t)M * D * 2 <= WS_ARA && WS_GB + (size_t)M * D * 2 <= WS_END && WS_ARA + (size_t)M * DFF * 2 <= WS_END, "activation map");
constexpr int CW_TMO = 0, CW_CODE = 1, CW_BAR = 4096;

constexpr int RING_OFF = 0, RING_BYTES = 131072;
constexpr int LDSCTL_OFF = RING_BYTES, MISC_OFF = LDSCTL_OFF + 320;
constexpr int LDS_BYTES = 147456;
static_assert(MISC_OFF + 128 <= LDS_BYTES, "LDS map");

#define GAS __attribute__((address_space(1)))
#define LAS __attribute__((address_space(3)))
typedef unsigned short bf16;
typedef unsigned v4u __attribute__((ext_vector_type(4)));
typedef unsigned v2u __attribute__((ext_vector_type(2)));
typedef float f32x4 __attribute__((ext_vector_type(4)));
typedef float f32x2 __attribute__((ext_vector_type(2)));
typedef short bf16x8 __attribute__((ext_vector_type(8)));
typedef GAS unsigned gu32;
#define RLX_AGENT __ATOMIC_RELAXED, __HIP_MEMORY_SCOPE_AGENT
#ifndef NT_STREAM
#define NT_STREAM 1
#endif
#if NT_STREAM
#define LD_STREAM(p) __builtin_nontemporal_load(p)
#define ST_STREAM(p, v) __builtin_nontemporal_store((v), (p))
#else
#define LD_STREAM(p) (*(p))
#define ST_STREAM(p, v) (*(p) = (v))
#endif
#define LDS_WAIT() asm volatile("s_waitcnt lgkmcnt(0)" ::: "memory")
#define VM_WAIT() asm volatile("s_waitcnt vmcnt(0)" ::: "memory")
__device__ __forceinline__ unsigned pk2(float lo, float hi) { return pg8::cvt_pk_op(lo, hi); }
__device__ __forceinline__ unsigned pk2x(float lo, float hi) { return pg8::cvt_pk_bf16(lo, hi); }
__device__ __forceinline__ float bflo(unsigned w) { return __uint_as_float(w << 16); }
__device__ __forceinline__ float bfhi(unsigned w) { return __uint_as_float(w & 0xffff0000u); }
__device__ __forceinline__ float gelu_t(float x) { return pg8::gelu_tanh_f(x); }

#define XB_TMO      128
#define XB_XCNT(j)  (256  + 64 * (j))
#define XB_XSUB(j)  (1280 + 64 * (j))
#define XB_XGEN(j)  (2304 + 64 * (j))
#define XB_TOP      3328
#define XB_TOPGEN   3392
#define XCD_BAR_WORDS 3456
#define XB_SPIN_CAP (1u << 18)

__device__ __forceinline__ unsigned xb_ld(unsigned* p)              { return __hip_atomic_load(p, __ATOMIC_RELAXED, __HIP_MEMORY_SCOPE_AGENT); }
__device__ __forceinline__ unsigned xb_add(unsigned* p, unsigned v) { return __hip_atomic_fetch_add(p, v, __ATOMIC_RELAXED, __HIP_MEMORY_SCOPE_AGENT); }
__device__ __forceinline__ unsigned xb_xcc_id() { return (unsigned)__builtin_amdgcn_s_getreg((3 << 11) | 20) & 0xFu; }
#define XB_SPIN(cond, bar) do { unsigned _sp = 0; while (cond) { __builtin_amdgcn_s_sleep(1); \
    if ((++_sp & 255u) == 0u) { if (xb_ld(&(bar)[XB_TMO])) break; if (_sp > XB_SPIN_CAP) { atomicAdd(&(bar)[XB_TMO], 1u); break; } } } } while (0)

struct XcdBarrier { unsigned* bar; unsigned x; volatile LAS unsigned* st; };

__device__ __forceinline__ XcdBarrier xcd_barrier_post(unsigned* bar, volatile LAS unsigned* st) {
    XcdBarrier b; b.bar = bar; b.x = xb_xcc_id(); b.st = st;
    if (threadIdx.x == 0) (void)xb_add(&bar[XB_XCNT(b.x)], 1u);
    return b;
}
__device__ __forceinline__ void xcd_barrier_complete(unsigned* bar, unsigned x, unsigned& nloc, unsigned& nx) {
    const unsigned G = gridDim.x * gridDim.y * gridDim.z;
    unsigned sum, cnt, mine, sp = 0u;
    for (;;) {
        sum = 0u; cnt = 0u; mine = 0u;
#pragma unroll
        for (unsigned j = 0; j < 16; ++j) { const unsigned c = xb_ld(&bar[XB_XCNT(j)]); sum += c; cnt += (c > 0u) ? 1u : 0u; mine = (j == x) ? c : mine; }
        if (sum == G) break;
        __builtin_amdgcn_s_sleep(1);
        if ((++sp & 255u) == 0u) { if (xb_ld(&bar[XB_TMO])) break; if (sp > XB_SPIN_CAP) { atomicAdd(&bar[XB_TMO], 1u); break; } }
    }
    nloc = mine > 0u ? mine : 1u; nx = cnt > 0u ? cnt : 1u;
}
__device__ __forceinline__ void xcd_barrier(const XcdBarrier& b) {
    asm volatile("s_waitcnt vmcnt(0)" ::: "memory");
    __syncthreads();
    if (threadIdx.x == 0) {
        unsigned* bar = b.bar;
        __builtin_amdgcn_s_waitcnt(0);
        unsigned nloc = b.st[0], nx = b.st[1];
        if (nloc == 0u) { xcd_barrier_complete(bar, b.x, nloc, nx); b.st[0] = nloc; b.st[1] = nx; }
        const unsigned old = xb_add(&bar[XB_XSUB(b.x)], 1u);
        const unsigned gen = old / nloc;
        if (old + 1u == (gen + 1u) * nloc) {
            __builtin_amdgcn_fence(__ATOMIC_RELEASE, "agent");
            asm volatile("s_waitcnt vmcnt(0)" ::: "memory");
            const unsigned og = xb_add(&bar[XB_TOP], 1u);
            const unsigned tg = og / nx;
            if (og + 1u == (tg + 1u) * nx) xb_add(&bar[XB_TOPGEN], 1u);
            else XB_SPIN(xb_ld(&bar[XB_TOPGEN]) == tg, bar);
            __builtin_amdgcn_fence(__ATOMIC_ACQUIRE, "agent");
            xb_add(&bar[XB_XGEN(b.x)], 1u);
            asm volatile("s_waitcnt vmcnt(0)" ::: "memory");
        } else {
            XB_SPIN(xb_ld(&bar[XB_XGEN(b.x)]) == gen, bar);
            __builtin_amdgcn_fence(__ATOMIC_ACQUIRE, "agent");
            asm volatile("s_waitcnt vmcnt(0)" ::: "memory");
        }
    }
    __syncthreads();
}

struct Args { const float* in[24]; float* out; unsigned char* ws; int ph_lo, ph_hi; };
struct Frame {
    LAS unsigned char* lds;
    volatile LAS unsigned* MISC;
    gu32* ctl;
    int tid, lane, wave;
    int vcu, G;
    float* out; unsigned char* ws;
};
enum { I_X = 0, I_NMIXPRE, I_WIN, I_VNG, I_VNB, I_WSP, I_BSP, I_WPROJ, I_LRE, I_LIM, I_LOGDT, I_BRE, I_BIM, I_CRE, I_CIM, I_DSKIP, I_WGLUA, I_WGLUB, I_WOUT, I_NMIXPOST, I_NMLPPRE, I_WUP, I_WDN, I_NMLPPOST };

__device__ __forceinline__ float wave_sum(float v) {
#pragma unroll
    for (int o = 1; o < 64; o <<= 1) v += __shfl_xor(v, o);
    return v;
}

__device__ __forceinline__ void p0_transpose_item(const float* W, int K, int N, bf16* WT, int out_row0, LAS unsigned char* scr, int k0, int n0, int lane) {
    const int c = lane & 15, kq = lane >> 4;
    const float* src = W + (size_t)(k0 + 4 * kq) * N + n0 + 4 * c;
    f32x4 v[16];
#pragma unroll
    for (int i = 0; i < 16; ++i) v[i] = LD_STREAM((const GAS f32x4*)(src + (size_t)((i & 3) + 16 * (i >> 2)) * N));
#pragma unroll
    for (int mb = 0; mb < 4; ++mb)
#pragma unroll
        for (int j = 0; j < 4; ++j) { v2u o; o.x = pk2(v[4 * mb + 0][j], v[4 * mb + 1][j]); o.y = pk2(v[4 * mb + 2][j], v[4 * mb + 3][j]);
            *(LAS v2u*)(scr + (4 * c + j) * 136 + (16 * mb + 4 * kq) * 2) = o; }
    LDS_WAIT(); asm volatile("" ::: "memory");
#pragma unroll
    for (int r = 0; r < 8; ++r) { const int n = (lane >> 3) + 8 * r; const LAS unsigned char* p = scr + n * 136 + (lane & 7) * 16;
        const v2u x = *(const LAS v2u*)p, y = *(const LAS v2u*)(p + 8); v4u o; o.x = x.x; o.y = x.y; o.z = y.x; o.w = y.y;
        const int orow = out_row0 + n;
        *(GAS v4u*)(WT + ((((size_t)(orow >> 8) * (size_t)(K >> 6) + (size_t)(k0 >> 6)) * 256 + (size_t)(orow & 255)) * 64 + 8 * (lane & 7))) = o; }
    LDS_WAIT(); asm volatile("" ::: "memory");
}
__device__ __forceinline__ size_t tile16_off(int row, int col, int ncols) { return TILED_A ? ((((size_t)(row >> 8) * (size_t)(ncols >> 6) + (size_t)(col >> 6)) * 256 + (size_t)(row & 255)) * 64 + (size_t)(col & 63)) : ((size_t)row * ncols + col); }
__device__ __forceinline__ size_t tile8_off(int row, int kb, int nbytes) { return TILED_A ? ((((size_t)(row >> 8) * (size_t)(nbytes >> 7) + (size_t)(kb >> 7)) * 256 + (size_t)(row & 255)) * 128 + (size_t)(kb & 127)) : ((size_t)row * nbytes + kb); }
#ifndef TILED_MIX
#define TILED_MIX 0
#endif
__device__ __forceinline__ size_t mix_off(int row, int col) { return TILED_MIX ? ((((size_t)(row >> 8) * 64 + (size_t)(col >> 6)) * 256 + (size_t)(row & 255)) * 64 + (size_t)(col & 63)) : ((size_t)row * D + col); }
__device__ __forceinline__ float wave_max(float v) {
#pragma unroll
    for (int o = 1; o < 64; o <<= 1) v = fmaxf(v, __shfl_xor(v, o));
    return v;
}
__device__ __forceinline__ unsigned pk4_i8(float a, float b, float c, float d) {
    const int qa = (int)__builtin_rintf(fminf(fmaxf(a, -127.f), 127.f)), qb = (int)__builtin_rintf(fminf(fmaxf(b, -127.f), 127.f)), qc = (int)__builtin_rintf(fminf(fmaxf(c, -127.f), 127.f)), qd = (int)__builtin_rintf(fminf(fmaxf(d, -127.f), 127.f));
    return ((unsigned)qa & 0xffu) | (((unsigned)qb & 0xffu) << 8) | (((unsigned)qc & 0xffu) << 16) | ((unsigned)qd << 24);
}
__device__ __forceinline__ void rms_row_to_bf16(const float* xrow, const float* g, bf16* orow, unsigned char* o8base, int m, float* rs, int lane) {
    const GAS f32x4* xr = (const GAS f32x4*)xrow + lane; const GAS f32x4* gr = (const GAS f32x4*)g + lane;
    f32x4 v[16]; float s = 0.f;
#pragma unroll
    for (int j = 0; j < 16; ++j) { v[j] = LD_STREAM(xr + 64 * j); s += (v[j].x * v[j].x + v[j].y * v[j].y) + (v[j].z * v[j].z + v[j].w * v[j].w); }
    const float rstd = 1.0f / sqrtf(wave_sum(s) * (1.f / D) + NORM_EPS);
    GAS v2u* o8 = (GAS v2u*)orow + lane; float am = 0.f;
#pragma unroll
    for (int j = 0; j < 16; ++j) { const f32x4 gg = gr[64 * j]; v[j].x *= rstd * gg.x; v[j].y *= rstd * gg.y; v[j].z *= rstd * gg.z; v[j].w *= rstd * gg.w;
        am = fmaxf(fmaxf(am, fmaxf(fabsf(v[j].x), fabsf(v[j].y))), fmaxf(fabsf(v[j].z), fabsf(v[j].w)));
        if (N16 > 0) { v2u o; o.x = pk2(v[j].x, v[j].y); o.y = pk2(v[j].z, v[j].w); o8[64 * j] = o; } }
    am = fmaxf(wave_max(am), 1e-30f); const float qs = 127.0f / am;
    if (lane == 0) rs[0] = am * (1.0f / 127.0f);
    GAS unsigned char* q8 = (GAS unsigned char*)(o8base + tile8_off(m, 4 * lane, D)); const size_t qstep = tile8_off(0, 256, D);
#pragma unroll
    for (int j = 0; j < 16; ++j) { *(GAS unsigned*)q8 = pk4_i8(v[j].x * qs, v[j].y * qs, v[j].z * qs, v[j].w * qs); q8 += qstep; }
}
__device__ __forceinline__ void p0_colmax_item(const float* W, int N, unsigned* cmax, int k0, int n0, int ncol0, int lane) {
    const int c = lane & 15, kq = lane >> 4;
    f32x4 mx = (f32x4){0.f, 0.f, 0.f, 0.f};
    for (int sb = 0; sb < 8; ++sb) { const float* src = W + (size_t)(k0 + 64 * sb + 4 * kq) * N + n0 + 4 * c;
#pragma unroll
        for (int i = 0; i < 16; ++i) { const f32x4 t = *(const GAS f32x4*)(src + (size_t)((i & 3) + 16 * (i >> 2)) * N);
            mx.x = fmaxf(mx.x, fabsf(t.x)); mx.y = fmaxf(mx.y, fabsf(t.y)); mx.z = fmaxf(mx.z, fabsf(t.z)); mx.w = fmaxf(mx.w, fabsf(t.w)); } }
#pragma unroll
    for (int j = 0; j < 4; ++j) { float t = mx[j]; t = fmaxf(t, __shfl_xor(t, 16)); t = fmaxf(t, __shfl_xor(t, 32)); mx[j] = t; }
    if (kq == 0) {
#pragma unroll
        for (int j = 0; j < 4; ++j) atomicMax(cmax + (n0 - ncol0) + 4 * c + j, __float_as_uint(mx[j])); }
}
__device__ __forceinline__ void p0_quant_item(const float* W, int K, int N, unsigned char* Wq, int out_row0, LAS unsigned char* scr, int k0, int n0, const unsigned* cmax, float* cs, int lane) {
    const int c = lane & 15, kq = lane >> 4;
    const float* src = W + (size_t)(k0 + 4 * kq) * N + n0 + 4 * c;
    f32x4 v[16];
#pragma unroll
    for (int i = 0; i < 16; ++i) v[i] = *(const GAS f32x4*)(src + (size_t)((i & 3) + 16 * (i >> 2)) * N);
    float qs[4];
#pragma unroll
    for (int j = 0; j < 4; ++j) { const float am = fmaxf(__uint_as_float(cmax[out_row0 + 4 * c + j]), 1e-30f); qs[j] = 127.0f / am; if (k0 == 0 && kq == 0) cs[out_row0 + 4 * c + j] = am * (1.0f / 127.0f); }
#pragma unroll
    for (int mb = 0; mb < 4; ++mb)
#pragma unroll
        for (int j = 0; j < 4; ++j) *(LAS unsigned*)(scr + (4 * c + j) * 68 + 16 * mb + 4 * kq) = pk4_i8(qs[j] * v[4 * mb + 0][j], qs[j] * v[4 * mb + 1][j], qs[j] * v[4 * mb + 2][j], qs[j] * v[4 * mb + 3][j]);
    LDS_WAIT(); asm volatile("" ::: "memory");
#pragma unroll
    for (int r = 0; r < 4; ++r) { const int n = (lane >> 2) + 16 * r; const LAS unsigned* p = (const LAS unsigned*)(scr + n * 68 + 16 * (lane & 3));
        v4u o; o.x = p[0]; o.y = p[1]; o.z = p[2]; o.w = p[3];
        const int orow = out_row0 + n;
        *(GAS v4u*)(Wq + ((((size_t)(orow >> 8) * (size_t)(K >> 7) + (size_t)(k0 >> 7)) * 256 + (size_t)(orow & 255)) * 128 + (size_t)(k0 & 127) + 16 * (lane & 3))) = o; }
    LDS_WAIT(); asm volatile("" ::: "memory");
}
#ifndef REGQ
#define REGQ (IN_INT8 == 2)
#endif
template <int ROWS>
__device__ __forceinline__ void q_load(Frame& F, const float* W, int N, int n0, int k0, unsigned* cmax, unsigned (&d)[ROWS / 4]) {
    constexpr int RW = ROWS / 8, NB = RW < 16 ? RW : 16;
    int lane = F.lane; asm volatile("" : "+v"(lane));
    const GAS unsigned char* src = (const GAS unsigned char*)(W + (size_t)(k0 + F.wave * RW) * N + n0);
    const unsigned lo = 16u * (unsigned)lane, rstep = 4u * (unsigned)N;
    f32x4 mx = (f32x4){0.f, 0.f, 0.f, 0.f};
#pragma unroll
    for (int ib = 0; ib < RW; ib += NB) {
        f32x4 v[NB];
#pragma unroll
        for (int i = 0; i < NB; ++i) v[i] = LD_STREAM((const GAS f32x4*)(src + (size_t)(ib + i) * rstep + lo));
#pragma unroll
        for (int i = 0; i < NB; ++i) {
            mx.x = fmaxf(mx.x, fabsf(v[i].x)); mx.y = fmaxf(mx.y, fabsf(v[i].y)); mx.z = fmaxf(mx.z, fabsf(v[i].z)); mx.w = fmaxf(mx.w, fabsf(v[i].w));
            d[2 * (ib + i)] = pk2x(v[i].x, v[i].y); d[2 * (ib + i) + 1] = pk2x(v[i].z, v[i].w); }
    }
    LAS float* red = (LAS float*)(F.lds + RING_OFF);
    *(LAS f32x4*)(red + F.wave * 256 + 4 * lane) = mx;
    __syncthreads();
    if (F.tid < 256) { float m = red[F.tid];
#pragma unroll
        for (int w = 1; w < NWAVES; ++w) m = fmaxf(m, red[w * 256 + F.tid]);
        atomicMax(cmax + F.tid, __float_as_uint(m)); }
}
template <int ROWS>
__device__ __forceinline__ void q_store(Frame& F, unsigned char* Wq, int panel, int k0, const unsigned* cmax, float* cs, const unsigned (&d)[ROWS / 4]) {
    constexpr int RW = ROWS / 8;
    int lane = F.lane; asm volatile("" : "+v"(lane));
    const v4u cm = *(const GAS v4u*)(cmax + 4 * lane);
    float qs[4]; f32x4 sc;
#pragma unroll
    for (int j = 0; j < 4; ++j) { const float am = fmaxf(__uint_as_float(cm[j]), 1e-30f); qs[j] = 127.0f / am; sc[j] = am * (1.0f / 127.0f); }
    if (k0 == 0 && F.wave == 0) *(GAS f32x4*)(cs + 4 * lane) = sc;
    const int k = k0 + F.wave * RW;
    GAS unsigned char* o = (GAS unsigned char*)Wq + (((size_t)panel * (D / 128) + (size_t)(k >> 7)) * 256 + (size_t)(4 * lane)) * 128 + (size_t)(k & 127);
#define QV(i, j) (qs[j] * (((j) & 1) ? bfhi(d[2 * (i) + ((j) >> 1)]) : bflo(d[2 * (i) + ((j) >> 1)])))
#pragma unroll
    for (int j = 0; j < 4; ++j) {
        if constexpr (RW >= 16) {
#pragma unroll
            for (int g = 0; g < RW / 16; ++g) { v4u o4;
#pragma unroll
                for (int q = 0; q < 4; ++q) o4[q] = pk4_i8(QV(16 * g + 4 * q, j), QV(16 * g + 4 * q + 1, j), QV(16 * g + 4 * q + 2, j), QV(16 * g + 4 * q + 3, j));
                *(GAS v4u*)(o + j * 128 + 16 * g) = o4; }
        } else { v2u o2; o2.x = pk4_i8(QV(0, j), QV(1, j), QV(2, j), QV(3, j)); o2.y = pk4_i8(QV(4, j), QV(5, j), QV(6, j), QV(7, j)); *(GAS v2u*)(o + j * 128) = o2; }
    }
#undef QV
}
template <int ROWS>
__device__ __forceinline__ void q_rounds(Frame& F, const Args& A, const XcdBarrier& bar, int gp0, int ngp) {
    constexpr int KB = D / ROWS, PIN = INW / 256;
    const int NT = ngp * KB;
    for (int t0 = 0; t0 < NT; t0 += F.G) {
        const int t = t0 + F.vcu; const bool act = t < NT;
        const int gp = gp0 + t / KB, k0 = (t % KB) * ROWS; const bool isin = gp < PIN; const int panel = isin ? gp : gp - PIN;
        unsigned* cmax = (unsigned*)(F.ctl + (isin ? CW_CMAXIN : CW_CMAXUP)) + 256 * panel;
        unsigned d[ROWS / 4];
        if (act) q_load<ROWS>(F, isin ? A.in[I_WIN] : A.in[I_WUP], isin ? INW : DFF, 256 * panel, k0, cmax, d);
        if (N_LAUNCHES == 1) xcd_barrier(bar);
        if (act) q_store<ROWS>(F, isin ? F.ws + WS_W8 : F.ws + WS_WUP, panel, k0, cmax, (float*)(F.ws + (isin ? WS_CSIN : WS_CSUP)) + 256 * panel, d);
    }
}
__device__ __forceinline__ void p0_quant_rounds(Frame& F, const Args& A, const XcdBarrier& bar) {
    static_assert((INW + DFF) / 256 == 116 && (!REGQ || N_LAUNCHES == 1), "panel split below; the tiles cross a grid barrier");
    __syncthreads();
    q_rounds<512>(F, A, bar, 0, 96);
    q_rounds<256>(F, A, bar, 96, 16);
    q_rounds<64>(F, A, bar, 112, 4);
}
__device__ __forceinline__ void s5_pow(double lre, double lim, double dt, int n, double& re, double& im) {
    const double mag = exp((double)n * dt * lre), ang = (double)n * dt * lim; double sn, cs; sincos(ang, &sn, &cs); re = mag * cs; im = mag * sn;
}
__device__ __forceinline__ void s5_coef(double lre, double lim, double dt, double& re, double& im) {
    double are, aim; s5_pow(lre, lim, dt, 1, are, aim); const double nr = are - 1.0, ni = aim, den = lre * lre + lim * lim;
    re = (nr * lre + ni * lim) / den; im = (ni * lre - nr * lim) / den;
}
__device__ __forceinline__ void p0_s5_item(Frame& F, const Args& A, int item) {
    const int lane = F.lane, p = lane;
    bf16* KTAB = (bf16*)(F.ws + WS_KTAB); bf16* BMAT = (bf16*)(F.ws + WS_BMAT); bf16* CMAT = (bf16*)(F.ws + WS_CMAT); float* AT = (float*)(F.ws + WS_AT);
    const int kind = item >> 11, r = item & 2047, g = (kind < 3) ? (r >> 5) : r, n = r & 31;
    const double lre = (double)A.in[I_LRE][g * SP + p], lim = (double)A.in[I_LIM][g * SP + p], dt = exp((double)A.in[I_LOGDT][g]);
    if (kind == 3) { double re, im; s5_pow(lre, lim, dt, TC, re, im); AT[(g * SP + p) * 2] = (float)re; AT[(g * SP + p) * 2 + 1] = (float)im; return; }
    if (kind == 2) {
        double wr, wi; s5_pow(lre, lim, dt, n + 1, wr, wi); const float wrf = (float)wr, wif = (float)wi;
#pragma unroll
        for (int h = 0; h < SGD; ++h) { const float cr = A.in[I_CRE][(g * SGD + h) * SP + p], ci = A.in[I_CIM][(g * SGD + h) * SP + p];
            bf16* row = CMAT + ((size_t)g * 512 + n * 16 + h) * 128;
            row[p] = (bf16)(pk2x(cr * wrf - ci * wif, 0.f) & 0xffffu); row[64 + p] = (bf16)(pk2x(-(cr * wif + ci * wrf), 0.f) & 0xffffu); }
        return;
    }
    double cre, cim; s5_coef(lre, lim, dt, cre, cim);
    if (kind == 1) {
        double ar, ai; s5_pow(lre, lim, dt, TC - 1 - n, ar, ai); const float wr = (float)(ar * cre - ai * cim), wi = (float)(ar * cim + ai * cre);
        float vr[16], vi[16];
#pragma unroll
        for (int h = 0; h < SGD; ++h) { const float br = A.in[I_BRE][(g * SP + p) * SGD + h], bi = A.in[I_BIM][(g * SP + p) * SGD + h]; vr[h] = wr * br - wi * bi; vi[h] = wr * bi + wi * br; }
        v4u o; bf16* rr = BMAT + ((size_t)g * 128 + p) * 512 + n * 16; bf16* ri = BMAT + ((size_t)g * 128 + 64 + p) * 512 + n * 16;
        o.x = pk2x(vr[0], vr[1]); o.y = pk2x(vr[2], vr[3]); o.z = pk2x(vr[4], vr[5]); o.w = pk2x(vr[6], vr[7]); *(v4u*)rr = o;
        o.x = pk2x(vr[8], vr[9]); o.y = pk2x(vr[10], vr[11]); o.z = pk2x(vr[12], vr[13]); o.w = pk2x(vr[14], vr[15]); *(v4u*)(rr + 8) = o;
        o.x = pk2x(vi[0], vi[1]); o.y = pk2x(vi[2], vi[3]); o.z = pk2x(vi[4], vi[5]); o.w = pk2x(vi[6], vi[7]); *(v4u*)ri = o;
        o.x = pk2x(vi[8], vi[9]); o.y = pk2x(vi[10], vi[11]); o.z = pk2x(vi[12], vi[13]); o.w = pk2x(vi[14], vi[15]); *(v4u*)(ri + 8) = o;
        return;
    }
    double ar, ai; s5_pow(lre, lim, dt, n, ar, ai); const float wr = (float)(ar * cre - ai * cim), wi = (float)(ar * cim + ai * cre);
    float vr[16], vi[16];
#pragma unroll
    for (int h = 0; h < SGD; ++h) { const float br = A.in[I_BRE][(g * SP + p) * SGD + h], bi = A.in[I_BIM][(g * SP + p) * SGD + h]; vr[h] = wr * br - wi * bi; vi[h] = wr * bi + wi * br; }
    float crs[16], cis[16];
#pragma unroll
    for (int h = 0; h < SGD; ++h) { crs[h] = A.in[I_CRE][(g * SGD + h) * SP + p]; cis[h] = A.in[I_CIM][(g * SGD + h) * SP + p]; }
    __builtin_amdgcn_sched_barrier(0);
#pragma unroll
    for (int h = 0; h < SGD; ++h) { const float cr = crs[h], ci = cis[h];
        float t8[8], t4[4], t2[2], mine;
#pragma unroll
        for (int i = 0; i < 8; ++i) { const float a = cr * vr[2 * i] - ci * vi[2 * i], b = cr * vr[2 * i + 1] - ci * vi[2 * i + 1]; const bool up = lane & 1; t8[i] = (up ? b : a) + __shfl_xor(up ? a : b, 1); }
#pragma unroll
        for (int i = 0; i < 4; ++i) { const bool up = lane & 2; t4[i] = (up ? t8[2 * i + 1] : t8[2 * i]) + __shfl_xor(up ? t8[2 * i] : t8[2 * i + 1], 2); }
#pragma unroll
        for (int i = 0; i < 2; ++i) { const bool up = lane & 4; t2[i] = (up ? t4[2 * i + 1] : t4[2 * i]) + __shfl_xor(up ? t4[2 * i] : t4[2 * i + 1], 4); }
        { const bool up = lane & 8; mine = (up ? t2[1] : t2[0]) + __shfl_xor(up ? t2[0] : t2[1], 8); }
        mine += __shfl_xor(mine, 16); mine += __shfl_xor(mine, 32);
        if (lane < SGD) { if (n == 0 && lane == h) mine += A.in[I_DSKIP][g * SGD + h]; KTAB[(((size_t)g * TC + n) * SGD + h) * SGD + lane] = (bf16)(pk2x(mine, 0.f) & 0xffffu); } }
}
__device__ __forceinline__ void p0_prologue(Frame& F, const Args& A) {
    LAS unsigned char* scr = F.lds + RING_OFF + F.wave * 16384;
#ifndef P0_S5WAVE
#define P0_S5WAVE 0
#endif
    constexpr int NSW = P0_S5WAVE ? NWAVES - 1 : NWAVES;
    if (P0_S5WAVE && F.wave == NWAVES - 1) { for (int it = F.vcu; it < 3 * 2048 + SG; it += F.G) p0_s5_item(F, A, it); return; }
    const int gw = F.vcu * NSW + F.wave, NGW = F.G * NSW;
    if (!P0_S5WAVE) for (int it = gw; it < 3 * 2048 + SG; it += NGW) p0_s5_item(F, A, it);
    { bf16* Hh = (bf16*)(F.ws + WS_ARB); float* RS1 = (float*)(F.ws + WS_RS1);
      for (int m = gw; m < M; m += NGW) rms_row_to_bf16(A.in[I_X] + (size_t)m * D, A.in[I_NMIXPRE], Hh + (size_t)m * D, F.ws + WS_H8, m, RS1 + m, F.lane); }
    constexpr int I_1 = (D / 64) * (N16 / 64), I_2 = (AW / 64) * (D / 64), I_3 = (BW / 64) * (D / 64), I_4 = I_3, I_5 = (D / 64) * (D / 64), I_7 = (DFF / 64) * (D / 64);
    constexpr int NITEMS = I_1 + I_2 + I_3 + I_4 + I_5 + I_7;
    for (int it = gw; it < NITEMS; it += NGW) {
        int r = it;
        if (r < I_1) { const int nblk = N16 > 0 ? N16 / 64 : 1, kb = r / nblk, nb = r % nblk; p0_transpose_item(A.in[I_WIN], D, INW, (bf16*)(F.ws + WS_WIN), 64 * nb, scr, 64 * kb, win_col16(64 * nb), F.lane); continue; } r -= I_1;
        if (r < I_2) { const int nblk = D / 64, kb = r / nblk, nb = r % nblk; p0_transpose_item(A.in[I_WPROJ], AW, D, (bf16*)(F.ws + WS_WPROJ), 64 * nb, scr, 64 * kb, 64 * nb, F.lane); continue; } r -= I_2;
        if (r < I_3) { const int nblk = D / 64, kb = r / nblk, nb = r % nblk, n0 = 64 * nb; p0_transpose_item(A.in[I_WGLUA], BW, D, (bf16*)(F.ws + WS_WGLU), (n0 >> 7) * 256 + (n0 & 127), scr, 64 * kb, n0, F.lane); continue; } r -= I_3;
        if (r < I_4) { const int nblk = D / 64, kb = r / nblk, nb = r % nblk, n0 = 64 * nb; p0_transpose_item(A.in[I_WGLUB], BW, D, (bf16*)(F.ws + WS_WGLU), (n0 >> 7) * 256 + 128 + (n0 & 127), scr, 64 * kb, n0, F.lane); continue; } r -= I_4;
        if (r < I_5) { const int nblk = D / 64, kb = r / nblk, nb = r % nblk; p0_transpose_item(A.in[I_WOUT], D, D, (bf16*)(F.ws + WS_WOUT), 64 * nb, scr, 64 * kb, 64 * nb, F.lane); continue; } r -= I_5;
        { const int nblk = D / 64, kb = r / nblk, nb = r % nblk; p0_transpose_item(A.in[I_WDN], DFF, D, (bf16*)(F.ws + WS_WDN), 64 * nb, scr, 64 * kb, 64 * nb, F.lane); }
    }
    if (!REGQ) { unsigned* CMI = (unsigned*)(F.ctl + CW_CMAXIN); unsigned* CMU = (unsigned*)(F.ctl + CW_CMAXUP);
      constexpr int C_1 = (NG8 / 64) * (D / 512), C_2 = (DFF / 64) * (D / 512);
      for (int it = gw; it < C_1 + C_2; it += NGW) {
          if (it < C_1) { const int nb = it % (NG8 / 64), kb = it / (NG8 / 64), n0 = win_col8(64 * nb); p0_colmax_item(A.in[I_WIN], INW, CMI, 512 * kb, n0, n0 - 64 * nb, F.lane); }
          else { const int r = it - C_1, nb = r % (DFF / 64), kb = r / (DFF / 64); p0_colmax_item(A.in[I_WUP], DFF, CMU, 512 * kb, 64 * nb, 0, F.lane); } } }
}
__device__ __forceinline__ void p0_quantize(Frame& F, const Args& A) {
    LAS unsigned char* scr = F.lds + RING_OFF + F.wave * 16384;
    const int gw = F.vcu * NWAVES + F.wave, NGW = F.G * NWAVES;
    const unsigned* CMI = (const unsigned*)(F.ctl + CW_CMAXIN); const unsigned* CMU = (const unsigned*)(F.ctl + CW_CMAXUP);
    constexpr int Q_1 = (D / 128) * (NG8 / 64), Q_2 = (D / 128) * (DFF / 64);
    for (int it0 = gw; it0 < Q_1 + Q_2; it0 += NGW) { const int it = Q_1 + Q_2 - 1 - it0;
        if (it < Q_1) { const int nblk = NG8 / 64, kb2 = it / nblk, nb = it % nblk;
            p0_quant_item(A.in[I_WIN], D, INW, F.ws + WS_W8, 64 * nb, scr, 128 * kb2, win_col8(64 * nb), CMI, (float*)(F.ws + WS_CSIN), F.lane);
            p0_quant_item(A.in[I_WIN], D, INW, F.ws + WS_W8, 64 * nb, scr, 128 * kb2 + 64, win_col8(64 * nb), CMI, (float*)(F.ws + WS_CSIN), F.lane); }
        else { const int r = it - Q_1, nblk = DFF / 64, kb2 = r / nblk, nb = r % nblk;
            p0_quant_item(A.in[I_WUP], D, DFF, F.ws + WS_WUP, 64 * nb, scr, 128 * kb2, 64 * nb, CMU, (float*)(F.ws + WS_CSUP), F.lane);
            p0_quant_item(A.in[I_WUP], D, DFF, F.ws + WS_WUP, 64 * nb, scr, 128 * kb2 + 64, 64 * nb, CMU, (float*)(F.ws + WS_CSUP), F.lane); }
    }
}

constexpr int SPG_VNT_STRIDE = 136, SPG_BUF_BYTES = 128 * SPG_VNT_STRIDE * 2;
constexpr int DUMP_OFF = RING_BYTES - 2048;
__device__ __forceinline__ void l2_touch(Frame& F, const void* p) { __builtin_amdgcn_global_load_lds((const unsigned*)p, (LAS unsigned*)(F.lds + DUMP_OFF + F.wave * 256), 4, 0, 0); }
#ifndef SPG_H0
#define SPG_H0 9
#endif
__device__ __forceinline__ void spatial_unit(Frame& F, const Args& A, int unit) {
    const int c = unit >> 1, hh = unit & 1, lane = F.lane, w = F.wave, h0 = hh ? SPG_H0 : 0, nheads = hh ? AH - SPG_H0 : SPG_H0;
    const bf16* UA = (const bf16*)(F.ws + WS_UA); const bf16* VA = (const bf16*)(F.ws + WS_VA); bf16* SA = (bf16*)(F.ws + WS_ARB);
    const float* VST = (const float*)(F.ws + WS_PART);
    const size_t tok0 = (size_t)c * ACH;
    const int fr = lane & 15, fq = lane >> 4, trow = 16 * w + fr;
    const int sfill = 64 * (w & 1) + lane, c8b = 4 * (w >> 1);
    float mean, rstd;
    { const GAS f32x4* p = (const GAS f32x4*)(VST + (tok0 + sfill) * 64); float s1 = 0.f, s2 = 0.f;
#pragma unroll
      for (int j = 0; j < 16; ++j) { const f32x4 t = p[j]; s1 += t.x + t.z; s2 += t.y + t.w; }
      mean = s1 * (1.f / AW); const float var = fmaxf(s2 * (1.f / AW) - mean * mean, 0.f); rstd = 1.0f / sqrtf(var + NORM_EPS); }
    const bf16* vsrc = TILED_A ? VA + ((size_t)c * 16 * 128 + sfill) * 128 + 8 * c8b : VA + (tok0 + sfill) * AW + 8 * c8b; const size_t hstr = TILED_A ? (size_t)128 * 128 : (size_t)AHD;
    LAS float* gl = (LAS float*)(F.lds + 2 * SPG_BUF_BYTES); LAS float* bl = gl + 9 * AHD;
    if (F.tid < nheads * (AHD / 4)) { const f32x4 gv = ((const GAS f32x4*)(A.in[I_VNG] + h0 * AHD))[F.tid], bv = ((const GAS f32x4*)(A.in[I_VNB] + h0 * AHD))[F.tid]; ((LAS f32x4*)gl)[F.tid] = gv; ((LAS f32x4*)bl)[F.tid] = bv; }
    const int nks = (w + 2) >> 1;
    v4u vreg[4]; f32x4 wv[4][2]; v2u uu[8]; float bsp;
#define SPG_FETCH(hh_) do { const int hq = (hh_); \
        _Pragma("unroll") for (int i = 0; i < 4; ++i) vreg[i] = LD_STREAM((const GAS v4u*)(vsrc + hq * hstr + 8 * i)); \
        const float* Wrow = A.in[I_WSP] + ((size_t)hq * ACH + trow) * ACH + 8 * fq; \
        _Pragma("unroll") for (int ks = 0; ks < 4; ++ks) if (ks < nks) { wv[ks][0] = *(const GAS f32x4*)(Wrow + 32 * ks); wv[ks][1] = *(const GAS f32x4*)(Wrow + 32 * ks + 4); } \
        const bf16* urow = TILED_A ? UA + (((size_t)c * 16 + hq) * 128 + trow) * 128 + 4 * fq : UA + (tok0 + trow) * AW + hq * AHD + 4 * fq; \
        _Pragma("unroll") for (int n = 0; n < 8; ++n) uu[n] = LD_STREAM((const GAS v2u*)(urow + 16 * n)); \
        bsp = A.in[I_BSP][hq * ACH + trow]; } while (0)
    SPG_FETCH(h0);
    __syncthreads();
#pragma unroll 1
    for (int hi = 0; hi < nheads; ++hi) { const int h = h0 + hi;
        LAS bf16* vnT = (LAS bf16*)(F.lds + (hi & 1) * SPG_BUF_BYTES);
#pragma unroll
        for (int i = 0; i < 4; ++i) { const int c8 = c8b + i; const v4u x = vreg[i];
            const float e[8] = {bflo(x.x), bfhi(x.x), bflo(x.y), bfhi(x.y), bflo(x.z), bfhi(x.z), bflo(x.w), bfhi(x.w)};
            const f32x4 g0 = *(const LAS f32x4*)(gl + hi * AHD + 8 * c8), g1 = *(const LAS f32x4*)(gl + hi * AHD + 8 * c8 + 4), b0 = *(const LAS f32x4*)(bl + hi * AHD + 8 * c8), b1 = *(const LAS f32x4*)(bl + hi * AHD + 8 * c8 + 4);
            const float gg[8] = {g0.x, g0.y, g0.z, g0.w, g1.x, g1.y, g1.z, g1.w}, bb[8] = {b0.x, b0.y, b0.z, b0.w, b1.x, b1.y, b1.z, b1.w};
#pragma unroll
            for (int j = 0; j < 8; ++j) { const float y = (e[j] - mean) * rstd * gg[j] + bb[j]; vnT[(8 * c8 + j) * SPG_VNT_STRIDE + sfill] = (bf16)(pk2x(y, 0.f) & 0xffffu); } }
        v4u wb[4];
#pragma unroll
        for (int ks = 0; ks < 4; ++ks) if (ks < nks) { const int s0 = 32 * ks + 8 * fq;
            float wvv[8] = {wv[ks][0].x, wv[ks][0].y, wv[ks][0].z, wv[ks][0].w, wv[ks][1].x, wv[ks][1].y, wv[ks][1].z, wv[ks][1].w};
#pragma unroll
            for (int j = 0; j < 8; ++j) wvv[j] = (s0 + j <= trow) ? wvv[j] : 0.f;
            wb[ks].x = pk2x(wvv[0], wvv[1]); wb[ks].y = pk2x(wvv[2], wvv[3]); wb[ks].z = pk2x(wvv[4], wvv[5]); wb[ks].w = pk2x(wvv[6], wvv[7]); }
        v2u uc[8];
#pragma unroll
        for (int n = 0; n < 8; ++n) uc[n] = uu[n];
        const float bc = bsp; const int srow_t = (int)(tok0 + trow), scol = h * AHD + 4 * fq;
        __builtin_amdgcn_sched_barrier(0);
        if (hi + 1 < nheads) SPG_FETCH(h + 1);
        __syncthreads();
        f32x4 acc[8];
#pragma unroll
        for (int n = 0; n < 8; ++n) acc[n] = (f32x4){0.f, 0.f, 0.f, 0.f};
#pragma unroll
        for (int ks = 0; ks < 4; ++ks) if (ks < nks) { const int s0 = 32 * ks + 8 * fq; const bf16x8 bfrag = __builtin_bit_cast(bf16x8, wb[ks]);
#pragma unroll
            for (int n = 0; n < 8; ++n) { const bf16x8 afrag = *(const LAS bf16x8*)(vnT + (16 * n + fr) * SPG_VNT_STRIDE + s0);
                acc[n] = __builtin_amdgcn_mfma_f32_16x16x32_bf16(afrag, bfrag, acc[n], 0, 0, 0); } }
#pragma unroll
        for (int n = 0; n < 8; ++n) { const v2u u2 = uc[n]; v2u o;
            o.x = pk2x(bflo(u2.x) * (acc[n][0] + bc), bfhi(u2.x) * (acc[n][1] + bc)); o.y = pk2x(bflo(u2.y) * (acc[n][2] + bc), bfhi(u2.y) * (acc[n][3] + bc)); *(GAS v2u*)(SA + tile16_off(srow_t, scol + 16 * n, AW)) = o; }
    }
#undef SPG_FETCH
    __syncthreads();
}

constexpr int S5_KT_OFF = 0;
constexpr int S5_E_OFF = 17408;
constexpr int S5_S_OFF = S5_E_OFF + 128 * 65 * 4;
constexpr int S5_S_STRIDE = 136;
static_assert(S5_S_OFF + 128 * S5_S_STRIDE * 2 <= RING_BYTES - 2048, "S5 LDS");
#ifndef S5_PF
#define S5_PF 1
#endif
#ifndef S5_SB3
#define S5_SB3 0
#endif
__device__ __forceinline__ void s5_unit(Frame& F, int unit, int part = 3) {
    const int q = unit & 1, g = (unit >> 1) & 63, b = unit >> 7, tid = F.tid, lane = F.lane, w = F.wave, fr = lane & 15, fq = lane >> 4;
    const bf16* KTAB = (const bf16*)(F.ws + WS_KTAB) + (size_t)g * TC * 256; const bf16* BMAT = (const bf16*)(F.ws + WS_BMAT) + (size_t)g * 128 * 512;
    const bf16* CMAT = (const bf16*)(F.ws + WS_CMAT) + (size_t)g * 512 * 128; const float* AT = (const float*)(F.ws + WS_AT) + g * SP * 2;
    const bf16* XB = (const bf16*)(F.ws + WS_XB2) + ((size_t)g * NCH + (size_t)b * NCHB) * 512;
    bf16* ZB = (bf16*)(F.ws + WS_ZB);
    LAS unsigned char* kt = F.lds + S5_KT_OFF; LAS float* Eb = (LAS float*)(F.lds + S5_E_OFF); LAS bf16* Sb = (LAS bf16*)(F.lds + S5_S_OFF);
    if (S5_PF && (part & 1)) { l2_touch(F, (const unsigned char*)XB + (size_t)tid * 128); l2_touch(F, (const unsigned char*)XB + 65536 + (size_t)tid * 128); }
    if (tid < 32) *(LAS v4u*)(kt + tid * 16) = (v4u){0u, 0u, 0u, 0u};
#pragma unroll
    for (int i = 0; i < 2; ++i) { const int pc = tid + 512 * i; *(LAS v4u*)(kt + 512 + pc * 16) = *(const GAS v4u*)(KTAB + pc * 8); }
    if (part & 1) {
        float sre = 0.f, sim = 0.f; const float are = AT[2 * lane], aim = AT[2 * lane + 1];
        const int nblk = 2 * (q + 1);
        const int ntw = w & 3, rt0 = 4 * (w >> 2);
        bf16x8 ba[16], bb[16];
        { const bf16* xr = XB + (size_t)(16 * ntw + fr) * 512 + 8 * fq;
#pragma unroll
          for (int kk = 0; kk < 16; ++kk) ba[kk] = *(const GAS bf16x8*)(xr + 32 * kk); }
        const bf16* bmr = BMAT + (size_t)(16 * rt0 + fr) * 512 + 8 * fq;
        for (int blk = 0; blk < nblk; blk += 2) {
#pragma unroll
            for (int hb = 0; hb < 2; ++hb) {
                if (!(part & 8)) {
                { const int bn = blk + hb + 1 < nblk ? blk + hb + 1 : nblk - 1;
                  const bf16* xn = XB + (size_t)(64 * bn + 16 * ntw + fr) * 512 + 8 * fq;
#pragma unroll
                  for (int kk = 0; kk < 16; ++kk) { if (hb) ba[kk] = *(const GAS bf16x8*)(xn + 32 * kk); else bb[kk] = *(const GAS bf16x8*)(xn + 32 * kk); } }
#pragma unroll 1
                for (int i = 0; i < 4; ++i) { bf16x8 af[16];
#pragma unroll
                    for (int kk = 0; kk < 16; ++kk) af[kk] = *(const GAS bf16x8*)(bmr + (size_t)i * 16 * 512 + 32 * kk);
                    __builtin_amdgcn_sched_barrier(0);
                    f32x4 acc = (f32x4){0.f, 0.f, 0.f, 0.f};
#pragma unroll
                    for (int kk = 0; kk < 16; ++kk) acc = __builtin_amdgcn_mfma_f32_16x16x32_bf16(af[kk], hb ? bb[kk] : ba[kk], acc, 0, 0, 0);
#pragma unroll
                    for (int r = 0; r < 4; ++r) Eb[(16 * (rt0 + i) + 4 * fq + r) * 65 + 16 * ntw + fr] = acc[r];
                    __builtin_amdgcn_sched_barrier(0); }
                }
                const int blkc = blk + hb;
            if (S5_PF && blkc + 2 < nblk) l2_touch(F, (const unsigned char*)XB + (size_t)(blkc + 2) * 65536 + (size_t)tid * 128);
            __syncthreads();
            if (w == 0 && !(part & 4)) {
                const bool wr_s = 64 * blkc >= 128 * q;
#pragma unroll 1
                for (int j0 = 0; j0 < 64; j0 += 16) { float er[16], ei[16];
#pragma unroll
                    for (int i = 0; i < 16; ++i) { er[i] = Eb[lane * 65 + j0 + i]; ei[i] = Eb[(64 + lane) * 65 + j0 + i]; }
                    LAS bf16* sp = Sb + (64 * blkc + j0 - 128 * q) * S5_S_STRIDE + lane;
#pragma unroll
                    for (int i = 0; i < 16; ++i) {
                        if (wr_s) { sp[i * S5_S_STRIDE] = (bf16)(pk2x(sre, 0.f) & 0xffffu); sp[i * S5_S_STRIDE + 64] = (bf16)(pk2x(sim, 0.f) & 0xffffu); }
                        const float nr = are * sre - aim * sim + er[i], ni = are * sim + aim * sre + ei[i]; sre = nr; sim = ni; } }
            }
            __syncthreads();
            }
        }
    }
#ifndef S5_V3
#define S5_V3 1
#endif
#if S5_V3
    if (part & 2) {
        const bf16* xr = XB + (size_t)(128 * q + 16 * w + fr) * 512 + 8 * fq;
        bf16x8 bf[16], sf[4], cfa[4], cfb[4];
#pragma unroll
        for (int kk = 0; kk < 16; ++kk) bf[kk] = *(const GAS bf16x8*)(xr + 32 * kk);
        const bf16* cmp = CMAT + (size_t)fr * 128 + 8 * fq;
#pragma unroll
        for (int kk = 0; kk < 4; ++kk) cfa[kk] = *(const GAS bf16x8*)(cmp + 32 * kk);
#pragma unroll
        for (int kk = 0; kk < 4; ++kk) sf[kk] = *(const LAS bf16x8*)(Sb + (16 * w + fr) * S5_S_STRIDE + 32 * kk + 8 * fq);
        const int ktl = 512 - (lane >> 5) * 512 + fr * 32 + (fq & 1) * 16;
        const size_t tok0 = (size_t)b * SEQ + (size_t)(128 * q + 16 * w + fr) * TC;
#pragma unroll
        for (int mt = 0; mt < 32; ++mt) {
            if (mt + 1 < 32) {
#pragma unroll
                for (int kk = 0; kk < 4; ++kk) cfb[kk] = *(const GAS bf16x8*)(cmp + (size_t)(16 * (mt + 1)) * 128 + 32 * kk); }
            f32x4 acc = (f32x4){0.f, 0.f, 0.f, 0.f};
#pragma unroll
            for (int kk = 0; kk <= mt / 2; ++kk) { const bf16x8 afrag = *(const LAS bf16x8*)(kt + ktl + (mt - 2 * kk) * 512); acc = __builtin_amdgcn_mfma_f32_16x16x32_bf16(afrag, bf[kk], acc, 0, 0, 0); }
#pragma unroll
            for (int kk = 0; kk < 4; ++kk) acc = __builtin_amdgcn_mfma_f32_16x16x32_bf16(cfa[kk], sf[kk], acc, 0, 0, 0);
            v2u o; o.x = pk2x(gelu_t(acc[0]), gelu_t(acc[1])); o.y = pk2x(gelu_t(acc[2]), gelu_t(acc[3]));
            *(GAS v2u*)(ZB + tile16_off((int)(tok0 + mt), g * SGD + 4 * fq, BW)) = o;
#pragma unroll
            for (int kk = 0; kk < 4; ++kk) cfa[kk] = cfb[kk];
        }
    }
#else
    const int mts[4] = {w, 15 - w, 16 + w, 31 - w};
    bf16x8 cf[4][4];
#pragma unroll
    for (int i = 0; i < 4; ++i)
#pragma unroll
        for (int kk = 0; kk < 4; ++kk) cf[i][kk] = *(const GAS bf16x8*)(CMAT + (size_t)(16 * mts[i] + fr) * 128 + 32 * kk + 8 * fq);
    const int ktl = 512 - (lane >> 5) * 512 + fr * 32 + (fq & 1) * 16;
#pragma unroll 1
    for (int nt = 0; nt < ((part & 2) ? 8 : 0); ++nt) {
        const bf16* xr = XB + (size_t)(128 * q + 16 * nt + fr) * 512 + 8 * fq;
        f32x4 acc[4];
#pragma unroll
        for (int i = 0; i < 4; ++i) acc[i] = (f32x4){0.f, 0.f, 0.f, 0.f};
        { bf16x8 bf[16];
#pragma unroll
            for (int kk = 0; kk < 16; ++kk) bf[kk] = *(const GAS bf16x8*)(xr + 32 * kk);
#if S5_SB3
            __builtin_amdgcn_sched_barrier(0);
#endif
#pragma unroll
            for (int kk = 0; kk < 16; ++kk) {
#pragma unroll
                for (int i = 0; i < 4; ++i) { const int d0 = mts[i] - 2 * kk;
                    if (d0 >= 0) { const bf16x8 afrag = *(const LAS bf16x8*)(kt + ktl + d0 * 512); acc[i] = __builtin_amdgcn_mfma_f32_16x16x32_bf16(afrag, bf[kk], acc[i], 0, 0, 0); } }
                asm volatile("" ::: "memory"); } }
#pragma unroll
        for (int kk = 0; kk < 4; ++kk) { const bf16x8 sfrag = *(const LAS bf16x8*)(Sb + (16 * nt + fr) * S5_S_STRIDE + 32 * kk + 8 * fq);
#pragma unroll
            for (int i = 0; i < 4; ++i) acc[i] = __builtin_amdgcn_mfma_f32_16x16x32_bf16(cf[i][kk], sfrag, acc[i], 0, 0, 0); }
#pragma unroll
        for (int i = 0; i < 4; ++i) { const size_t tok = (size_t)b * SEQ + (size_t)(128 * q + 16 * nt + fr) * TC + mts[i];
            v2u o; o.x = pk2x(gelu_t(acc[i][0]), gelu_t(acc[i][1])); o.y = pk2x(gelu_t(acc[i][2]), gelu_t(acc[i][3]));
            *(GAS v2u*)(ZB + tile16_off((int)tok, g * SGD + 4 * fq, BW)) = o; }
    }
#endif
    __syncthreads();
}

#ifndef X1_BF16
#define X1_BF16 1
#endif
__device__ __forceinline__ void n1_load(Frame& F, const Args& A, int m, f32x4 (&xv)[16], float& pv) {
    const int lane = F.lane; const GAS f32x4* xr = (const GAS f32x4*)(A.in[I_X] + (size_t)m * D) + lane;
    pv = ((const float*)(F.ws + WS_PART) + (size_t)m * 64)[lane];
#pragma unroll
    for (int j = 0; j < 16; ++j) xv[j] = LD_STREAM(xr + 64 * j);
}
__device__ __forceinline__ void n1_mix(Frame& F, int m, v2u (&mv)[16]) {
    const int lane = F.lane;
    const GAS bf16* mixp = (const GAS bf16*)((const bf16*)(F.ws + WS_ARB) + mix_off(m, 4 * lane)); const size_t mstep = mix_off(0, 256);
#pragma unroll
    for (int j = 0; j < 16; ++j) { mv[j] = LD_STREAM((const GAS v2u*)mixp); mixp += mstep; }
}
__device__ __forceinline__ void n1_proc(Frame& F, const Args& A, int m, f32x4 (&v)[16], v2u (&mv)[16], float pv) {
    const int lane = F.lane; const float rstd1 = 1.0f / sqrtf(wave_sum(pv) * (1.f / D) + NORM_EPS);
    const LAS f32x4* g1 = (const LAS f32x4*)(F.lds + RING_OFF) + lane; const LAS f32x4* g2 = (const LAS f32x4*)(F.lds + RING_OFF + D * 4) + lane;
    GAS f32x4* orow = (GAS f32x4*)(F.out + (size_t)m * D) + lane; GAS v2u* x1row = (GAS v2u*)(F.out + (size_t)m * D + D / 2) + lane;
    float s = 0.f;
#pragma unroll
    for (int j = 0; j < 16; ++j) { const f32x4 gg = g1[64 * j]; const v2u mm = mv[j];
        v[j].x += bflo(mm.x) * rstd1 * gg.x; v[j].y += bfhi(mm.x) * rstd1 * gg.y; v[j].z += bflo(mm.y) * rstd1 * gg.z; v[j].w += bfhi(mm.y) * rstd1 * gg.w;
        s += (v[j].x * v[j].x + v[j].y * v[j].y) + (v[j].z * v[j].z + v[j].w * v[j].w);
        if (X1_BF16) { v2u o; o.x = pk2x(v[j].x, v[j].y); o.y = pk2x(v[j].z, v[j].w); ST_STREAM(x1row + 64 * j, o); } else orow[64 * j] = v[j];
        asm volatile("" ::: "memory"); }
    const float rstd2 = 1.0f / sqrtf(wave_sum(s) * (1.f / D) + NORM_EPS);
    float am = 0.f;
#pragma unroll
    for (int j = 0; j < 16; ++j) { const f32x4 gg = g2[64 * j]; v[j].x *= rstd2 * gg.x; v[j].y *= rstd2 * gg.y; v[j].z *= rstd2 * gg.z; v[j].w *= rstd2 * gg.w;
        am = fmaxf(fmaxf(am, fmaxf(fabsf(v[j].x), fabsf(v[j].y))), fmaxf(fabsf(v[j].z), fabsf(v[j].w))); asm volatile("" ::: "memory"); }
    am = fmaxf(wave_max(am), 1e-30f); const float qs = 127.0f / am;
    if (lane == 0) ((float*)(F.ws + WS_RS2))[m] = am * (1.0f / 127.0f);
    GAS unsigned char* q8 = (GAS unsigned char*)(F.ws + WS_H2Q + tile8_off(m, 4 * lane, D)); const size_t qstep = tile8_off(0, 256, D);
#pragma unroll
    for (int j = 0; j < 16; ++j) { *(GAS unsigned*)q8 = pk4_i8(v[j].x * qs, v[j].y * qs, v[j].z * qs, v[j].w * qs); q8 += qstep; }
}
__device__ __forceinline__ void n1_phase(Frame& F, const Args& A) {
    const int gw = F.vcu * NWAVES + F.wave, NGW = F.G * NWAVES;
    for (int i = F.tid; i < D / 4; i += NWAVES * 64) { ((LAS f32x4*)(F.lds + RING_OFF))[i] = ((const GAS f32x4*)A.in[I_NMIXPOST])[i]; ((LAS f32x4*)(F.lds + RING_OFF + D * 4))[i] = ((const GAS f32x4*)A.in[I_NMLPPRE])[i]; }
    __syncthreads();
    f32x4 xa[16], xb[16]; v2u mv[16]; float pa = 0.f, pb = 0.f;
    if (gw < M) n1_load(F, A, gw, xa, pa);
    for (int m = gw; m < M; m += 2 * NGW) {
        const int m1 = m + NGW < M ? m + NGW : m, m2 = m + 2 * NGW < M ? m + 2 * NGW : m1;
        n1_mix(F, m, mv);
        n1_load(F, A, m1, xb, pb);
        n1_proc(F, A, m, xa, mv, pa);
        if (m + NGW < M) {
            n1_mix(F, m1, mv);
            n1_load(F, A, m2, xa, pa);
            n1_proc(F, A, m1, xb, mv, pb); }
    }
}
#if X1_BF16
typedef v2u x1v_t;
#else
typedef f32x4 x1v_t;
#endif
#ifndef ROWS_BATCH
#define ROWS_BATCH 1
#endif
__device__ __forceinline__ void n2_load(Frame& F, int m, x1v_t (&xv)[16], v2u (&fv)[16], float& pv) {
    const int lane = F.lane; const GAS x1v_t* xr = (const GAS x1v_t*)(F.out + (size_t)m * D + (X1_BF16 ? D / 2 : 0)) + lane;
    pv = ((const float*)(F.ws + WS_PART) + (size_t)m * 64)[lane];
#pragma unroll
    for (int j = 0; j < 16; ++j) xv[j] = LD_STREAM(xr + 64 * j);
    const GAS bf16* ffp = (const GAS bf16*)((const bf16*)(F.ws + WS_ARB) + mix_off(m, 4 * lane)); const size_t fstep = mix_off(0, 256);
#pragma unroll
    for (int j = 0; j < 16; ++j) { fv[j] = LD_STREAM((const GAS v2u*)ffp); ffp += fstep; }
}
__device__ __forceinline__ void n2_proc(Frame& F, const Args& A, int m, x1v_t (&v)[16], v2u (&fv)[16], float pv) {
    const int lane = F.lane; const float rstd = 1.0f / sqrtf(wave_sum(pv) * (1.f / D) + NORM_EPS);
    const LAS f32x4* g1 = (const LAS f32x4*)(F.lds + RING_OFF) + lane; GAS f32x4* orow = (GAS f32x4*)(F.out + (size_t)m * D) + lane;
#pragma unroll
    for (int j = 0; j < 16; ++j) { const f32x4 gg = g1[64 * j]; const v2u mm = fv[j]; f32x4 x;
#if X1_BF16
        x.x = bflo(v[j].x); x.y = bfhi(v[j].x); x.z = bflo(v[j].y); x.w = bfhi(v[j].y);
#else
        x = v[j];
#endif
        x.x += bflo(mm.x) * rstd * gg.x; x.y += bfhi(mm.x) * rstd * gg.y; x.z += bflo(mm.y) * rstd * gg.z; x.w += bfhi(mm.y) * rstd * gg.w; ST_STREAM(orow + 64 * j, x); }
}
__device__ __forceinline__ void n2_phase(Frame& F, const Args& A) {
    const int gw = F.vcu * NWAVES + F.wave, NGW = F.G * NWAVES;
    for (int i = F.tid; i < D / 4; i += NWAVES * 64) ((LAS f32x4*)(F.lds + RING_OFF))[i] = ((const GAS f32x4*)A.in[I_NMLPPOST])[i];
    __syncthreads();
    x1v_t xa[16], xb[16]; v2u fa[16], fb[16]; float pa = 0.f, pb = 0.f;
    if (gw < M) n2_load(F, gw, xa, fa, pa);
    for (int m = gw; m < M; m += 2 * NGW) {
        const int m1 = m + NGW < M ? m + NGW : m, m2 = m + 2 * NGW < M ? m + 2 * NGW : m1;
        n2_load(F, m1, xb, fb, pb);
        n2_proc(F, A, m, xa, fa, pa);
        if (m + NGW < M) {
            n2_load(F, m2, xa, fa, pa);
            n2_proc(F, A, m1, xb, fb, pb); }
    }
}

__global__ void __launch_bounds__(NWAVES * 64, 2) mk_fwd(Args args) {
    extern __shared__ __attribute__((aligned(16))) unsigned char lds[];
    Frame F;
    F.lds = (LAS unsigned char*)lds;
    F.MISC = (volatile LAS unsigned*)(F.lds + MISC_OFF);
    F.tid = threadIdx.x; F.lane = F.tid & 63; F.wave = __builtin_amdgcn_readfirstlane(F.tid >> 6);
    F.G = gridDim.x; { const int bx = blockIdx.x; F.vcu = (F.G % 8 == 0) ? (bx % 8) * (F.G / 8) + bx / 8 : bx; }
    F.ws = args.ws; F.out = args.out;
    F.ctl = (gu32*)(F.ws + WS_CTL);
    for (int u = F.tid; u < (LDS_BYTES - LDSCTL_OFF) / 4; u += NWAVES * 64) ((LAS unsigned*)(F.lds + LDSCTL_OFF))[u] = 0u;
    __syncthreads();
    XcdBarrier bar; bar.bar = (unsigned*)(F.ctl + CW_BAR); bar.x = 0; bar.st = nullptr;
    if (N_LAUNCHES == 1) bar = xcd_barrier_post((unsigned*)(F.ctl + CW_BAR), F.MISC + 8);
#define GRID_BAR() do { if (N_LAUNCHES == 1) xcd_barrier(bar); } while (0)
    const int lo = args.ph_lo, hi = args.ph_hi;
#ifndef PH_MASK
#define PH_MASK 0x3ff
#endif
#define IN(k) (((PH_MASK >> (k)) & 1) && lo <= (k) && (k) < hi)
#define BOTH(k) (IN(k) && IN((k) + 1))
#ifndef DUP_MASK
#define DUP_MASK 0
#endif
#define NREP(k) (((DUP_MASK >> (k)) & 1) ? 2 : 1)
    unsigned char* ws = F.ws;
    bf16* ARB = (bf16*)(ws + WS_ARB);

    if (IN(0)) {
_Pragma("unroll")
        for (int rep = 0; rep < NREP(0); ++rep) { p0_prologue(F, args); if (REGQ) p0_quant_rounds(F, args, bar); else { GRID_BAR(); p0_quantize(F, args); } if (BOTH(0) || rep + 1 < NREP(0)) GRID_BAR(); }
    }

    if (IN(1)) {
_Pragma("unroll")
      for (int rep = 0; rep < NREP(1); ++rep) {
        if (N16 > 0) { pg8::Gemm g{ARB, (const bf16*)(ws + WS_WIN), M, N16, D}; pg8::StaticOrder S; S.init(M, N16, F.G, (int)blockIdx.x);
          pg8::EpiIn E{(bf16*)(ws + WS_UA), (bf16*)(ws + WS_VA), (bf16*)(ws + WS_XB2), (bf16*)(ws + WS_GA), (bf16*)(ws + WS_GB), (float*)(ws + WS_PART), 8, 0, 8, nullptr, nullptr, TILED_A};
          pg8::gemm_phase<pg8::EpiIn, pg8::StaticOrder, PG8_ALIGN, PG8_SP2, false, 0, false, true>(F.lds + RING_OFF, g, S, E); }
        { pg8::Gemm g{(const bf16*)(ws + WS_H8), (const bf16*)(ws + WS_W8), M, NG8, D / 2}; pg8::StaticOrder S; S.init(M, NG8, F.G, (int)blockIdx.x);
          pg8::EpiIn E{(bf16*)(ws + WS_UA), (bf16*)(ws + WS_VA), (bf16*)(ws + WS_XB2), (bf16*)(ws + WS_GA), (bf16*)(ws + WS_GB), (float*)(ws + WS_PART), IN_INT8 == 2 ? 0 : 8, IN_INT8 == 2 ? 0 : 8, IN_INT8 == 2 ? 0 : IN_INT8 == 1 ? 8 : 12, (const float*)(ws + WS_RS1), (const float*)(ws + WS_CSIN), TILED_A};
          pg8::gemm_phase<pg8::EpiIn, pg8::StaticOrder, I8_ALIGN, I8_SP2, true, 0, TILED_A, true>(F.lds + RING_OFF, g, S, E); }
        if (BOTH(1) || rep + 1 < NREP(1)) GRID_BAR();
      }
    }

    if (IN(2)) {
_Pragma("unroll")
      for (int rep = 0; rep < NREP(2); ++rep) {
#ifndef SPG_REP
#define SPG_REP 1
#endif
#ifndef S5_REP
#define S5_REP 1
#endif
#ifndef S5_PART
#define S5_PART 3
#endif
_Pragma("unroll 1")
        for (int u = F.vcu; u < 256 * SPG_REP; u += F.G) { spatial_unit(F, args, u & 255); if (SPG_REP > 1) __syncthreads(); }
        __syncthreads();
_Pragma("unroll 1")
        for (int u = F.vcu; u < 256 * S5_REP; u += F.G) { s5_unit(F, u & 255, u < 256 ? 3 : S5_PART); if (S5_REP > 1) __syncthreads(); }
        if (BOTH(2) || rep + 1 < NREP(2)) GRID_BAR();
      }
    }

    if (IN(3)) {
_Pragma("unroll")
      for (int rep = 0; rep < NREP(3); ++rep) {
        pg8::Gemm g{(const bf16*)(ws + WS_ZB), (const bf16*)(ws + WS_WGLU), M, 2 * D, BW}; pg8::StaticOrder S; S.init(M, 2 * D, F.G, (int)blockIdx.x, P345_WGM);
        pg8::EpiGlu E{(bf16*)(ws + WS_GB), TILED_A};
        pg8::gemm_phase<pg8::EpiGlu, pg8::StaticOrder, PG8_ALIGN, PG8_SP2, false, 0, TILED_A, true>(F.lds + RING_OFF, g, S, E);
        if (BOTH(3) || rep + 1 < NREP(3)) GRID_BAR();
      }
    }

    if (IN(4)) {
_Pragma("unroll")
      for (int rep = 0; rep < NREP(4); ++rep) {
        pg8::Gemm g{ARB, (const bf16*)(ws + WS_WPROJ), M, D, AW}; pg8::StaticOrder S; S.init(M, D, F.G, (int)blockIdx.x, P345_WGM);
        pg8::EpiProj E{(bf16*)(ws + WS_GA), (const bf16*)(ws + WS_GB), TILED_A};
        pg8::gemm_phase<pg8::EpiProj, pg8::StaticOrder, PG8_ALIGN, PG8_SP2, false, 0, TILED_A, true>(F.lds + RING_OFF, g, S, E);
        if (BOTH(4) || rep + 1 < NREP(4)) GRID_BAR();
      }
    }

    if (IN(5)) {
_Pragma("unroll")
      for (int rep = 0; rep < NREP(5); ++rep) {
        pg8::Gemm g{(const bf16*)(ws + WS_GA), (const bf16*)(ws + WS_WOUT), M, D, D}; pg8::StaticOrder S; S.init(M, D, F.G, (int)blockIdx.x, P345_WGM);
        pg8::EpiStat E{ARB, (float*)(ws + WS_PART), TILED_MIX};
        pg8::gemm_phase<pg8::EpiStat, pg8::StaticOrder, PG8_ALIGN, PG8_SP2, false, 0, TILED_A, true>(F.lds + RING_OFF, g, S, E);
        if (BOTH(5) || rep + 1 < NREP(5)) GRID_BAR();
      }
    }

    if (IN(6)) {
_Pragma("unroll")
      for (int rep = 0; rep < NREP(6); ++rep) {
        n1_phase(F, args);
        if (BOTH(6) || rep + 1 < NREP(6)) GRID_BAR();
      }
    }

    if (IN(7)) {
_Pragma("unroll")
      for (int rep = 0; rep < NREP(7); ++rep) {
        pg8::Gemm g{(const bf16*)(ws + WS_H2Q), (const bf16*)(ws + WS_WUP), M, DFF, D / 2}; pg8::StaticOrder S; S.init(M, DFF, F.G, (int)blockIdx.x, P7_WGM);
        pg8::EpiUp E{(bf16*)(ws + WS_ARA), (const float*)(ws + WS_RS2), (const float*)(ws + WS_CSUP), TILED_HID};
        pg8::gemm_phase<pg8::EpiUp, pg8::StaticOrder, I8_ALIGN, I8_SP2, true, 0, TILED_A, true>(F.lds + RING_OFF, g, S, E);
        if (BOTH(7) || rep + 1 < NREP(7)) GRID_BAR();
      }
    }

    if (IN(8)) {
_Pragma("unroll")
      for (int rep = 0; rep < NREP(8); ++rep) {
        pg8::Gemm g{(const bf16*)(ws + WS_ARA), (const bf16*)(ws + WS_WDN), M, D, DFF}; pg8::StaticOrder S; S.init(M, D, F.G, (int)blockIdx.x, P8_WGM);
        pg8::EpiStat E{ARB, (float*)(ws + WS_PART), TILED_MIX};
        pg8::gemm_phase<pg8::EpiStat, pg8::StaticOrder, PG8_ALIGN, PG8_SP2, false, P8_AUXA, TILED_HID != 0, true>(F.lds + RING_OFF, g, S, E);
        if (BOTH(8) || rep + 1 < NREP(8)) GRID_BAR();
      }
    }

    if (IN(9)) {
_Pragma("unroll")
      for (int rep = 0; rep < NREP(9); ++rep) {
        n2_phase(F, args);
        if (rep + 1 < NREP(9)) GRID_BAR();
      }
    }
#undef IN
#undef BOTH
}

extern "C" void kernel_launch(void* const* d_in, const int* in_sizes, int n_in, void* d_out, int out_size, void* d_ws, size_t ws_size, hipStream_t stream) {
    static int grid = 0;
    if (grid == 0) {
        if (n_in != 24 || in_sizes[0] != M * D || out_size != M * D || ws_size < WS_END) { fprintf(stderr, "kernel_launch: unexpected shapes / workspace (n_in %d, ws %zu < %zu)\n", n_in, ws_size, (size_t)WS_END); grid = -1; return; }
        int dev = 0, cus = 0, per_cu = 0;
        if (hipGetDevice(&dev) != hipSuccess || hipDeviceGetAttribute(&cus, hipDeviceAttributeMultiprocessorCount, dev) != hipSuccess) { grid = -1; return; }
        if (hipFuncSetAttribute((const void*)mk_fwd, hipFuncAttributeMaxDynamicSharedMemorySize, LDS_BYTES) != hipSuccess) { grid = -1; return; }
        if (hipOccupancyMaxActiveBlocksPerMultiprocessor(&per_cu, (const void*)mk_fwd, NWAVES * 64, LDS_BYTES) != hipSuccess || per_cu < 1) { fprintf(stderr, "kernel_launch: occupancy query says %d\n", per_cu); }
        (void)hipGetLastError();
        grid = cus;
    }
    if (grid < 0) return;
    if (hipMemsetAsync((char*)d_ws + WS_CTL, 0, CTL_ZERO_BYTES, stream) != hipSuccess) return;
    Args a{};
    for (int i = 0; i < 24; ++i) a.in[i] = (const float*)d_in[i];
    a.out = (float*)d_out; a.ws = (unsigned char*)d_ws;
    if (N_LAUNCHES == 1) { a.ph_lo = 0; a.ph_hi = N_PHASES; hipLaunchKernelGGL(mk_fwd, dim3(grid), dim3(NWAVES * 64), LDS_BYTES, stream, a); }
    else for (int li = 0; li < N_PHASES; ++li) { a.ph_lo = li; a.ph_hi = li + 1; hipLaunchKernelGGL(mk_fwd, dim3(grid), dim3(NWAVES * 64), LDS_BYTES, stream, a); }
}
```

```cpp
#include <hip/hip_runtime.h>
#include <cstdio>
#include <cstdint>

#ifndef MK_N_LAUNCHES
#define MK_N_LAUNCHES 1
#endif
namespace pg8 {
#define PG8_LAS __attribute__((address_space(3)))
typedef unsigned short bf16_t;
typedef short bf16x8 __attribute__((ext_vector_type(8)));
typedef float f32x4 __attribute__((ext_vector_type(4)));
typedef unsigned u32x4 __attribute__((ext_vector_type(4)));
typedef int v4i_t __attribute__((ext_vector_type(4)));
typedef int v8i_t __attribute__((ext_vector_type(8)));
constexpr int BM = 256, BK = 64, HALF = 128, HTB = HALF * BK * 2  , STAGE_BYTES = 8 * HTB, NXCD = 8, WGM = 8;

__host__ __device__ __forceinline__ int lds_byte(int r, int c) { const int st = (r >> 4) * 2 + (c >> 5), rr = r & 15, cc = c & 31, ob = rr * 64 + cc * 2; return st * 1024 + (ob ^ (((ob >> 9) & 1) << 5)); }
__host__ __device__ __forceinline__ void stage_rc(int b, int& R, int& C) { const int st = b / 1024, sb = b % 1024, swz = sb ^ (((sb >> 9) & 1) << 5); R = (st >> 1) * 16 + swz / 64; C = (st & 1) * 32 + (swz % 64) / 2; }
__host__ __device__ __forceinline__ int perm32(int rho) { const int n = rho >> 4, i = rho & 15; return 8 * (i >> 2) + 4 * n + (i & 3); }

struct Unit { int pm, pn; };
struct Gemm { const bf16_t* A; const bf16_t* Bt; int M, N, K; };

struct StaticOrder {
    int nM, nN, nwg, G, c, wgm;
    __host__ __device__ void init(int M, int N, int G_, int c_, int wgm_ = WGM) { nM = M / BM; nN = N / BM; nwg = nM * nN; G = G_; c = c_; wgm = wgm_; }
    __host__ __device__ __forceinline__ bool next(int i, Unit& u) const {
        const long L = (long)i * G + c; if (L >= nwg) return false;
        int wgid = (int)L; { const int q = nwg / NXCD, r = nwg % NXCD, xcd = wgid % NXCD, off = wgid / NXCD; wgid = (xcd < r ? xcd * (q + 1) : r * (q + 1) + (xcd - r) * q) + off; }
        const int nig = wgm * nN, gid = wgid / nig, fm = gid * wgm, gsz = (nM - fm) < wgm ? (nM - fm) : wgm;
        u.pm = fm + ((wgid % nig) % gsz); u.pn = (wgid % nig) / gsz; return true;
    }
    __device__ __forceinline__ void a_ready(const Unit&) const {}
    __device__ __forceinline__ void done(const Unit&) const {}
};

__device__ __forceinline__ unsigned cvt_pk_bf16(float lo, float hi) { unsigned r; asm volatile("v_cvt_pk_bf16_f32 %0, %1, %2" : "=v"(r) : "v"(lo), "v"(hi)); return r; }
#ifndef MANT6
#define MANT6 0
#endif
__device__ __forceinline__ unsigned cvt_pk_op(float lo, float hi) {
#if MANT6
    unsigned a = __float_as_uint(lo), b = __float_as_uint(hi); a += 0xFFFFu + ((a >> 17) & 1u); b += 0xFFFFu + ((b >> 17) & 1u); return ((a >> 16) & 0xFFFEu) | (b & 0xFFFE0000u);
#else
    return cvt_pk_bf16(lo, hi);
#endif
}
typedef float f32x2 __attribute__((ext_vector_type(2)));
__device__ __forceinline__ f32x2 gelu_pk(f32x2 v) {
    const f32x2 av = __builtin_elementwise_abs(v), d = av * 0.2316418882f + 1.0f;
    f32x2 t; t.x = __builtin_amdgcn_rcpf(d.x); t.y = __builtin_amdgcn_rcpf(d.y);
    f32x2 q = t * 0.5307027145f + (-0.7265760135f); q = q * t + 0.7107068705f; q = q * t + (-0.142248368f); q = q * t + 0.127414796f; q = q * t;
    const f32x2 s = (v * v) * (-0.72134752044f);
    f32x2 e; e.x = __builtin_amdgcn_exp2f(s.x); e.y = __builtin_amdgcn_exp2f(s.y);
    const f32x2 m = v * (q * e), r = v - m;
    f32x2 o; o.x = v.x < 0.f ? m.x : r.x; o.y = v.y < 0.f ? m.y : r.y; return o;
}

typedef unsigned u32x2 __attribute__((ext_vector_type(2)));
#ifndef UP_NT
#define UP_NT 0
#endif
#if UP_NT
#define UP_STORE(p, v) __builtin_nontemporal_store((v), (p))
#else
#define UP_STORE(p, v) (*(p) = (v))
#endif
#ifndef EPI_NT
#define EPI_NT 0
#endif
#if EPI_NT
#define NT_STORE(p, v) __builtin_nontemporal_store((v), (p))
#else
#define NT_STORE(p, v) (*(p) = (v))
#endif
__device__ __forceinline__ float sigmoid_f(float x) { return __builtin_amdgcn_rcpf(1.0f + __builtin_amdgcn_exp2f(-1.4426950409f * x)); }
__device__ __forceinline__ float gelu_tanh_f(float x) { const float u = x * (1.0f + 0.044715f * x * x); return x * __builtin_amdgcn_rcpf(1.0f + __builtin_amdgcn_exp2f(-2.3022082f * u)); }
__device__ __forceinline__ float bf_lo(unsigned w) { return __uint_as_float(w << 16); }
__device__ __forceinline__ float bf_hi(unsigned w) { return __uint_as_float(w & 0xffff0000u); }
__device__ __forceinline__ u32x4 pack8(const f32x4& v0, const f32x4& v1) { u32x4 w; w.x = cvt_pk_op(v0[0], v0[1]); w.y = cvt_pk_op(v0[2], v0[3]); w.z = cvt_pk_op(v1[0], v1[1]); w.w = cvt_pk_op(v1[2], v1[3]); return w; }
__device__ __forceinline__ u32x4 pack8f(const f32x4& v0, const f32x4& v1) { u32x4 w; w.x = cvt_pk_bf16(v0[0], v0[1]); w.y = cvt_pk_bf16(v0[2], v0[3]); w.z = cvt_pk_bf16(v1[0], v1[1]); w.w = cvt_pk_bf16(v1[2], v1[3]); return w; }

__device__ __forceinline__ size_t t4096_off(bool tiled, int row, int c) { return tiled ? ((((size_t)(row >> 8) * 64 + (size_t)(c >> 6)) * 256 + (size_t)(row & 255)) * 64 + (size_t)(c & 63)) : ((size_t)row * 4096 + c); }
struct EpiIn {
    static constexpr bool PERM = true, AFTER_DRAIN = false;
    bf16_t *UA, *VA, *XB2, *GA, *GB; float* VST; int split, off_lo, off_hi; const float* rs; const float* cs; int ga_tiled;
    __device__ __forceinline__ void operator()(const f32x4 (&acc)[2][2][4][2], const Unit& u, int wr, int wc, int fr, int fq) const {
        const int row0 = u.pm * BM + wr * 64 + fr; const int pn = u.pn + (u.pn < split ? off_lo : off_hi);
        int mode, ldc, colt; bf16_t* base;
        if (pn < 8) { mode = 0; base = UA; ldc = 2048; colt = pn * 256; }
        else if (pn < 16) { mode = 0; base = VA; ldc = 2048; colt = (pn - 8) * 256; }
        else if (pn < 20) { mode = 1; base = XB2; ldc = 0; colt = (pn - 16) * 256; }
        else if (pn < 36) { mode = 2; base = GA; ldc = 4096; colt = (pn - 20) * 256; }
        else { mode = 2; base = GB; ldc = 4096; colt = (pn - 36) * 256; }
        const int col0 = colt + wc * 32 + 8 * fq; const bool vstat = (pn >= 8 && pn < 16); const bool q8 = (rs != nullptr);
        f32x4 csv[2][2];
        if (q8) {
#pragma unroll
            for (int bj = 0; bj < 2; ++bj) { const float* cp = cs + u.pn * BM + wc * 32 + 8 * fq + bj * HALF; csv[bj][0] = *(const f32x4*)cp; csv[bj][1] = *(const f32x4*)(cp + 4); } }
        float rsa[2][4];
#pragma unroll
        for (int ai = 0; ai < 2; ++ai)
#pragma unroll
            for (int m = 0; m < 4; ++m) rsa[ai][m] = q8 ? rs[row0 + ai * HALF + m * 16] : 1.0f;
        __builtin_amdgcn_sched_barrier(0);
#pragma unroll
        for (int ai = 0; ai < 2; ++ai)
#pragma unroll
            for (int m = 0; m < 4; ++m) { const int row = row0 + ai * HALF + m * 16; float s1 = 0.f, s2 = 0.f; const float rsv = rsa[ai][m];
#pragma unroll
                for (int bj = 0; bj < 2; ++bj) { f32x4 v0 = acc[ai][bj][m][0], v1 = acc[ai][bj][m][1]; const int c = col0 + bj * HALF;
                    if (q8) {
#pragma unroll
                        for (int j = 0; j < 4; ++j) { v0[j] = (float)__float_as_int(v0[j]) * (rsv * csv[bj][0][j]); v1[j] = (float)__float_as_int(v1[j]) * (rsv * csv[bj][1][j]); } }
                    if (mode == 0) {
#pragma unroll
                        for (int j = 0; j < 4; ++j) { v0[j] = gelu_tanh_f(v0[j]); v1[j] = gelu_tanh_f(v1[j]); }
                        if (vstat) { s1 += ((v0[0] + v0[1]) + (v0[2] + v0[3])) + ((v1[0] + v1[1]) + (v1[2] + v1[3]));
                            s2 += ((v0[0] * v0[0] + v0[1] * v0[1]) + (v0[2] * v0[2] + v0[3] * v0[3])) + ((v1[0] * v1[0] + v1[1] * v1[1]) + (v1[2] * v1[2] + v1[3] * v1[3])); } }
                    else if (mode == 2) {
#pragma unroll
                        for (int j = 0; j < 4; ++j) { v0[j] = sigmoid_f(v0[j]); v1[j] = sigmoid_f(v1[j]); } }
                    bf16_t* p;
                    if (mode == 1) p = base + ((((size_t)(c >> 4) * 512 + (size_t)(row >> 5)) * 32 + (size_t)(row & 31)) * 16 + (size_t)(c & 15));
                    else if (mode == 0 && ga_tiled) p = base + ((((size_t)(row >> 7) * 16 + (size_t)(c >> 7)) * 128 + (size_t)(row & 127)) * 128 + (size_t)(c & 127));
                    else if (mode == 2) p = base + t4096_off(ga_tiled != 0, row, c);
                    else p = base + (size_t)row * ldc + c;
                    NT_STORE((u32x4*)p, pack8(v0, v1)); }
                if (vstat) { s1 += __shfl_xor(s1, 16); s1 += __shfl_xor(s1, 32); s2 += __shfl_xor(s2, 16); s2 += __shfl_xor(s2, 32);
                    if (fq == 0) { f32x2 o; o.x = s1; o.y = s2; *(f32x2*)(VST + ((size_t)row * 32 + (pn - 8) * 4 + wc) * 2) = o; } } }
    }
};
#ifndef EPI_NT_LD
#define EPI_NT_LD 1
#endif
#if EPI_NT_LD
#define EPI_LD1(p) __builtin_nontemporal_load(p)
#else
#define EPI_LD1(p) (*(p))
#endif
struct EpiGlu {
    static constexpr bool PERM = true, AFTER_DRAIN = false;
    bf16_t* GBm; int gb_tiled;
    __device__ __forceinline__ void operator()(const f32x4 (&acc)[2][2][4][2], const Unit& u, int wr, int wc, int fr, int fq) const {
        const int row0 = u.pm * BM + wr * 64 + fr, oc0 = u.pn * 128 + wc * 32 + 8 * fq;
        u32x4 ga[2][4];
#pragma unroll
        for (int ai = 0; ai < 2; ++ai)
#pragma unroll
            for (int m = 0; m < 4; ++m) ga[ai][m] = EPI_LD1((const u32x4*)(GBm + t4096_off(gb_tiled != 0, row0 + ai * HALF + m * 16, oc0)));
        __builtin_amdgcn_sched_barrier(0);
#pragma unroll
        for (int ai = 0; ai < 2; ++ai)
#pragma unroll
            for (int m = 0; m < 4; ++m) { bf16_t* p = GBm + t4096_off(gb_tiled != 0, row0 + ai * HALF + m * 16, oc0); const u32x4 g = ga[ai][m];
                const f32x4 a0 = acc[ai][0][m][0], a1 = acc[ai][0][m][1], b0 = acc[ai][1][m][0], b1 = acc[ai][1][m][1]; f32x4 o0, o1;
                o0[0] = a0[0] * sigmoid_f(b0[0]) * bf_lo(g.x); o0[1] = a0[1] * sigmoid_f(b0[1]) * bf_hi(g.x); o0[2] = a0[2] * sigmoid_f(b0[2]) * bf_lo(g.y); o0[3] = a0[3] * sigmoid_f(b0[3]) * bf_hi(g.y);
                o1[0] = a1[0] * sigmoid_f(b1[0]) * bf_lo(g.z); o1[1] = a1[1] * sigmoid_f(b1[1]) * bf_hi(g.z); o1[2] = a1[2] * sigmoid_f(b1[2]) * bf_lo(g.w); o1[3] = a1[3] * sigmoid_f(b1[3]) * bf_hi(g.w);
                *(u32x4*)p = pack8(o0, o1); }
    }
};
struct EpiProj {
    static constexpr bool PERM = true, AFTER_DRAIN = false;
    bf16_t* GA; const bf16_t* GBm; int ga_tiled;
    __device__ __forceinline__ void operator()(const f32x4 (&acc)[2][2][4][2], const Unit& u, int wr, int wc, int fr, int fq) const {
        const int row0 = u.pm * BM + wr * 64 + fr, col0 = u.pn * BM + wc * 32 + 8 * fq;
#pragma unroll
        for (int ai = 0; ai < 2; ++ai) {
            u32x4 gav[4][2], gbv[4][2];
#pragma unroll
            for (int m = 0; m < 4; ++m)
#pragma unroll
                for (int bj = 0; bj < 2; ++bj) { const int rr = row0 + ai * HALF + m * 16, cc = col0 + bj * HALF;
                    const bf16_t* gap = ga_tiled ? GA + ((((size_t)(rr >> 8) * 64 + (size_t)(cc >> 6)) * 256 + (size_t)(rr & 255)) * 64 + (size_t)(cc & 63)) : GA + (size_t)rr * 4096 + cc;
                    gav[m][bj] = EPI_LD1((const u32x4*)gap); gbv[m][bj] = EPI_LD1((const u32x4*)(GBm + t4096_off(ga_tiled != 0, rr, cc))); }
            __builtin_amdgcn_sched_barrier(0);
#pragma unroll
            for (int m = 0; m < 4; ++m) { const size_t off = (size_t)(row0 + ai * HALF + m * 16) * 4096 + col0;
#pragma unroll
                for (int bj = 0; bj < 2; ++bj) { const int rr = row0 + ai * HALF + m * 16, cc = col0 + bj * HALF;
                    bf16_t* gap = ga_tiled ? GA + ((((size_t)(rr >> 8) * 64 + (size_t)(cc >> 6)) * 256 + (size_t)(rr & 255)) * 64 + (size_t)(cc & 63)) : GA + off + bj * HALF;
                    const u32x4 ga = gav[m][bj], gb = gbv[m][bj];
                    const f32x4 a0 = acc[ai][bj][m][0], a1 = acc[ai][bj][m][1]; f32x4 o0, o1;
                    o0[0] = a0[0] * bf_lo(ga.x) + bf_lo(gb.x); o0[1] = a0[1] * bf_hi(ga.x) + bf_hi(gb.x); o0[2] = a0[2] * bf_lo(ga.y) + bf_lo(gb.y); o0[3] = a0[3] * bf_hi(ga.y) + bf_hi(gb.y);
                    o1[0] = a1[0] * bf_lo(ga.z) + bf_lo(gb.z); o1[1] = a1[1] * bf_hi(ga.z) + bf_hi(gb.z); o1[2] = a1[2] * bf_lo(ga.w) + bf_lo(gb.w); o1[3] = a1[3] * bf_hi(ga.w) + bf_hi(gb.w);
                    *(u32x4*)gap = pack8(o0, o1); } } }
    }
};
struct EpiStat {
    static constexpr bool PERM = true, AFTER_DRAIN = false;
    bf16_t* O; float* part; int tiled;
    __device__ __forceinline__ void operator()(const f32x4 (&acc)[2][2][4][2], const Unit& u, int wr, int wc, int fr, int fq) const {
        const int row0 = u.pm * BM + wr * 64 + fr, col0 = u.pn * BM + wc * 32 + 8 * fq;
#pragma unroll
        for (int ai = 0; ai < 2; ++ai)
#pragma unroll
            for (int m = 0; m < 4; ++m) { const int row = row0 + ai * HALF + m * 16; float s = 0.f;
#pragma unroll
                for (int bj = 0; bj < 2; ++bj) { const f32x4 v0 = acc[ai][bj][m][0], v1 = acc[ai][bj][m][1];
                    s += (v0[0] * v0[0] + v0[1] * v0[1]) + (v0[2] * v0[2] + v0[3] * v0[3]) + (v1[0] * v1[0] + v1[1] * v1[1]) + (v1[2] * v1[2] + v1[3] * v1[3]);
                    *(u32x4*)(O + t4096_off(tiled != 0, row, col0 + bj * HALF)) = pack8f(v0, v1); }
                s += __shfl_xor(s, 16); s += __shfl_xor(s, 32);
                if (fq == 0) part[(size_t)row * 64 + u.pn * 4 + wc] = s; }
    }
};
struct EpiUp {
    static constexpr bool PERM = true, AFTER_DRAIN = false;
    bf16_t* H; const float* rs; const float* cs; int tiled;
    __device__ __forceinline__ void operator()(const f32x4 (&acc)[2][2][4][2], const Unit& u, int wr, int wc, int fr, int fq) const {
        const int row0 = u.pm * BM + wr * 64 + fr, col0 = u.pn * BM + wc * 32 + 8 * fq; const bool q8 = (rs != nullptr);
        f32x4 csv[2][2];
        if (q8) {
#pragma unroll
            for (int bj = 0; bj < 2; ++bj) { const float* cp = cs + col0 + bj * HALF; csv[bj][0] = *(const f32x4*)cp; csv[bj][1] = *(const f32x4*)(cp + 4); } }
        float rsa[2][4];
#pragma unroll
        for (int ai = 0; ai < 2; ++ai)
#pragma unroll
            for (int m = 0; m < 4; ++m) rsa[ai][m] = q8 ? rs[row0 + ai * HALF + m * 16] : 1.0f;
        __builtin_amdgcn_sched_barrier(0);
#pragma unroll
        for (int ai = 0; ai < 2; ++ai)
#pragma unroll
            for (int m = 0; m < 4; ++m) { const int row = row0 + ai * HALF + m * 16; const float rsv = rsa[ai][m];
                bf16_t* rowp = tiled ? H + (((size_t)u.pm * 256 + (size_t)(u.pn * 4 + (wc >> 1))) * 256 + (size_t)(row & 255)) * 64 + (wc & 1) * 32 + 8 * fq : H + (size_t)row * 16384 + col0;
#pragma unroll
                for (int bj = 0; bj < 2; ++bj) { f32x4 v0 = acc[ai][bj][m][0], v1 = acc[ai][bj][m][1];
                    if (q8) {
#pragma unroll
                        for (int j = 0; j < 4; ++j) { v0[j] = (float)__float_as_int(v0[j]) * (rsv * csv[bj][0][j]); v1[j] = (float)__float_as_int(v1[j]) * (rsv * csv[bj][1][j]); } }
#pragma unroll
                    for (int j = 0; j < 4; ++j) { const float a = fmaxf(v0[j], 0.f), b = fmaxf(v1[j], 0.f); v0[j] = a * a; v1[j] = b * b; }
                    UP_STORE((u32x4*)(rowp + (tiled ? bj * 2 * 256 * 64 : bj * HALF)), pack8(v0, v1)); } }
    }
};

template <class Epi, class Sched, bool ALIGN_EPI = false, bool SP2 = false, bool I8 = false, int AUXA = 0, bool TA = false, bool TB = false>
__device__ __forceinline__ void gemm_phase(PG8_LAS unsigned char* lds, const Gemm g, const Sched& S, const Epi& E) {
    const int tid = threadIdx.x, wid = __builtin_amdgcn_readfirstlane(tid >> 6), lane = tid & 63, wr = wid >> 2, wc = wid & 3, fr = lane & 15, fq = lane >> 4;
    const int K = g.K, nt = K / BK;
    unsigned voffA[2], voffB[2];
#pragma unroll
    for (int i = 0; i < 2; ++i) { int R, C; stage_rc(tid * 16 + i * 8192, R, C); const int Rb = Epi::PERM ? ((R & ~31) + perm32(R & 31)) : R;
        voffA[i] = (unsigned)(R * (TA ? BK : K) + C) * 2u; voffB[i] = (unsigned)(Rb * (TB ? BK : K) + C) * 2u; }
    const size_t kstepA = TA ? (size_t)BM * BK * 2 : (size_t)(BK * 2), kstepB = TB ? (size_t)BM * BK * 2 : (size_t)(BK * 2);
    const size_t hstepA = TA ? (size_t)HALF * BK * 2 : (size_t)HALF * K * 2, hstepB = TB ? (size_t)HALF * BK * 2 : (size_t)HALF * K * 2;
    const size_t hstep = (size_t)HALF * K * 2;
    const size_t tstep = 2 * hstep;
    const unsigned ldsw = (unsigned)wid * 1024u;
    const int aoff = lds_byte(wr * 64 + fr, fq * 8), boff = lds_byte(wc * 32 + fr, fq * 8);
#define PG8_SA(b, h) (((b) * 2 + (h)) * HTB)
#define PG8_SB(b, h) ((4 + (b) * 2 + (h)) * HTB)
#define PG8_STAGE(bufoff, gbase, voff) do { _Pragma("unroll") for (int _i = 0; _i < 2; ++_i) \
        __builtin_amdgcn_global_load_lds((const unsigned*)((const char*)(gbase) + (voff)[_i]), (PG8_LAS unsigned*)(lds + (bufoff) + ldsw + _i * 8192), 16, 0, 0); } while (0)
#define PG8_STAGEA(bufoff, gbase, voff) do { _Pragma("unroll") for (int _i = 0; _i < 2; ++_i) \
        __builtin_amdgcn_global_load_lds((const unsigned*)((const char*)(gbase) + (voff)[_i]), (PG8_LAS unsigned*)(lds + (bufoff) + ldsw + _i * 8192), 16, 0, AUXA); } while (0)
#define PG8_LDA(dst, b, h) do { _Pragma("unroll") for (int m = 0; m < 4; ++m) _Pragma("unroll") for (int k = 0; k < 2; ++k) dst[m][k] = *(const PG8_LAS bf16x8*)(lds + PG8_SA(b, h) + aoff + m * 2048 + k * 1024); } while (0)
#define PG8_LDB(dst, b, h) do { _Pragma("unroll") for (int n = 0; n < 2; ++n) _Pragma("unroll") for (int k = 0; k < 2; ++k) dst[n][k] = *(const PG8_LAS bf16x8*)(lds + PG8_SB(b, h) + boff + n * 2048 + k * 1024); } while (0)
#define PG8_MMA(ai, bj, At, Bt) do { __builtin_amdgcn_s_setprio(1); _Pragma("unroll") for (int m = 0; m < 4; ++m) _Pragma("unroll") for (int n = 0; n < 2; ++n) _Pragma("unroll") for (int k = 0; k < 2; ++k) { \
        if constexpr (I8) { acc[ai][bj][m][n] = __builtin_bit_cast(f32x4, __builtin_amdgcn_mfma_i32_16x16x64_i8(__builtin_bit_cast(v4i_t, Bt[n][k]), __builtin_bit_cast(v4i_t, At[m][k]), __builtin_bit_cast(v4i_t, acc[ai][bj][m][n]), 0, 0, 0)); } \
        else acc[ai][bj][m][n] = __builtin_amdgcn_mfma_f32_16x16x32_bf16(Bt[n][k], At[m][k], acc[ai][bj][m][n], 0, 0, 0); } __builtin_amdgcn_s_setprio(0); } while (0)
#define PG8_WAIT_V(n) asm volatile("s_waitcnt vmcnt(" #n ")" ::: "memory")
#define PG8_WAIT_L(n) asm volatile("s_waitcnt lgkmcnt(" #n ")" ::: "memory")
#define PG8_BAR __builtin_amdgcn_s_barrier()
#define PG8_SCHED __builtin_amdgcn_sched_barrier(0)
    Unit cur, nxt; int ui = 0;
    if (!S.next(0, cur)) return;
    f32x4 acc[2][2][4][2];
#pragma unroll
    for (int a = 0; a < 2; ++a)
#pragma unroll
        for (int b = 0; b < 2; ++b)
#pragma unroll
            for (int m = 0; m < 4; ++m)
#pragma unroll
                for (int n = 0; n < 2; ++n) acc[a][b][m][n] = (f32x4){0.f, 0.f, 0.f, 0.f};
    bf16x8 At[4][2], B0[2][2], B1[2][2];
    const char* cA = (const char*)g.A + (size_t)cur.pm * tstep; const char* cB = (const char*)g.Bt + (size_t)cur.pn * tstep;
    S.a_ready(cur);
    if constexpr (SP2) {
        PG8_STAGE(PG8_SB(0, 0), cB, voffB); PG8_STAGE(PG8_SB(0, 1), cB + hstepB, voffB); PG8_STAGEA(PG8_SA(0, 0), cA, voffA); PG8_STAGEA(PG8_SA(0, 1), cA + hstepA, voffA);
        if (wr == 1) PG8_BAR;
        PG8_WAIT_V(2); PG8_BAR;
        PG8_STAGE(PG8_SB(1, 0), cB + kstepB, voffB); PG8_STAGEA(PG8_SA(1, 0), cA + kstepA, voffA); PG8_STAGE(PG8_SB(1, 1), cB + hstepB + kstepB, voffB);
        PG8_WAIT_V(6); PG8_BAR;
    } else {
        PG8_STAGE(PG8_SB(0, 0), cB, voffB); PG8_STAGEA(PG8_SA(0, 0), cA, voffA); PG8_STAGE(PG8_SB(0, 1), cB + hstepB, voffB); PG8_STAGEA(PG8_SA(0, 1), cA + hstepA, voffA);
        if (wr == 1) PG8_BAR;
        PG8_WAIT_V(4); PG8_BAR;
        PG8_STAGE(PG8_SB(1, 0), cB + kstepB, voffB); PG8_STAGEA(PG8_SA(1, 0), cA + kstepA, voffA); PG8_STAGE(PG8_SB(1, 1), cB + hstepB + kstepB, voffB);
        PG8_WAIT_V(6); PG8_BAR;
    }
    for (;;) {
        const bool has_next = S.next(ui + 1, nxt);
        const char* nA = has_next ? (const char*)g.A + (size_t)nxt.pm * tstep : cA; const char* nB = has_next ? (const char*)g.Bt + (size_t)nxt.pn * tstep : cB;
        for (int t = 0; t < nt; t += 2) {
            const bool last = (t == nt - 2);
            const char* a1 = cA + (size_t)(t + 1) * kstepA;
            const char* a2 = last ? nA : cA + (size_t)(t + 2) * kstepA; const char* b2 = last ? nB : cB + (size_t)(t + 2) * kstepB;
            const char* a3 = a2 + kstepA; const char* b3 = b2 + kstepB;
            if (last && has_next) S.a_ready(nxt);
            if constexpr (SP2) {
            PG8_LDB(B0, 0, 0); PG8_LDB(B1, 0, 1); PG8_SCHED; PG8_LDA(At, 0, 0); PG8_STAGEA(PG8_SA(1, 1), a1 + hstepA, voffA);
            PG8_WAIT_V(8); PG8_WAIT_L(0); PG8_BAR; PG8_MMA(0, 0, At, B0); PG8_MMA(0, 1, At, B1); PG8_BAR; PG8_SCHED;
            PG8_LDA(At, 0, 1); PG8_STAGE(PG8_SB(0, 0), b2, voffB); PG8_STAGE(PG8_SB(0, 1), b2 + hstepB, voffB); PG8_STAGEA(PG8_SA(0, 0), a2, voffA);
            PG8_WAIT_V(8); PG8_WAIT_L(0); PG8_BAR; PG8_MMA(1, 0, At, B0); PG8_MMA(1, 1, At, B1); PG8_BAR; PG8_SCHED;
            PG8_LDB(B0, 1, 0); PG8_LDB(B1, 1, 1); PG8_SCHED; PG8_LDA(At, 1, 0); PG8_STAGEA(PG8_SA(0, 1), a2 + hstepA, voffA);
            PG8_WAIT_V(8); PG8_WAIT_L(0); PG8_BAR; PG8_MMA(0, 0, At, B0); PG8_MMA(0, 1, At, B1); PG8_BAR; PG8_SCHED;
            PG8_LDA(At, 1, 1); PG8_STAGE(PG8_SB(1, 0), b3, voffB); PG8_STAGE(PG8_SB(1, 1), b3 + hstepB, voffB); PG8_STAGEA(PG8_SA(1, 0), a3, voffA);
            PG8_WAIT_V(8); PG8_WAIT_L(0); PG8_BAR; PG8_MMA(1, 0, At, B0); PG8_MMA(1, 1, At, B1); PG8_BAR; PG8_SCHED;
            } else {
            PG8_LDB(B0, 0, 0); PG8_SCHED; PG8_LDA(At, 0, 0); PG8_STAGEA(PG8_SA(1, 1), a1 + hstepA, voffA);
            PG8_WAIT_L(8); PG8_BAR; PG8_WAIT_L(0); PG8_MMA(0, 0, At, B0); PG8_BAR; PG8_SCHED;
            PG8_LDB(B1, 0, 1); PG8_STAGE(PG8_SB(0, 0), b2, voffB);
            PG8_BAR; PG8_WAIT_L(0); PG8_MMA(0, 1, At, B1); PG8_BAR;
            PG8_LDA(At, 0, 1); PG8_STAGEA(PG8_SA(0, 0), a2, voffA);
            PG8_BAR; PG8_WAIT_L(0); PG8_MMA(1, 0, At, B0); PG8_BAR; PG8_SCHED;
            PG8_STAGE(PG8_SB(0, 1), b2 + hstepB, voffB);
            PG8_WAIT_V(6); PG8_BAR; PG8_MMA(1, 1, At, B1); PG8_BAR;
            PG8_LDB(B0, 1, 0); PG8_SCHED; PG8_LDA(At, 1, 0); PG8_STAGEA(PG8_SA(0, 1), a2 + hstepA, voffA);
            PG8_WAIT_L(8); PG8_BAR; PG8_WAIT_L(0); PG8_MMA(0, 0, At, B0); PG8_BAR; PG8_SCHED;
            PG8_LDB(B1, 1, 1); PG8_STAGE(PG8_SB(1, 0), b3, voffB);
            PG8_BAR; PG8_WAIT_L(0); PG8_MMA(0, 1, At, B1); PG8_BAR;
            PG8_LDA(At, 1, 1); PG8_STAGEA(PG8_SA(1, 0), a3, voffA);
            PG8_BAR; PG8_WAIT_L(0); PG8_MMA(1, 0, At, B0); PG8_BAR; PG8_SCHED;
            PG8_STAGE(PG8_SB(1, 1), b3 + hstepB, voffB);
            PG8_WAIT_V(6); PG8_BAR; PG8_MMA(1, 1, At, B1); PG8_BAR;
            }
        }
        if constexpr (ALIGN_EPI) { if (wr == 0) PG8_BAR; }
        if constexpr (!Epi::AFTER_DRAIN) { E(acc, cur, wr, wc, fr, fq); S.done(cur); }
        if (!has_next) break;
#pragma unroll
        for (int a = 0; a < 2; ++a)
#pragma unroll
            for (int b = 0; b < 2; ++b)
#pragma unroll
                for (int m = 0; m < 4; ++m)
#pragma unroll
                    for (int n = 0; n < 2; ++n) acc[a][b][m][n] = (f32x4){0.f, 0.f, 0.f, 0.f};
        cur = nxt; cA = nA; cB = nB; ++ui;
        if constexpr (ALIGN_EPI) { if (wr == 1) PG8_BAR; }
    }
    PG8_WAIT_V(0);
    if constexpr (!ALIGN_EPI) { if (wr == 0) PG8_BAR; }
    PG8_BAR;
    if constexpr (Epi::AFTER_DRAIN) { E.fused(acc, cur, wr, wc, fr, fq, lds, wid, lane); S.done(cur); }
#undef PG8_SA
#undef PG8_SB
#undef PG8_STAGE
#undef PG8_STAGEA
#undef PG8_LDA
#undef PG8_LDB
#undef PG8_MMA
#undef PG8_WAIT_V
#undef PG8_WAIT_L
#undef PG8_BAR
#undef PG8_SCHED
}
}
#ifndef TILED_A
#define TILED_A true
#endif
#ifndef TILED_HID
#define TILED_HID 1
#endif
#ifndef P8_AUXA
#define P8_AUXA 0
#endif
#ifndef P7_WGM
#define P7_WGM 8
#endif
#ifndef I8_SP2
#define I8_SP2 PG8_SP2
#endif
#ifndef I8_ALIGN
#define I8_ALIGN PG8_ALIGN
#endif
#ifndef P345_WGM
#define P345_WGM 8
#endif
#ifndef P8_WGM
#define P8_WGM 4
#endif
#ifndef PG8_SP2
#define PG8_SP2 true
#endif
#ifndef PG8_ALIGN
#define PG8_ALIGN true
#endif

constexpr int NWAVES = 8;
constexpr int N_LAUNCHES = MK_N_LAUNCHES;
constexpr int N_PHASES = 10;
constexpr int BATCH = 2, SEQ = 8192, D = 4096, M = BATCH * SEQ;
constexpr int AW = 2048, ACH = 128, AH = 16, AHD = 128;
constexpr int BW = 1024, SG = 64, SGD = 16, SP = 64;
constexpr int DFF = 16384, INW = 2 * AW + BW + 2 * D;
constexpr int TC = 32, NCHB = SEQ / TC, NCH = M / TC;
constexpr float NORM_EPS = 1e-6f;

constexpr size_t MiB = 1u << 20;
constexpr size_t WS_CTL = 0, CTL_ZERO_BYTES = 1 * MiB;
constexpr size_t WS_WIN = 1 * MiB, WS_WPROJ = 105 * MiB, WS_WGLU = 121 * MiB, WS_WOUT = 137 * MiB, WS_WUP = 169 * MiB, WS_WDN = 297 * MiB;
constexpr size_t WS_KTAB = 425 * MiB, WS_BMAT = 426 * MiB, WS_CMAT = 434 * MiB, WS_AT = 442 * MiB;
constexpr size_t WS_PART = 443 * MiB;
constexpr size_t WS_ARB = 448 * MiB;
constexpr size_t WS_ARA = 576 * MiB;
constexpr size_t WS_UA = WS_ARA, WS_VA = WS_ARA + 64 * MiB, WS_XB2 = WS_ARA + 128 * MiB, WS_ZB = WS_ARA + 160 * MiB, WS_GA = WS_ARA + 192 * MiB, WS_GB = WS_ARA + 320 * MiB;
#ifndef IN_INT8
#define IN_INT8 2
#endif
constexpr int NG8 = IN_INT8 == 2 ? INW : IN_INT8 == 1 ? 1024 + 2048 + 8192 : 2048 + 8192, N16 = INW - NG8;
__host__ __device__ constexpr int win_row16(int n) { return n < 2048 ? n : n - 2048; }
__host__ __device__ constexpr int win_row8(int n) { return n < 4096 ? n - 2048 : n - 3072; }
__host__ __device__ constexpr int win_col8(int r) { return IN_INT8 == 2 ? r : IN_INT8 == 1 ? r + 2048 : (r < 2048 ? r + 2048 : r + 3072); }
__host__ __device__ constexpr int win_col16(int r) { return r < 2048 ? r : r + 2048; }
constexpr size_t WS_H8 = WS_ARA + 448 * MiB;
constexpr size_t WS_W8 = WS_WIN + (size_t)N16 * D * 2;
constexpr size_t WS_H2Q = WS_WIN;
static_assert(WS_W8 + (size_t)NG8 * D <= WS_WPROJ && WS_H2Q + (size_t)M * D <= WS_WOUT, "int8 copies");
constexpr size_t WS_RS1 = WS_AT + 64 * 1024, WS_RS2 = WS_AT + 128 * 1024, WS_CSIN = WS_AT + 192 * 1024, WS_CSUP = WS_AT + 256 * 1024;
static_assert(WS_CSIN + (size_t)NG8 * 4 <= WS_CSUP && WS_CSUP + (size_t)DFF * 4 <= WS_PART, "scale arrays");
constexpr int CW_CMAXIN = 16384, CW_CMAXUP = 32768;
static_assert((CW_CMAXUP + DFF) * 4 <= (int)(1u << 20) && CW_CMAXIN + NG8 <= CW_CMAXUP, "CTL words inside the memset region");
constexpr size_t WS_END = 1088 * MiB;
static_assert(WS_WIN + (size_t)INW * D * 2 <= WS_WPROJ && WS_WPROJ + (size_t)D * AW * 2 <= WS_WGLU && WS_WGLU + (size_t)2 * D * BW * 2 <= WS_WOUT && WS_WOUT + (size_t)D * D * 2 <= WS_WUP &&
              WS_WUP + (size_t)DFF * D * 2 <= WS_WDN && WS_WDN + (size_t)D * DFF * 2 <= WS_KTAB, "weight map");
static_assert(WS_KTAB + (size_t)SG * TC * 256 * 2 <= WS_BMAT && WS_BMAT + (size_t)SG * 128 * 512 * 2 <= WS_CMAT && WS_CMAT + (size_t)SG * 512 * 128 * 2 <= WS_AT && WS_AT + (size_t)SG * SP * 8 <= WS_PART &&
              WS_PART + (size_t)M * 64 * 4 <= WS_ARB && WS_ARB + (size_t)M * D * 2 <= WS_ARA && WS_GB + (size_t)M * D * 2 <= WS_END && WS_ARA + (size_t)M * DFF * 2 <= WS_END, "activation map");
constexpr int CW_TMO = 0, CW_CODE = 1, CW_BAR = 4096;

constexpr int RING_OFF = 0, RING_BYTES = 131072;
constexpr int LDSCTL_OFF = RING_BYTES, MISC_OFF = LDSCTL_OFF + 320;
constexpr int LDS_BYTES = 147456;
static_assert(MISC_OFF + 128 <= LDS_BYTES, "LDS map");

#define GAS __attribute__((address_space(1)))
#define LAS __attribute__((address_space(3)))
typedef unsigned short bf16;
typedef unsigned v4u __attribute__((ext_vector_type(4)));
typedef unsigned v2u __attribute__((ext_vector_type(2)));
typedef float f32x4 __attribute__((ext_vector_type(4)));
typedef float f32x2 __attribute__((ext_vector_type(2)));
typedef short bf16x8 __attribute__((ext_vector_type(8)));
typedef GAS unsigned gu32;
#define RLX_AGENT __ATOMIC_RELAXED, __HIP_MEMORY_SCOPE_AGENT
#ifndef NT_STREAM
#define NT_STREAM 1
#endif
#if NT_STREAM
#define LD_STREAM(p) __builtin_nontemporal_load(p)
#define ST_STREAM(p, v) __builtin_nontemporal_store((v), (p))
#else
#define LD_STREAM(p) (*(p))
#define ST_STREAM(p, v) (*(p) = (v))
#endif
#define LDS_WAIT() asm volatile("s_waitcnt lgkmcnt(0)" ::: "memory")
#define VM_WAIT() asm volatile("s_waitcnt vmcnt(0)" ::: "memory")
__device__ __forceinline__ unsigned pk2(float lo, float hi) { return pg8::cvt_pk_op(lo, hi); }
__device__ __forceinline__ unsigned pk2x(float lo, float hi) { return pg8::cvt_pk_bf16(lo, hi); }
__device__ __forceinline__ float bflo(unsigned w) { return __uint_as_float(w << 16); }
__device__ __forceinline__ float bfhi(unsigned w) { return __uint_as_float(w & 0xffff0000u); }
__device__ __forceinline__ float gelu_t(float x) { return pg8::gelu_tanh_f(x); }

#define XB_TMO      128
#define XB_XCNT(j)  (256  + 64 * (j))
#define XB_XSUB(j)  (1280 + 64 * (j))
#define XB_XGEN(j)  (2304 + 64 * (j))
#define XB_TOP      3328
#define XB_TOPGEN   3392
#define XCD_BAR_WORDS 3456
#define XB_SPIN_CAP (1u << 18)

__device__ __forceinline__ unsigned xb_ld(unsigned* p)              { return __hip_atomic_load(p, __ATOMIC_RELAXED, __HIP_MEMORY_SCOPE_AGENT); }
__device__ __forceinline__ unsigned xb_add(unsigned* p, unsigned v) { return __hip_atomic_fetch_add(p, v, __ATOMIC_RELAXED, __HIP_MEMORY_SCOPE_AGENT); }
__device__ __forceinline__ unsigned xb_xcc_id() { return (unsigned)__builtin_amdgcn_s_getreg((3 << 11) | 20) & 0xFu; }
#define XB_SPIN(cond, bar) do { unsigned _sp = 0; while (cond) { __builtin_amdgcn_s_sleep(1); \
    if ((++_sp & 255u) == 0u) { if (xb_ld(&(bar)[XB_TMO])) break; if (_sp > XB_SPIN_CAP) { atomicAdd(&(bar)[XB_TMO], 1u); break; } } } } while (0)

struct XcdBarrier { unsigned* bar; unsigned x; volatile LAS unsigned* st; };

__device__ __forceinline__ XcdBarrier xcd_barrier_post(unsigned* bar, volatile LAS unsigned* st) {
    XcdBarrier b; b.bar = bar; b.x = xb_xcc_id(); b.st = st;
    if (threadIdx.x == 0) (void)xb_add(&bar[XB_XCNT(b.x)], 1u);
    return b;
}
__device__ __forceinline__ void xcd_barrier_complete(unsigned* bar, unsigned x, unsigned& nloc, unsigned& nx) {
    const unsigned G = gridDim.x * gridDim.y * gridDim.z;
    unsigned sum, cnt, mine, sp = 0u;
    for (;;) {
        sum = 0u; cnt = 0u; mine = 0u;
#pragma unroll
        for (unsigned j = 0; j < 16; ++j) { const unsigned c = xb_ld(&bar[XB_XCNT(j)]); sum += c; cnt += (c > 0u) ? 1u : 0u; mine = (j == x) ? c : mine; }
        if (sum == G) break;
        __builtin_amdgcn_s_sleep(1);
        if ((++sp & 255u) == 0u) { if (xb_ld(&bar[XB_TMO])) break; if (sp > XB_SPIN_CAP) { atomicAdd(&bar[XB_TMO], 1u); break; } }
    }
    nloc = mine > 0u ? mine : 1u; nx = cnt > 0u ? cnt : 1u;
}
__device__ __forceinline__ void xcd_barrier(const XcdBarrier& b) {
    asm volatile("s_waitcnt vmcnt(0)" ::: "memory");
    __syncthreads();
    if (threadIdx.x == 0) {
        unsigned* bar = b.bar;
        __builtin_amdgcn_s_waitcnt(0);
        unsigned nloc = b.st[0], nx = b.st[1];
        if (nloc == 0u) { xcd_barrier_complete(bar, b.x, nloc, nx); b.st[0] = nloc; b.st[1] = nx; }
        const unsigned old = xb_add(&bar[XB_XSUB(b.x)], 1u);
        const unsigned gen = old / nloc;
        if (old + 1u == (gen + 1u) * nloc) {
            __builtin_amdgcn_fence(__ATOMIC_RELEASE, "agent");
            asm volatile("s_waitcnt vmcnt(0)" ::: "memory");
            const unsigned og = xb_add(&bar[XB_TOP], 1u);
            const unsigned tg = og / nx;
            if (og + 1u == (tg + 1u) * nx) xb_add(&bar[XB_TOPGEN], 1u);
            else XB_SPIN(xb_ld(&bar[XB_TOPGEN]) == tg, bar);
            __builtin_amdgcn_fence(__ATOMIC_ACQUIRE, "agent");
            xb_add(&bar[XB_XGEN(b.x)], 1u);
            asm volatile("s_waitcnt vmcnt(0)" ::: "memory");
        } else {
            XB_SPIN(xb_ld(&bar[XB_XGEN(b.x)]) == gen, bar);
            __builtin_amdgcn_fence(__ATOMIC_ACQUIRE, "agent");
            asm volatile("s_waitcnt vmcnt(0)" ::: "memory");
        }
    }
    __syncthreads();
}

struct Args { const float* in[24]; float* out; unsigned char* ws; int ph_lo, ph_hi; };
struct Frame {
    LAS unsigned char* lds;
    volatile LAS unsigned* MISC;
    gu32* ctl;
    int tid, lane, wave;
    int vcu, G;
    float* out; unsigned char* ws;
};
enum { I_X = 0, I_NMIXPRE, I_WIN, I_VNG, I_VNB, I_WSP, I_BSP, I_WPROJ, I_LRE, I_LIM, I_LOGDT, I_BRE, I_BIM, I_CRE, I_CIM, I_DSKIP, I_WGLUA, I_WGLUB, I_WOUT, I_NMIXPOST, I_NMLPPRE, I_WUP, I_WDN, I_NMLPPOST };

__device__ __forceinline__ float wave_sum(float v) {
#pragma unroll
    for (int o = 1; o < 64; o <<= 1) v += __shfl_xor(v, o);
    return v;
}

__device__ __forceinline__ void p0_transpose_item(const float* W, int K, int N, bf16* WT, int out_row0, LAS unsigned char* scr, int k0, int n0, int lane) {
    const int c = lane & 15, kq = lane >> 4;
    const float* src = W + (size_t)(k0 + 4 * kq) * N + n0 + 4 * c;
    f32x4 v[16];
#pragma unroll
    for (int i = 0; i < 16; ++i) v[i] = LD_STREAM((const GAS f32x4*)(src + (size_t)((i & 3) + 16 * (i >> 2)) * N));
#pragma unroll
    for (int mb = 0; mb < 4; ++mb)
#pragma unroll
        for (int j = 0; j < 4; ++j) { v2u o; o.x = pk2(v[4 * mb + 0][j], v[4 * mb + 1][j]); o.y = pk2(v[4 * mb + 2][j], v[4 * mb + 3][j]);
            *(LAS v2u*)(scr + (4 * c + j) * 136 + (16 * mb + 4 * kq) * 2) = o; }
    LDS_WAIT(); asm volatile("" ::: "memory");
#pragma unroll
    for (int r = 0; r < 8; ++r) { const int n = (lane >> 3) + 8 * r; const LAS unsigned char* p = scr + n * 136 + (lane & 7) * 16;
        const v2u x = *(const LAS v2u*)p, y = *(const LAS v2u*)(p + 8); v4u o; o.x = x.x; o.y = x.y; o.z = y.x; o.w = y.y;
        const int orow = out_row0 + n;
        *(GAS v4u*)(WT + ((((size_t)(orow >> 8) * (size_t)(K >> 6) + (size_t)(k0 >> 6)) * 256 + (size_t)(orow & 255)) * 64 + 8 * (lane & 7))) = o; }
    LDS_WAIT(); asm volatile("" ::: "memory");
}
__device__ __forceinline__ size_t tile16_off(int row, int col, int ncols) { return TILED_A ? ((((size_t)(row >> 8) * (size_t)(ncols >> 6) + (size_t)(col >> 6)) * 256 + (size_t)(row & 255)) * 64 + (size_t)(col & 63)) : ((size_t)row * ncols + col); }
__device__ __forceinline__ size_t tile8_off(int row, int kb, int nbytes) { return TILED_A ? ((((size_t)(row >> 8) * (size_t)(nbytes >> 7) + (size_t)(kb >> 7)) * 256 + (size_t)(row & 255)) * 128 + (size_t)(kb & 127)) : ((size_t)row * nbytes + kb); }
#ifndef TILED_MIX
#define TILED_MIX 0
#endif
__device__ __forceinline__ size_t mix_off(int row, int col) { return TILED_MIX ? ((((size_t)(row >> 8) * 64 + (size_t)(col >> 6)) * 256 + (size_t)(row & 255)) * 64 + (size_t)(col & 63)) : ((size_t)row * D + col); }
__device__ __forceinline__ float wave_max(float v) {
#pragma unroll
    for (int o = 1; o < 64; o <<= 1) v = fmaxf(v, __shfl_xor(v, o));
    return v;
}
__device__ __forceinline__ unsigned pk4_i8(float a, float b, float c, float d) {
    const int qa = (int)__builtin_rintf(fminf(fmaxf(a, -127.f), 127.f)), qb = (int)__builtin_rintf(fminf(fmaxf(b, -127.f), 127.f)), qc = (int)__builtin_rintf(fminf(fmaxf(c, -127.f), 127.f)), qd = (int)__builtin_rintf(fminf(fmaxf(d, -127.f), 127.f));
    return ((unsigned)qa & 0xffu) | (((unsigned)qb & 0xffu) << 8) | (((unsigned)qc & 0xffu) << 16) | ((unsigned)qd << 24);
}
__device__ __forceinline__ void rms_row_to_bf16(const float* xrow, const float* g, bf16* orow, unsigned char* o8base, int m, float* rs, int lane) {
    const GAS f32x4* xr = (const GAS f32x4*)xrow + lane; const GAS f32x4* gr = (const GAS f32x4*)g + lane;
    f32x4 v[16]; float s = 0.f;
#pragma unroll
    for (int j = 0; j < 16; ++j) { v[j] = LD_STREAM(xr + 64 * j); s += (v[j].x * v[j].x + v[j].y * v[j].y) + (v[j].z * v[j].z + v[j].w * v[j].w); }
    const float rstd = 1.0f / sqrtf(wave_sum(s) * (1.f / D) + NORM_EPS);
    GAS v2u* o8 = (GAS v2u*)orow + lane; float am = 0.f;
#pragma unroll
    for (int j = 0; j < 16; ++j) { const f32x4 gg = gr[64 * j]; v[j].x *= rstd * gg.x; v[j].y *= rstd * gg.y; v[j].z *= rstd * gg.z; v[j].w *= rstd * gg.w;
        am = fmaxf(fmaxf(am, fmaxf(fabsf(v[j].x), fabsf(v[j].y))), fmaxf(fabsf(v[j].z), fabsf(v[j].w)));
        if (N16 > 0) { v2u o; o.x = pk2(v[j].x, v[j].y); o.y = pk2(v[j].z, v[j].w); o8[64 * j] = o; } }
    am = fmaxf(wave_max(am), 1e-30f); const float qs = 127.0f / am;
    if (lane == 0) rs[0] = am * (1.0f / 127.0f);
    GAS unsigned char* q8 = (GAS unsigned char*)(o8base + tile8_off(m, 4 * lane, D)); const size_t qstep = tile8_off(0, 256, D);
#pragma unroll
    for (int j = 0; j < 16; ++j) { *(GAS unsigned*)q8 = pk4_i8(v[j].x * qs, v[j].y * qs, v[j].z * qs, v[j].w * qs); q8 += qstep; }
}
__device__ __forceinline__ void p0_colmax_item(const float* W, int N, unsigned* cmax, int k0, int n0, int ncol0, int lane) {
    const int c = lane & 15, kq = lane >> 4;
    f32x4 mx = (f32x4){0.f, 0.f, 0.f, 0.f};
    for (int sb = 0; sb < 8; ++sb) { const float* src = W + (size_t)(k0 + 64 * sb + 4 * kq) * N + n0 + 4 * c;
#pragma unroll
        for (int i = 0; i < 16; ++i) { const f32x4 t = *(const GAS f32x4*)(src + (size_t)((i & 3) + 16 * (i >> 2)) * N);
            mx.x = fmaxf(mx.x, fabsf(t.x)); mx.y = fmaxf(mx.y, fabsf(t.y)); mx.z = fmaxf(mx.z, fabsf(t.z)); mx.w = fmaxf(mx.w, fabsf(t.w)); } }
#pragma unroll
    for (int j = 0; j < 4; ++j) { float t = mx[j]; t = fmaxf(t, __shfl_xor(t, 16)); t = fmaxf(t, __shfl_xor(t, 32)); mx[j] = t; }
    if (kq == 0) {
#pragma unroll
        for (int j = 0; j < 4; ++j) atomicMax(cmax + (n0 - ncol0) + 4 * c + j, __float_as_uint(mx[j])); }
}
__device__ __forceinline__ void p0_quant_item(const float* W, int K, int N, unsigned char* Wq, int out_row0, LAS unsigned char* scr, int k0, int n0, const unsigned* cmax, float* cs, int lane) {
    const int c = lane & 15, kq = lane >> 4;
    const float* src = W + (size_t)(k0 + 4 * kq) * N + n0 + 4 * c;
    f32x4 v[16];
#pragma unroll
    for (int i = 0; i < 16; ++i) v[i] = *(const GAS f32x4*)(src + (size_t)((i & 3) + 16 * (i >> 2)) * N);
    float qs[4];
#pragma unroll
    for (int j = 0; j < 4; ++j) { const float am = fmaxf(__uint_as_float(cmax[out_row0 + 4 * c + j]), 1e-30f); qs[j] = 127.0f / am; if (k0 == 0 && kq == 0) cs[out_row0 + 4 * c + j] = am * (1.0f / 127.0f); }
#pragma unroll
    for (int mb = 0; mb < 4; ++mb)
#pragma unroll
        for (int j = 0; j < 4; ++j) *(LAS unsigned*)(scr + (4 * c + j) * 68 + 16 * mb + 4 * kq) = pk4_i8(qs[j] * v[4 * mb + 0][j], qs[j] * v[4 * mb + 1][j], qs[j] * v[4 * mb + 2][j], qs[j] * v[4 * mb + 3][j]);
    LDS_WAIT(); asm volatile("" ::: "memory");
#pragma unroll
    for (int r = 0; r < 4; ++r) { const int n = (lane >> 2) + 16 * r; const LAS unsigned* p = (const LAS unsigned*)(scr + n * 68 + 16 * (lane & 3));
        v4u o; o.x = p[0]; o.y = p[1]; o.z = p[2]; o.w = p[3];
        const int orow = out_row0 + n;
        *(GAS v4u*)(Wq + ((((size_t)(orow >> 8) * (size_t)(K >> 7) + (size_t)(k0 >> 7)) * 256 + (size_t)(orow & 255)) * 128 + (size_t)(k0 & 127) + 16 * (lane & 3))) = o; }
    LDS_WAIT(); asm volatile("" ::: "memory");
}
#ifndef REGQ
#define REGQ (IN_INT8 == 2)
#endif
template <int ROWS>
__device__ __forceinline__ void q_load(Frame& F, const float* W, int N, int n0, int k0, unsigned* cmax, unsigned (&d)[ROWS / 4]) {
    constexpr int RW = ROWS / 8, NB = RW < 16 ? RW : 16;
    int lane = F.lane; asm volatile("" : "+v"(lane));
    const GAS unsigned char* src = (const GAS unsigned char*)(W + (size_t)(k0 + F.wave * RW) * N + n0);
    const unsigned lo = 16u * (unsigned)lane, rstep = 4u * (unsigned)N;
    f32x4 mx = (f32x4){0.f, 0.f, 0.f, 0.f};
#pragma unroll
    for (int ib = 0; ib < RW; ib += NB) {
        f32x4 v[NB];
#pragma unroll
        for (int i = 0; i < NB; ++i) v[i] = LD_STREAM((const GAS f32x4*)(src + (size_t)(ib + i) * rstep + lo));
#pragma unroll
        for (int i = 0; i < NB; ++i) {
            mx.x = fmaxf(mx.x, fabsf(v[i].x)); mx.y = fmaxf(mx.y, fabsf(v[i].y)); mx.z = fmaxf(mx.z, fabsf(v[i].z)); mx.w = fmaxf(mx.w, fabsf(v[i].w));
            d[2 * (ib + i)] = pk2x(v[i].x, v[i].y); d[2 * (ib + i) + 1] = pk2x(v[i].z, v[i].w); }
    }
    LAS float* red = (LAS float*)(F.lds + RING_OFF);
    *(LAS f32x4*)(red + F.wave * 256 + 4 * lane) = mx;
    __syncthreads();
    if (F.tid < 256) { float m = red[F.tid];
#pragma unroll
        for (int w = 1; w < NWAVES; ++w) m = fmaxf(m, red[w * 256 + F.tid]);
        atomicMax(cmax + F.tid, __float_as_uint(m)); }
}
template <int ROWS>
__device__ __forceinline__ void q_store(Frame& F, unsigned char* Wq, int panel, int k0, const unsigned* cmax, float* cs, const unsigned (&d)[ROWS / 4]) {
    constexpr int RW = ROWS / 8;
    int lane = F.lane; asm volatile("" : "+v"(lane));
    const v4u cm = *(const GAS v4u*)(cmax + 4 * lane);
    float qs[4]; f32x4 sc;
#pragma unroll
    for (int j = 0; j < 4; ++j) { const float am = fmaxf(__uint_as_float(cm[j]), 1e-30f); qs[j] = 127.0f / am; sc[j] = am * (1.0f / 127.0f); }
    if (k0 == 0 && F.wave == 0) *(GAS f32x4*)(cs + 4 * lane) = sc;
    const int k = k0 + F.wave * RW;
    GAS unsigned char* o = (GAS unsigned char*)Wq + (((size_t)panel * (D / 128) + (size_t)(k >> 7)) * 256 + (size_t)(4 * lane)) * 128 + (size_t)(k & 127);
#define QV(i, j) (qs[j] * (((j) & 1) ? bfhi(d[2 * (i) + ((j) >> 1)]) : bflo(d[2 * (i) + ((j) >> 1)])))
#pragma unroll
    for (int j = 0; j < 4; ++j) {
        if constexpr (RW >= 16) {
#pragma unroll
            for (int g = 0; g < RW / 16; ++g) { v4u o4;
#pragma unroll
                for (int q = 0; q < 4; ++q) o4[q] = pk4_i8(QV(16 * g + 4 * q, j), QV(16 * g + 4 * q + 1, j), QV(16 * g + 4 * q + 2, j), QV(16 * g + 4 * q + 3, j));
                *(GAS v4u*)(o + j * 128 + 16 * g) = o4; }
        } else { v2u o2; o2.x = pk4_i8(QV(0, j), QV(1, j), QV(2, j), QV(3, j)); o2.y = pk4_i8(QV(4, j), QV(5, j), QV(6, j), QV(7, j)); *(GAS v2u*)(o + j * 128) = o2; }
    }
#undef QV
}
template <int ROWS>
__device__ __forceinline__ void q_rounds(Frame& F, const Args& A, const XcdBarrier& bar, int gp0, int ngp) {
    constexpr int KB = D / ROWS, PIN = INW / 256;
    const int NT = ngp * KB;
    for (int t0 = 0; t0 < NT; t0 += F.G) {
        const int t = t0 + F.vcu; const bool act = t < NT;
        const int gp = gp0 + t / KB, k0 = (t % KB) * ROWS; const bool isin = gp < PIN; const int panel = isin ? gp : gp - PIN;
        unsigned* cmax = (unsigned*)(F.ctl + (isin ? CW_CMAXIN : CW_CMAXUP)) + 256 * panel;
        unsigned d[ROWS / 4];
        if (act) q_load<ROWS>(F, isin ? A.in[I_WIN] : A.in[I_WUP], isin ? INW : DFF, 256 * panel, k0, cmax, d);
        if (N_LAUNCHES == 1) xcd_barrier(bar);
        if (act) q_store<ROWS>(F, isin ? F.ws + WS_W8 : F.ws + WS_WUP, panel, k0, cmax, (float*)(F.ws + (isin ? WS_CSIN : WS_CSUP)) + 256 * panel, d);
    }
}
__device__ __forceinline__ void p0_quant_rounds(Frame& F, const Args& A, const XcdBarrier& bar) {
    static_assert((INW + DFF) / 256 == 116 && (!REGQ || N_LAUNCHES == 1), "panel split below; the tiles cross a grid barrier");
    __syncthreads();
    q_rounds<512>(F, A, bar, 0, 96);
    q_rounds<256>(F, A, bar, 96, 16);
    q_rounds<64>(F, A, bar, 112, 4);
}
__device__ __forceinline__ void s5_pow(double lre, double lim, double dt, int n, double& re, double& im) {
    const double mag = exp((double)n * dt * lre), ang = (double)n * dt * lim; double sn, cs; sincos(ang, &sn, &cs); re = mag * cs; im = mag * sn;
}
__device__ __forceinline__ void s5_coef(double lre, double lim, double dt, double& re, double& im) {
    double are, aim; s5_pow(lre, lim, dt, 1, are, aim); const double nr = are - 1.0, ni = aim, den = lre * lre + lim * lim;
    re = (nr * lre + ni * lim) / den; im = (ni * lre - nr * lim) / den;
}
__device__ __forceinline__ void p0_s5_item(Frame& F, const Args& A, int item) {
    const int lane = F.lane, p = lane;
    bf16* KTAB = (bf16*)(F.ws + WS_KTAB); bf16* BMAT = (bf16*)(F.ws + WS_BMAT); bf16* CMAT = (bf16*)(F.ws + WS_CMAT); float* AT = (float*)(F.ws + WS_AT);
    const int kind = item >> 11, r = item & 2047, g = (kind < 3) ? (r >> 5) : r, n = r & 31;
    const double lre = (double)A.in[I_LRE][g * SP + p], lim = (double)A.in[I_LIM][g * SP + p], dt = exp((double)A.in[I_LOGDT][g]);
    if (kind == 3) { double re, im; s5_pow(lre, lim, dt, TC, re, im); AT[(g * SP + p) * 2] = (float)re; AT[(g * SP + p) * 2 + 1] = (float)im; return; }
    if (kind == 2) {
        double wr, wi; s5_pow(lre, lim, dt, n + 1, wr, wi); const float wrf = (float)wr, wif = (float)wi;
#pragma unroll
        for (int h = 0; h < SGD; ++h) { const float cr = A.in[I_CRE][(g * SGD + h) * SP + p], ci = A.in[I_CIM][(g * SGD + h) * SP + p];
            bf16* row = CMAT + ((size_t)g * 512 + n * 16 + h) * 128;
            row[p] = (bf16)(pk2x(cr * wrf - ci * wif, 0.f) & 0xffffu); row[64 + p] = (bf16)(pk2x(-(cr * wif + ci * wrf), 0.f) & 0xffffu); }
        return;
    }
    double cre, cim; s5_coef(lre, lim, dt, cre, cim);
    if (kind == 1) {
        double ar, ai; s5_pow(lre, lim, dt, TC - 1 - n, ar, ai); const float wr = (float)(ar * cre - ai * cim), wi = (float)(ar * cim + ai * cre);
        float vr[16], vi[16];
#pragma unroll
        for (int h = 0; h < SGD; ++h) { const float br = A.in[I_BRE][(g * SP + p) * SGD + h], bi = A.in[I_BIM][(g * SP + p) * SGD + h]; vr[h] = wr * br - wi * bi; vi[h] = wr * bi + wi * br; }
        v4u o; bf16* rr = BMAT + ((size_t)g * 128 + p) * 512 + n * 16; bf16* ri = BMAT + ((size_t)g * 128 + 64 + p) * 512 + n * 16;
        o.x = pk2x(vr[0], vr[1]); o.y = pk2x(vr[2], vr[3]); o.z = pk2x(vr[4], vr[5]); o.w = pk2x(vr[6], vr[7]); *(v4u*)rr = o;
        o.x = pk2x(vr[8], vr[9]); o.y = pk2x(vr[10], vr[11]); o.z = pk2x(vr[12], vr[13]); o.w = pk2x(vr[14], vr[15]); *(v4u*)(rr + 8) = o;
        o.x = pk2x(vi[0], vi[1]); o.y = pk2x(vi[2], vi[3]); o.z = pk2x(vi[4], vi[5]); o.w = pk2x(vi[6], vi[7]); *(v4u*)ri = o;
        o.x = pk2x(vi[8], vi[9]); o.y = pk2x(vi[10], vi[11]); o.z = pk2x(vi[12], vi[13]); o.w = pk2x(vi[14], vi[15]); *(v4u*)(ri + 8) = o;
        return;
    }
    double ar, ai; s5_pow(lre, lim, dt, n, ar, ai); const float wr = (float)(ar * cre - ai * cim), wi = (float)(ar * cim + ai * cre);
    float vr[16], vi[16];
#pragma unroll
    for (int h = 0; h < SGD; ++h) { const float br = A.in[I_BRE][(g * SP + p) * SGD + h], bi = A.in[I_BIM][(g * SP + p) * SGD + h]; vr[h] = wr * br - wi * bi; vi[h] = wr * bi + wi * br; }
    float crs[16], cis[16];
#pragma unroll
    for (int h = 0; h < SGD; ++h) { crs[h] = A.in[I_CRE][(g * SGD + h) * SP + p]; cis[h] = A.in[I_CIM][(g * SGD + h) * SP + p]; }
    __builtin_amdgcn_sched_barrier(0);
#pragma unroll
    for (int h = 0; h < SGD; ++h) { const float cr = crs[h], ci = cis[h];
        float t8[8], t4[4], t2[2], mine;
#pragma unroll
        for (int i = 0; i < 8; ++i) { const float a = cr * vr[2 * i] - ci * vi[2 * i], b = cr * vr[2 * i + 1] - ci * vi[2 * i + 1]; const bool up = lane & 1; t8[i] = (up ? b : a) + __shfl_xor(up ? a : b, 1); }
#pragma unroll
        for (int i = 0; i < 4; ++i) { const bool up = lane & 2; t4[i] = (up ? t8[2 * i + 1] : t8[2 * i]) + __shfl_xor(up ? t8[2 * i] : t8[2 * i + 1], 2); }
#pragma unroll
        for (int i = 0; i < 2; ++i) { const bool up = lane & 4; t2[i] = (up ? t4[2 * i + 1] : t4[2 * i]) + __shfl_xor(up ? t4[2 * i] : t4[2 * i + 1], 4); }
        { const bool up = lane & 8; mine = (up ? t2[1] : t2[0]) + __shfl_xor(up ? t2[0] : t2[1], 8); }
        mine += __shfl_xor(mine, 16); mine += __shfl_xor(mine, 32);
        if (lane < SGD) { if (n == 0 && lane == h) mine += A.in[I_DSKIP][g * SGD + h]; KTAB[(((size_t)g * TC + n) * SGD + h) * SGD + lane] = (bf16)(pk2x(mine, 0.f) & 0xffffu); } }
}
__device__ __forceinline__ void p0_prologue(Frame& F, const Args& A) {
    LAS unsigned char* scr = F.lds + RING_OFF + F.wave * 16384;
#ifndef P0_S5WAVE
#define P0_S5WAVE 0
#endif
    constexpr int NSW = P0_S5WAVE ? NWAVES - 1 : NWAVES;
    if (P0_S5WAVE && F.wave == NWAVES - 1) { for (int it = F.vcu; it < 3 * 2048 + SG; it += F.G) p0_s5_item(F, A, it); return; }
    const int gw = F.vcu * NSW + F.wave, NGW = F.G * NSW;
    if (!P0_S5WAVE) for (int it = gw; it < 3 * 2048 + SG; it += NGW) p0_s5_item(F, A, it);
    { bf16* Hh = (bf16*)(F.ws + WS_ARB); float* RS1 = (float*)(F.ws + WS_RS1);
      for (int m = gw; m < M; m += NGW) rms_row_to_bf16(A.in[I_X] + (size_t)m * D, A.in[I_NMIXPRE], Hh + (size_t)m * D, F.ws + WS_H8, m, RS1 + m, F.lane); }
    constexpr int I_1 = (D / 64) * (N16 / 64), I_2 = (AW / 64) * (D / 64), I_3 = (BW / 64) * (D / 64), I_4 = I_3, I_5 = (D / 64) * (D / 64), I_7 = (DFF / 64) * (D / 64);
    constexpr int NITEMS = I_1 + I_2 + I_3 + I_4 + I_5 + I_7;
    for (int it = gw; it < NITEMS; it += NGW) {
        int r = it;
        if (r < I_1) { const int nblk = N16 > 0 ? N16 / 64 : 1, kb = r / nblk, nb = r % nblk; p0_transpose_item(A.in[I_WIN], D, INW, (bf16*)(F.ws + WS_WIN), 64 * nb, scr, 64 * kb, win_col16(64 * nb), F.lane); continue; } r -= I_1;
        if (r < I_2) { const int nblk = D / 64, kb = r / nblk, nb = r % nblk; p0_transpose_item(A.in[I_WPROJ], AW, D, (bf16*)(F.ws + WS_WPROJ), 64 * nb, scr, 64 * kb, 64 * nb, F.lane); continue; } r -= I_2;
        if (r < I_3) { const int nblk = D / 64, kb = r / nblk, nb = r % nblk, n0 = 64 * nb; p0_transpose_item(A.in[I_WGLUA], BW, D, (bf16*)(F.ws + WS_WGLU), (n0 >> 7) * 256 + (n0 & 127), scr, 64 * kb, n0, F.lane); continue; } r -= I_3;
        if (r < I_4) { const int nblk = D / 64, kb = r / nblk, nb = r % nblk, n0 = 64 * nb; p0_transpose_item(A.in[I_WGLUB], BW, D, (bf16*)(F.ws + WS_WGLU), (n0 >> 7) * 256 + 128 + (n0 & 127), scr, 64 * kb, n0, F.lane); continue; } r -= I_4;
        if (r < I_5) { const int nblk = D / 64, kb = r / nblk, nb = r % nblk; p0_transpose_item(A.in[I_WOUT], D, D, (bf16*)(F.ws + WS_WOUT), 64 * nb, scr, 64 * kb, 64 * nb, F.lane); continue; } r -= I_5;
        { const int nblk = D / 64, kb = r / nblk, nb = r % nblk; p0_transpose_item(A.in[I_WDN], DFF, D, (bf16*)(F.ws + WS_WDN), 64 * nb, scr, 64 * kb, 64 * nb, F.lane); }
    }
    if (!REGQ) { unsigned* CMI = (unsigned*)(F.ctl + CW_CMAXIN); unsigned* CMU = (unsigned*)(F.ctl + CW_CMAXUP);
      constexpr int C_1 = (NG8 / 64) * (D / 512), C_2 = (DFF / 64) * (D / 512);
      for (int it = gw; it < C_1 + C_2; it += NGW) {
          if (it < C_1) { const int nb = it % (NG8 / 64), kb = it / (NG8 / 64), n0 = win_col8(64 * nb); p0_colmax_item(A.in[I_WIN], INW, CMI, 512 * kb, n0, n0 - 64 * nb, F.lane); }
          else { const int r = it - C_1, nb = r % (DFF / 64), kb = r / (DFF / 64); p0_colmax_item(A.in[I_WUP], DFF, CMU, 512 * kb, 64 * nb, 0, F.lane); } } }
}
__device__ __forceinline__ void p0_quantize(Frame& F, const Args& A) {
    LAS unsigned char* scr = F.lds + RING_OFF + F.wave * 16384;
    const int gw = F.vcu * NWAVES + F.wave, NGW = F.G * NWAVES;
    const unsigned* CMI = (const unsigned*)(F.ctl + CW_CMAXIN); const unsigned* CMU = (const unsigned*)(F.ctl + CW_CMAXUP);
    constexpr int Q_1 = (D / 128) * (NG8 / 64), Q_2 = (D / 128) * (DFF / 64);
    for (int it0 = gw; it0 < Q_1 + Q_2; it0 += NGW) { const int it = Q_1 + Q_2 - 1 - it0;
        if (it < Q_1) { const int nblk = NG8 / 64, kb2 = it / nblk, nb = it % nblk;
            p0_quant_item(A.in[I_WIN], D, INW, F.ws + WS_W8, 64 * nb, scr, 128 * kb2, win_col8(64 * nb), CMI, (float*)(F.ws + WS_CSIN), F.lane);
            p0_quant_item(A.in[I_WIN], D, INW, F.ws + WS_W8, 64 * nb, scr, 128 * kb2 + 64, win_col8(64 * nb), CMI, (float*)(F.ws + WS_CSIN), F.lane); }
        else { const int r = it - Q_1, nblk = DFF / 64, kb2 = r / nblk, nb = r % nblk;
            p0_quant_item(A.in[I_WUP], D, DFF, F.ws + WS_WUP, 64 * nb, scr, 128 * kb2, 64 * nb, CMU, (float*)(F.ws + WS_CSUP), F.lane);
            p0_quant_item(A.in[I_WUP], D, DFF, F.ws + WS_WUP, 64 * nb, scr, 128 * kb2 + 64, 64 * nb, CMU, (float*)(F.ws + WS_CSUP), F.lane); }
    }
}

constexpr int SPG_VNT_STRIDE = 136, SPG_BUF_BYTES = 128 * SPG_VNT_STRIDE * 2;
constexpr int DUMP_OFF = RING_BYTES - 2048;
__device__ __forceinline__ void l2_touch(Frame& F, const void* p) { __builtin_amdgcn_global_load_lds((const unsigned*)p, (LAS unsigned*)(F.lds + DUMP_OFF + F.wave * 256), 4, 0, 0); }
#ifndef SPG_H0
#define SPG_H0 9
#endif
__device__ __forceinline__ void spatial_unit(Frame& F, const Args& A, int unit) {
    const int c = unit >> 1, hh = unit & 1, lane = F.lane, w = F.wave, h0 = hh ? SPG_H0 : 0, nheads = hh ? AH - SPG_H0 : SPG_H0;
    const bf16* UA = (const bf16*)(F.ws + WS_UA); const bf16* VA = (const bf16*)(F.ws + WS_VA); bf16* SA = (bf16*)(F.ws + WS_ARB);
    const float* VST = (const float*)(F.ws + WS_PART);
    const size_t tok0 = (size_t)c * ACH;
    const int fr = lane & 15, fq = lane >> 4, trow = 16 * w + fr;
    const int sfill = 64 * (w & 1) + lane, c8b = 4 * (w >> 1);
    float mean, rstd;
    { const GAS f32x4* p = (const GAS f32x4*)(VST + (tok0 + sfill) * 64); float s1 = 0.f, s2 = 0.f;
#pragma unroll
      for (int j = 0; j < 16; ++j) { const f32x4 t = p[j]; s1 += t.x + t.z; s2 += t.y + t.w; }
      mean = s1 * (1.f / AW); const float var = fmaxf(s2 * (1.f / AW) - mean * mean, 0.f); rstd = 1.0f / sqrtf(var + NORM_EPS); }
    const bf16* vsrc = TILED_A ? VA + ((size_t)c * 16 * 128 + sfill) * 128 + 8 * c8b : VA + (tok0 + sfill) * AW + 8 * c8b; const size_t hstr = TILED_A ? (size_t)128 * 128 : (size_t)AHD;
    LAS float* gl = (LAS float*)(F.lds + 2 * SPG_BUF_BYTES); LAS float* bl = gl + 9 * AHD;
    if (F.tid < nheads * (AHD / 4)) { const f32x4 gv = ((const GAS f32x4*)(A.in[I_VNG] + h0 * AHD))[F.tid], bv = ((const GAS f32x4*)(A.in[I_VNB] + h0 * AHD))[F.tid]; ((LAS f32x4*)gl)[F.tid] = gv; ((LAS f32x4*)bl)[F.tid] = bv; }
    const int nks = (w + 2) >> 1;
    v4u vreg[4]; f32x4 wv[4][2]; v2u uu[8]; float bsp;
#define SPG_FETCH(hh_) do { const int hq = (hh_); \
        _Pragma("unroll") for (int i = 0; i < 4; ++i) vreg[i] = LD_STREAM((const GAS v4u*)(vsrc + hq * hstr + 8 * i)); \
        const float* Wrow = A.in[I_WSP] + ((size_t)hq * ACH + trow) * ACH + 8 * fq; \
        _Pragma("unroll") for (int ks = 0; ks < 4; ++ks) if (ks < nks) { wv[ks][0] = *(const GAS f32x4*)(Wrow + 32 * ks); wv[ks][1] = *(const GAS f32x4*)(Wrow + 32 * ks + 4); } \
        const bf16* urow = TILED_A ? UA + (((size_t)c * 16 + hq) * 128 + trow) * 128 + 4 * fq : UA + (tok0 + trow) * AW + hq * AHD + 4 * fq; \
        _Pragma("unroll") for (int n = 0; n < 8; ++n) uu[n] = LD_STREAM((const GAS v2u*)(urow + 16 * n)); \
        bsp = A.in[I_BSP][hq * ACH + trow]; } while (0)
    SPG_FETCH(h0);
    __syncthreads();
#pragma unroll 1
    for (int hi = 0; hi < nheads; ++hi) { const int h = h0 + hi;
        LAS bf16* vnT = (LAS bf16*)(F.lds + (hi & 1) * SPG_BUF_BYTES);
#pragma unroll
        for (int i = 0; i < 4; ++i) { const int c8 = c8b + i; const v4u x = vreg[i];
            const float e[8] = {bflo(x.x), bfhi(x.x), bflo(x.y), bfhi(x.y), bflo(x.z), bfhi(x.z), bflo(x.w), bfhi(x.w)};
            const f32x4 g0 = *(const LAS f32x4*)(gl + hi * AHD + 8 * c8), g1 = *(const LAS f32x4*)(gl + hi * AHD + 8 * c8 + 4), b0 = *(const LAS f32x4*)(bl + hi * AHD + 8 * c8), b1 = *(const LAS f32x4*)(bl + hi * AHD + 8 * c8 + 4);
            const float gg[8] = {g0.x, g0.y, g0.z, g0.w, g1.x, g1.y, g1.z, g1.w}, bb[8] = {b0.x, b0.y, b0.z, b0.w, b1.x, b1.y, b1.z, b1.w};
#pragma unroll
            for (int j = 0; j < 8; ++j) { const float y = (e[j] - mean) * rstd * gg[j] + bb[j]; vnT[(8 * c8 + j) * SPG_VNT_STRIDE + sfill] = (bf16)(pk2x(y, 0.f) & 0xffffu); } }
        v4u wb[4];
#pragma unroll
        for (int ks = 0; ks < 4; ++ks) if (ks < nks) { const int s0 = 32 * ks + 8 * fq;
            float wvv[8] = {wv[ks][0].x, wv[ks][0].y, wv[ks][0].z, wv[ks][0].w, wv[ks][1].x, wv[ks][1].y, wv[ks][1].z, wv[ks][1].w};
#pragma unroll
            for (int j = 0; j < 8; ++j) wvv[j] = (s0 + j <= trow) ? wvv[j] : 0.f;
            wb[ks].x = pk2x(wvv[0], wvv[1]); wb[ks].y = pk2x(wvv[2], wvv[3]); wb[ks].z = pk2x(wvv[4], wvv[5]); wb[ks].w = pk2x(wvv[6], wvv[7]); }
        v2u uc[8];
#pragma unroll
        for (int n = 0; n < 8; ++n) uc[n] = uu[n];
        const float bc = bsp; const int srow_t = (int)(tok0 + trow), scol = h * AHD + 4 * fq;
        __builtin_amdgcn_sched_barrier(0);
        if (hi + 1 < nheads) SPG_FETCH(h + 1);
        __syncthreads();
        f32x4 acc[8];
#pragma unroll
        for (int n = 0; n < 8; ++n) acc[n] = (f32x4){0.f, 0.f, 0.f, 0.f};
#pragma unroll
        for (int ks = 0; ks < 4; ++ks) if (ks < nks) { const int s0 = 32 * ks + 8 * fq; const bf16x8 bfrag = __builtin_bit_cast(bf16x8, wb[ks]);
#pragma unroll
            for (int n = 0; n < 8; ++n) { const bf16x8 afrag = *(const LAS bf16x8*)(vnT + (16 * n + fr) * SPG_VNT_STRIDE + s0);
                acc[n] = __builtin_amdgcn_mfma_f32_16x16x32_bf16(afrag, bfrag, acc[n], 0, 0, 0); } }
#pragma unroll
        for (int n = 0; n < 8; ++n) { const v2u u2 = uc[n]; v2u o;
            o.x = pk2x(bflo(u2.x) * (acc[n][0] + bc), bfhi(u2.x) * (acc[n][1] + bc)); o.y = pk2x(bflo(u2.y) * (acc[n][2] + bc), bfhi(u2.y) * (acc[n][3] + bc)); *(GAS v2u*)(SA + tile16_off(srow_t, scol + 16 * n, AW)) = o; }
    }
#undef SPG_FETCH
    __syncthreads();
}

constexpr int S5_KT_OFF = 0;
constexpr int S5_E_OFF = 17408;
constexpr int S5_S_OFF = S5_E_OFF + 128 * 65 * 4;
constexpr int S5_S_STRIDE = 136;
static_assert(S5_S_OFF + 128 * S5_S_STRIDE * 2 <= RING_BYTES - 2048, "S5 LDS");
#ifndef S5_PF
#define S5_PF 1
#endif
#ifndef S5_SB3
#define S5_SB3 0
#endif
__device__ __forceinline__ void s5_unit(Frame& F, int unit, int part = 3) {
    const int q = unit & 1, g = (unit >> 1) & 63, b = unit >> 7, tid = F.tid, lane = F.lane, w = F.wave, fr = lane & 15, fq = lane >> 4;
    const bf16* KTAB = (const bf16*)(F.ws + WS_KTAB) + (size_t)g * TC * 256; const bf16* BMAT = (const bf16*)(F.ws + WS_BMAT) + (size_t)g * 128 * 512;
    const bf16* CMAT = (const bf16*)(F.ws + WS_CMAT) + (size_t)g * 512 * 128; const float* AT = (const float*)(F.ws + WS_AT) + g * SP * 2;
    const bf16* XB = (const bf16*)(F.ws + WS_XB2) + ((size_t)g * NCH + (size_t)b * NCHB) * 512;
    bf16* ZB = (bf16*)(F.ws + WS_ZB);
    LAS unsigned char* kt = F.lds + S5_KT_OFF; LAS float* Eb = (LAS float*)(F.lds + S5_E_OFF); LAS bf16* Sb = (LAS bf16*)(F.lds + S5_S_OFF);
    if (S5_PF && (part & 1)) { l2_touch(F, (const unsigned char*)XB + (size_t)tid * 128); l2_touch(F, (const unsigned char*)XB + 65536 + (size_t)tid * 128); }
    if (tid < 32) *(LAS v4u*)(kt + tid * 16) = (v4u){0u, 0u, 0u, 0u};
#pragma unroll
    for (int i = 0; i < 2; ++i) { const int pc = tid + 512 * i; *(LAS v4u*)(kt + 512 + pc * 16) = *(const GAS v4u*)(KTAB + pc * 8); }
    if (part & 1) {
        float sre = 0.f, sim = 0.f; const float are = AT[2 * lane], aim = AT[2 * lane + 1];
        const int nblk = 2 * (q + 1), ntile = 4 * nblk;
        constexpr int XS_OFF = 86016, XS_STRIDE = 1040, XS_BUF = 16 * XS_STRIDE;
        static_assert(S5_S_OFF + 128 * S5_S_STRIDE * 2 <= XS_OFF && XS_OFF + 2 * XS_BUF <= DUMP_OFF, "S5 staging LDS");
        bf16x8 af[16];
#pragma unroll
        for (int kk = 0; kk < 16; ++kk) af[kk] = *(const GAS bf16x8*)(BMAT + (size_t)(16 * w + fr) * 512 + 32 * kk + 8 * fq);
#define S5_STAGE(t_, b_) do { const int tt_ = (t_); _Pragma("unroll") for (int rr = 0; rr < 2; ++rr) { const int r_ = 2 * w + rr; \
            __builtin_amdgcn_global_load_lds((const unsigned*)((const unsigned char*)XB + (size_t)(16 * tt_ + r_) * 1024 + lane * 16), (LAS unsigned*)(F.lds + XS_OFF + (b_) * XS_BUF + r_ * XS_STRIDE), 16, 0, 0); } } while (0)
        S5_STAGE(0, 0);
        for (int blk = 0; blk < nblk; ++blk) { const int blkc = blk;
#pragma unroll
            for (int nt = 0; nt < 4; ++nt) { const int t = 4 * blk + nt, cur = nt & 1;
                { const int tn = t + 1 < ntile ? t + 1 : ntile - 1; S5_STAGE(tn, cur ^ 1); }
                asm volatile("s_waitcnt vmcnt(2)" ::: "memory");
                __syncthreads();
                f32x4 acc = (f32x4){0.f, 0.f, 0.f, 0.f};
                const LAS unsigned char* xs = F.lds + XS_OFF + cur * XS_BUF + fr * XS_STRIDE + fq * 16;
#pragma unroll
                for (int kk = 0; kk < 16; ++kk) { const bf16x8 bfrag = *(const LAS bf16x8*)(xs + kk * 64); acc = __builtin_amdgcn_mfma_f32_16x16x32_bf16(af[kk], bfrag, acc, 0, 0, 0); }
#pragma unroll
                for (int r = 0; r < 4; ++r) Eb[(16 * w + 4 * fq + r) * 65 + 16 * nt + fr] = acc[r];
                __syncthreads(); }
            if (S5_PF && blkc + 2 < nblk) l2_touch(F, (const unsigned char*)XB + (size_t)(blkc + 2) * 65536 + (size_t)tid * 128);
            __syncthreads();
            if (w == 0 && !(part & 4)) {
                const bool wr_s = 64 * blkc >= 128 * q;
#pragma unroll 1
                for (int j0 = 0; j0 < 64; j0 += 16) { float er[16], ei[16];
#pragma unroll
                    for (int i = 0; i < 16; ++i) { er[i] = Eb[lane * 65 + j0 + i]; ei[i] = Eb[(64 + lane) * 65 + j0 + i]; }
                    LAS bf16* sp = Sb + (64 * blkc + j0 - 128 * q) * S5_S_STRIDE + lane;
#pragma unroll
                    for (int i = 0; i < 16; ++i) {
                        if (wr_s) { sp[i * S5_S_STRIDE] = (bf16)(pk2x(sre, 0.f) & 0xffffu); sp[i * S5_S_STRIDE + 64] = (bf16)(pk2x(sim, 0.f) & 0xffffu); }
                        const float nr = are * sre - aim * sim + er[i], ni = are * sim + aim * sre + ei[i]; sre = nr; sim = ni; } }
            }
            __syncthreads();
        }
#undef S5_STAGE
    }
#ifndef S5_V3
#define S5_V3 1
#endif
#if S5_V3
    if (part & 2) {
        const bf16* xr = XB + (size_t)(128 * q + 16 * w + fr) * 512 + 8 * fq;
        bf16x8 bf[16], sf[4], cfa[4], cfb[4];
#pragma unroll
        for (int kk = 0; kk < 16; ++kk) bf[kk] = *(const GAS bf16x8*)(xr + 32 * kk);
        const bf16* cmp = CMAT + (size_t)fr * 128 + 8 * fq;
#pragma unroll
        for (int kk = 0; kk < 4; ++kk) cfa[kk] = *(const GAS bf16x8*)(cmp + 32 * kk);
#pragma unroll
        for (int kk = 0; kk < 4; ++kk) sf[kk] = *(const LAS bf16x8*)(Sb + (16 * w + fr) * S5_S_STRIDE + 32 * kk + 8 * fq);
        const int ktl = 512 - (lane >> 5) * 512 + fr * 32 + (fq & 1) * 16;
        const size_t tok0 = (size_t)b * SEQ + (size_t)(128 * q + 16 * w + fr) * TC;
#pragma unroll
        for (int mt = 0; mt < 32; ++mt) {
            if (mt + 1 < 32) {
#pragma unroll
                for (int kk = 0; kk < 4; ++kk) cfb[kk] = *(const GAS bf16x8*)(cmp + (size_t)(16 * (mt + 1)) * 128 + 32 * kk); }
            f32x4 acc = (f32x4){0.f, 0.f, 0.f, 0.f};
#pragma unroll
            for (int kk = 0; kk <= mt / 2; ++kk) { const bf16x8 afrag = *(const LAS bf16x8*)(kt + ktl + (mt - 2 * kk) * 512); acc = __builtin_amdgcn_mfma_f32_16x16x32_bf16(afrag, bf[kk], acc, 0, 0, 0); }
#pragma unroll
            for (int kk = 0; kk < 4; ++kk) acc = __builtin_amdgcn_mfma_f32_16x16x32_bf16(cfa[kk], sf[kk], acc, 0, 0, 0);
            v2u o; o.x = pk2x(gelu_t(acc[0]), gelu_t(acc[1])); o.y = pk2x(gelu_t(acc[2]), gelu_t(acc[3]));
            *(GAS v2u*)(ZB + tile16_off((int)(tok0 + mt), g * SGD + 4 * fq, BW)) = o;
#pragma unroll
            for (int kk = 0; kk < 4; ++kk) cfa[kk] = cfb[kk];
        }
    }
#else
    const int mts[4] = {w, 15 - w, 16 + w, 31 - w};
    bf16x8 cf[4][4];
#pragma unroll
    for (int i = 0; i < 4; ++i)
#pragma unroll
        for (int kk = 0; kk < 4; ++kk) cf[i][kk] = *(const GAS bf16x8*)(CMAT + (size_t)(16 * mts[i] + fr) * 128 + 32 * kk + 8 * fq);
    const int ktl = 512 - (lane >> 5) * 512 + fr * 32 + (fq & 1) * 16;
#pragma unroll 1
    for (int nt = 0; nt < ((part & 2) ? 8 : 0); ++nt) {
        const bf16* xr = XB + (size_t)(128 * q + 16 * nt + fr) * 512 + 8 * fq;
        f32x4 acc[4];
#pragma unroll
        for (int i = 0; i < 4; ++i) acc[i] = (f32x4){0.f, 0.f, 0.f, 0.f};
        { bf16x8 bf[16];
#pragma unroll
            for (int kk = 0; kk < 16; ++kk) bf[kk] = *(const GAS bf16x8*)(xr + 32 * kk);
#if S5_SB3
            __builtin_amdgcn_sched_barrier(0);
#endif
#pragma unroll
            for (int kk = 0; kk < 16; ++kk) {
#pragma unroll
                for (int i = 0; i < 4; ++i) { const int d0 = mts[i] - 2 * kk;
                    if (d0 >= 0) { const bf16x8 afrag = *(const LAS bf16x8*)(kt + ktl + d0 * 512); acc[i] = __builtin_amdgcn_mfma_f32_16x16x32_bf16(afrag, bf[kk], acc[i], 0, 0, 0); } }
                asm volatile("" ::: "memory"); } }
#pragma unroll
        for (int kk = 0; kk < 4; ++kk) { const bf16x8 sfrag = *(const LAS bf16x8*)(Sb + (16 * nt + fr) * S5_S_STRIDE + 32 * kk + 8 * fq);
#pragma unroll
            for (int i = 0; i < 4; ++i) acc[i] = __builtin_amdgcn_mfma_f32_16x16x32_bf16(cf[i][kk], sfrag, acc[i], 0, 0, 0); }
#pragma unroll
        for (int i = 0; i < 4; ++i) { const size_t tok = (size_t)b * SEQ + (size_t)(128 * q + 16 * nt + fr) * TC + mts[i];
            v2u o; o.x = pk2x(gelu_t(acc[i][0]), gelu_t(acc[i][1])); o.y = pk2x(gelu_t(acc[i][2]), gelu_t(acc[i][3]));
            *(GAS v2u*)(ZB + tile16_off((int)tok, g * SGD + 4 * fq, BW)) = o; }
    }
#endif
    __syncthreads();
}

#ifndef X1_BF16
#define X1_BF16 1
#endif
__device__ __forceinline__ void n1_load(Frame& F, const Args& A, int m, f32x4 (&xv)[16], float& pv) {
    const int lane = F.lane; const GAS f32x4* xr = (const GAS f32x4*)(A.in[I_X] + (size_t)m * D) + lane;
    pv = ((const float*)(F.ws + WS_PART) + (size_t)m * 64)[lane];
#pragma unroll
    for (int j = 0; j < 16; ++j) xv[j] = LD_STREAM(xr + 64 * j);
}
__device__ __forceinline__ void n1_mix(Frame& F, int m, v2u (&mv)[16]) {
    const int lane = F.lane;
    const GAS bf16* mixp = (const GAS bf16*)((const bf16*)(F.ws + WS_ARB) + mix_off(m, 4 * lane)); const size_t mstep = mix_off(0, 256);
#pragma unroll
    for (int j = 0; j < 16; ++j) { mv[j] = LD_STREAM((const GAS v2u*)mixp); mixp += mstep; }
}
__device__ __forceinline__ void n1_proc(Frame& F, const Args& A, int m, f32x4 (&v)[16], v2u (&mv)[16], float pv) {
    const int lane = F.lane; const float rstd1 = 1.0f / sqrtf(wave_sum(pv) * (1.f / D) + NORM_EPS);
    const LAS f32x4* g1 = (const LAS f32x4*)(F.lds + RING_OFF) + lane; const LAS f32x4* g2 = (const LAS f32x4*)(F.lds + RING_OFF + D * 4) + lane;
    GAS f32x4* orow = (GAS f32x4*)(F.out + (size_t)m * D) + lane; GAS v2u* x1row = (GAS v2u*)(F.out + (size_t)m * D + D / 2) + lane;
    float s = 0.f;
#pragma unroll
    for (int j = 0; j < 16; ++j) { const f32x4 gg = g1[64 * j]; const v2u mm = mv[j];
        v[j].x += bflo(mm.x) * rstd1 * gg.x; v[j].y += bfhi(mm.x) * rstd1 * gg.y; v[j].z += bflo(mm.y) * rstd1 * gg.z; v[j].w += bfhi(mm.y) * rstd1 * gg.w;
        s += (v[j].x * v[j].x + v[j].y * v[j].y) + (v[j].z * v[j].z + v[j].w * v[j].w);
        if (X1_BF16) { v2u o; o.x = pk2x(v[j].x, v[j].y); o.y = pk2x(v[j].z, v[j].w); ST_STREAM(x1row + 64 * j, o); } else orow[64 * j] = v[j];
        asm volatile("" ::: "memory"); }
    const float rstd2 = 1.0f / sqrtf(wave_sum(s) * (1.f / D) + NORM_EPS);
    float am = 0.f;
#pragma unroll
    for (int j = 0; j < 16; ++j) { const f32x4 gg = g2[64 * j]; v[j].x *= rstd2 * gg.x; v[j].y *= rstd2 * gg.y; v[j].z *= rstd2 * gg.z; v[j].w *= rstd2 * gg.w;
        am = fmaxf(fmaxf(am, fmaxf(fabsf(v[j].x), fabsf(v[j].y))), fmaxf(fabsf(v[j].z), fabsf(v[j].w))); asm volatile("" ::: "memory"); }
    am = fmaxf(wave_max(am), 1e-30f); const float qs = 127.0f / am;
    if (lane == 0) ((float*)(F.ws + WS_RS2))[m] = am * (1.0f / 127.0f);
    GAS unsigned char* q8 = (GAS unsigned char*)(F.ws + WS_H2Q + tile8_off(m, 4 * lane, D)); const size_t qstep = tile8_off(0, 256, D);
#pragma unroll
    for (int j = 0; j < 16; ++j) { *(GAS unsigned*)q8 = pk4_i8(v[j].x * qs, v[j].y * qs, v[j].z * qs, v[j].w * qs); q8 += qstep; }
}
__device__ __forceinline__ void n1_phase(Frame& F, const Args& A) {
    const int gw = F.vcu * NWAVES + F.wave, NGW = F.G * NWAVES;
    for (int i = F.tid; i < D / 4; i += NWAVES * 64) { ((LAS f32x4*)(F.lds + RING_OFF))[i] = ((const GAS f32x4*)A.in[I_NMIXPOST])[i]; ((LAS f32x4*)(F.lds + RING_OFF + D * 4))[i] = ((const GAS f32x4*)A.in[I_NMLPPRE])[i]; }
    __syncthreads();
    f32x4 xa[16], xb[16]; v2u mv[16]; float pa = 0.f, pb = 0.f;
    if (gw < M) n1_load(F, A, gw, xa, pa);
    for (int m = gw; m < M; m += 2 * NGW) {
        const int m1 = m + NGW < M ? m + NGW : m, m2 = m + 2 * NGW < M ? m + 2 * NGW : m1;
        n1_mix(F, m, mv);
        n1_load(F, A, m1, xb, pb);
        n1_proc(F, A, m, xa, mv, pa);
        if (m + NGW < M) {
            n1_mix(F, m1, mv);
            n1_load(F, A, m2, xa, pa);
            n1_proc(F, A, m1, xb, mv, pb); }
    }
}
#if X1_BF16
typedef v2u x1v_t;
#else
typedef f32x4 x1v_t;
#endif
#ifndef ROWS_BATCH
#define ROWS_BATCH 1
#endif
__device__ __forceinline__ void n2_load(Frame& F, int m, x1v_t (&xv)[16], v2u (&fv)[16], float& pv) {
    const int lane = F.lane; const GAS x1v_t* xr = (const GAS x1v_t*)(F.out + (size_t)m * D + (X1_BF16 ? D / 2 : 0)) + lane;
    pv = ((const float*)(F.ws + WS_PART) + (size_t)m * 64)[lane];
#pragma unroll
    for (int j = 0; j < 16; ++j) xv[j] = LD_STREAM(xr + 64 * j);
    const GAS bf16* ffp = (const GAS bf16*)((const bf16*)(F.ws + WS_ARB) + mix_off(m, 4 * lane)); const size_t fstep = mix_off(0, 256);
#pragma unroll
    for (int j = 0; j < 16; ++j) { fv[j] = LD_STREAM((const GAS v2u*)ffp); ffp += fstep; }
}
__device__ __forceinline__ void n2_proc(Frame& F, const Args& A, int m, x1v_t (&v)[16], v2u (&fv)[16], float pv) {
    const int lane = F.lane; const float rstd = 1.0f / sqrtf(wave_sum(pv) * (1.f / D) + NORM_EPS);
    const LAS f32x4* g1 = (const LAS f32x4*)(F.lds + RING_OFF) + lane; GAS f32x4* orow = (GAS f32x4*)(F.out + (size_t)m * D) + lane;
#pragma unroll
    for (int j = 0; j < 16; ++j) { const f32x4 gg = g1[64 * j]; const v2u mm = fv[j]; f32x4 x;
#if X1_BF16
        x.x = bflo(v[j].x); x.y = bfhi(v[j].x); x.z = bflo(v[j].y); x.w = bfhi(v[j].y);
#else
        x = v[j];
#endif
        x.x += bflo(mm.x) * rstd * gg.x; x.y += bfhi(mm.x) * rstd * gg.y; x.z += bflo(mm.y) * rstd * gg.z; x.w += bfhi(mm.y) * rstd * gg.w; ST_STREAM(orow + 64 * j, x); }
}
__device__ __forceinline__ void n2_phase(Frame& F, const Args& A) {
    const int gw = F.vcu * NWAVES + F.wave, NGW = F.G * NWAVES;
    for (int i = F.tid; i < D / 4; i += NWAVES * 64) ((LAS f32x4*)(F.lds + RING_OFF))[i] = ((const GAS f32x4*)A.in[I_NMLPPOST])[i];
    __syncthreads();
    x1v_t xa[16], xb[16]; v2u fa[16], fb[16]; float pa = 0.f, pb = 0.f;
    if (gw < M) n2_load(F, gw, xa, fa, pa);
    for (int m = gw; m < M; m += 2 * NGW) {
        const int m1 = m + NGW < M ? m + NGW : m, m2 = m + 2 * NGW < M ? m + 2 * NGW : m1;
        n2_load(F, m1, xb, fb, pb);
        n2_proc(F, A, m, xa, fa, pa);
        if (m + NGW < M) {
            n2_load(F, m2, xa, fa, pa);
            n2_proc(F, A, m1, xb, fb, pb); }
    }
}

__global__ void __launch_bounds__(NWAVES * 64, 2) mk_fwd(Args args) {
    extern __shared__ __attribute__((aligned(16))) unsigned char lds[];
    Frame F;
    F.lds = (LAS unsigned char*)lds;
    F.MISC = (volatile LAS unsigned*)(F.lds + MISC_OFF);
    F.tid = threadIdx.x; F.lane = F.tid & 63; F.wave = __builtin_amdgcn_readfirstlane(F.tid >> 6);
    F.G = gridDim.x; { const int bx = blockIdx.x; F.vcu = (F.G % 8 == 0) ? (bx % 8) * (F.G / 8) + bx / 8 : bx; }
    F.ws = args.ws; F.out = args.out;
    F.ctl = (gu32*)(F.ws + WS_CTL);
    for (int u = F.tid; u < (LDS_BYTES - LDSCTL_OFF) / 4; u += NWAVES * 64) ((LAS unsigned*)(F.lds + LDSCTL_OFF))[u] = 0u;
    __syncthreads();
    XcdBarrier bar; bar.bar = (unsigned*)(F.ctl + CW_BAR); bar.x = 0; bar.st = nullptr;
    if (N_LAUNCHES == 1) bar = xcd_barrier_post((unsigned*)(F.ctl + CW_BAR), F.MISC + 8);
#define GRID_BAR() do { if (N_LAUNCHES == 1) xcd_barrier(bar); } while (0)
    const int lo = args.ph_lo, hi = args.ph_hi;
#ifndef PH_MASK
#define PH_MASK 0x3ff
#endif
#define IN(k) (((PH_MASK >> (k)) & 1) && lo <= (k) && (k) < hi)
#define BOTH(k) (IN(k) && IN((k) + 1))
#ifndef DUP_MASK
#define DUP_MASK 0
#endif
#define NREP(k) (((DUP_MASK >> (k)) & 1) ? 2 : 1)
    unsigned char* ws = F.ws;
    bf16* ARB = (bf16*)(ws + WS_ARB);

    if (IN(0)) {
_Pragma("unroll")
        for (int rep = 0; rep < NREP(0); ++rep) { p0_prologue(F, args); if (REGQ) p0_quant_rounds(F, args, bar); else { GRID_BAR(); p0_quantize(F, args); } if (BOTH(0) || rep + 1 < NREP(0)) GRID_BAR(); }
    }

    if (IN(1)) {
_Pragma("unroll")
      for (int rep = 0; rep < NREP(1); ++rep) {
        if (N16 > 0) { pg8::Gemm g{ARB, (const bf16*)(ws + WS_WIN), M, N16, D}; pg8::StaticOrder S; S.init(M, N16, F.G, (int)blockIdx.x);
          pg8::EpiIn E{(bf16*)(ws + WS_UA), (bf16*)(ws + WS_VA), (bf16*)(ws + WS_XB2), (bf16*)(ws + WS_GA), (bf16*)(ws + WS_GB), (float*)(ws + WS_PART), 8, 0, 8, nullptr, nullptr, TILED_A};
          pg8::gemm_phase<pg8::EpiIn, pg8::StaticOrder, PG8_ALIGN, PG8_SP2, false, 0, false, true>(F.lds + RING_OFF, g, S, E); }
        { pg8::Gemm g{(const bf16*)(ws + WS_H8), (const bf16*)(ws + WS_W8), M, NG8, D / 2}; pg8::StaticOrder S; S.init(M, NG8, F.G, (int)blockIdx.x);
          pg8::EpiIn E{(bf16*)(ws + WS_UA), (bf16*)(ws + WS_VA), (bf16*)(ws + WS_XB2), (bf16*)(ws + WS_GA), (bf16*)(ws + WS_GB), (float*)(ws + WS_PART), IN_INT8 == 2 ? 0 : 8, IN_INT8 == 2 ? 0 : 8, IN_INT8 == 2 ? 0 : IN_INT8 == 1 ? 8 : 12, (const float*)(ws + WS_RS1), (const float*)(ws + WS_CSIN), TILED_A};
          pg8::gemm_phase<pg8::EpiIn, pg8::StaticOrder, I8_ALIGN, I8_SP2, true, 0, TILED_A, true>(F.lds + RING_OFF, g, S, E); }
        if (BOTH(1) || rep + 1 < NREP(1)) GRID_BAR();
      }
    }

    if (IN(2)) {
_Pragma("unroll")
      for (int rep = 0; rep < NREP(2); ++rep) {
#ifndef SPG_REP
#define SPG_REP 1
#endif
#ifndef S5_REP
#define S5_REP 1
#endif
#ifndef S5_PART
#define S5_PART 3
#endif
_Pragma("unroll 1")
        for (int u = F.vcu; u < 256 * SPG_REP; u += F.G) { spatial_unit(F, args, u & 255); if (SPG_REP > 1) __syncthreads(); }
        __syncthreads();
_Pragma("unroll 1")
        for (int u = F.vcu; u < 256 * S5_REP; u += F.G) { s5_unit(F, u & 255, u < 256 ? 3 : S5_PART); if (S5_REP > 1) __syncthreads(); }
        if (BOTH(2) || rep + 1 < NREP(2)) GRID_BAR();
      }
    }

    if (IN(3)) {
_Pragma("unroll")
      for (int rep = 0; rep < NREP(3); ++rep) {
        pg8::Gemm g{(const bf16*)(ws + WS_ZB), (const bf16*)(ws + WS_WGLU), M, 2 * D, BW}; pg8::StaticOrder S; S.init(M, 2 * D, F.G, (int)blockIdx.x, P345_WGM);
        pg8::EpiGlu E{(bf16*)(ws + WS_GB), TILED_A};
        pg8::gemm_phase<pg8::EpiGlu, pg8::StaticOrder, PG8_ALIGN, PG8_SP2, false, 0, TILED_A, true>(F.lds + RING_OFF, g, S, E);
        if (BOTH(3) || rep + 1 < NREP(3)) GRID_BAR();
      }
    }

    if (IN(4)) {
_Pragma("unroll")
      for (int rep = 0; rep < NREP(4); ++rep) {
        pg8::Gemm g{ARB, (const bf16*)(ws + WS_WPROJ), M, D, AW}; pg8::StaticOrder S; S.init(M, D, F.G, (int)blockIdx.x, P345_WGM);
        pg8::EpiProj E{(bf16*)(ws + WS_GA), (const bf16*)(ws + WS_GB), TILED_A};
        pg8::gemm_phase<pg8::EpiProj, pg8::StaticOrder, PG8_ALIGN, PG8_SP2, false, 0, TILED_A, true>(F.lds + RING_OFF, g, S, E);
        if (BOTH(4) || rep + 1 < NREP(4)) GRID_BAR();
      }
    }

    if (IN(5)) {
_Pragma("unroll")
      for (int rep = 0; rep < NREP(5); ++rep) {
        pg8::Gemm g{(const bf16*)(ws + WS_GA), (const bf16*)(ws + WS_WOUT), M, D, D}; pg8::StaticOrder S; S.init(M, D, F.G, (int)blockIdx.x, P345_WGM);
        pg8::EpiStat E{ARB, (float*)(ws + WS_PART), TILED_MIX};
        pg8::gemm_phase<pg8::EpiStat, pg8::StaticOrder, PG8_ALIGN, PG8_SP2, false, 0, TILED_A, true>(F.lds + RING_OFF, g, S, E);
        if (BOTH(5) || rep + 1 < NREP(5)) GRID_BAR();
      }
    }

    if (IN(6)) {
_Pragma("unroll")
      for (int rep = 0; rep < NREP(6); ++rep) {
        n1_phase(F, args);
        if (BOTH(6) || rep + 1 < NREP(6)) GRID_BAR();
      }
    }

    if (IN(7)) {
_Pragma("unroll")
      for (int rep = 0; rep < NREP(7); ++rep) {
        pg8::Gemm g{(const bf16*)(ws + WS_H2Q), (const bf16*)(ws + WS_WUP), M, DFF, D / 2}; pg8::StaticOrder S; S.init(M, DFF, F.G, (int)blockIdx.x, P7_WGM);
        pg8::EpiUp E{(bf16*)(ws + WS_ARA), (const float*)(ws + WS_RS2), (const float*)(ws + WS_CSUP), TILED_HID};
        pg8::gemm_phase<pg8::EpiUp, pg8::StaticOrder, I8_ALIGN, I8_SP2, true, 0, TILED_A, true>(F.lds + RING_OFF, g, S, E);
        if (BOTH(7) || rep + 1 < NREP(7)) GRID_BAR();
      }
    }

    if (IN(8)) {
_Pragma("unroll")
      for (int rep = 0; rep < NREP(8); ++rep) {
        pg8::Gemm g{(const bf16*)(ws + WS_ARA), (const bf16*)(ws + WS_WDN), M, D, DFF}; pg8::StaticOrder S; S.init(M, D, F.G, (int)blockIdx.x, P8_WGM);
        pg8::EpiStat E{ARB, (float*)(ws + WS_PART), TILED_MIX};
        pg8::gemm_phase<pg8::EpiStat, pg8::StaticOrder, PG8_ALIGN, PG8_SP2, false, P8_AUXA, TILED_HID != 0, true>(F.lds + RING_OFF, g, S, E);
        if (BOTH(8) || rep + 1 < NREP(8)) GRID_BAR();
      }
    }

    if (IN(9)) {
_Pragma("unroll")
      for (int rep = 0; rep < NREP(9); ++rep) {
        n2_phase(F, args);
        if (rep + 1 < NREP(9)) GRID_BAR();
      }
    }
#undef IN
#undef BOTH
}

extern "C" void kernel_launch(void* const* d_in, const int* in_sizes, int n_in, void* d_out, int out_size, void* d_ws, size_t ws_size, hipStream_t stream) {
    static int grid = 0;
    if (grid == 0) {
        if (n_in != 24 || in_sizes[0] != M * D || out_size != M * D || ws_size < WS_END) { fprintf(stderr, "kernel_launch: unexpected shapes / workspace (n_in %d, ws %zu < %zu)\n", n_in, ws_size, (size_t)WS_END); grid = -1; return; }
        int dev = 0, cus = 0, per_cu = 0;
        if (hipGetDevice(&dev) != hipSuccess || hipDeviceGetAttribute(&cus, hipDeviceAttributeMultiprocessorCount, dev) != hipSuccess) { grid = -1; return; }
        if (hipFuncSetAttribute((const void*)mk_fwd, hipFuncAttributeMaxDynamicSharedMemorySize, LDS_BYTES) != hipSuccess) { grid = -1; return; }
        if (hipOccupancyMaxActiveBlocksPerMultiprocessor(&per_cu, (const void*)mk_fwd, NWAVES * 64, LDS_BYTES) != hipSuccess || per_cu < 1) { fprintf(stderr, "kernel_launch: occupancy query says %d\n", per_cu); }
        (void)hipGetLastError();
        grid = cus;
    }
    if (grid < 0) return;
    if (hipMemsetAsync((char*)d_ws + WS_CTL, 0, CTL_ZERO_BYTES, stream) != hipSuccess) return;
    Args a{};
    for (int i = 0; i < 24; ++i) a.in[i] = (const float*)d_in[i];
    a.out = (float*)d_out; a.ws = (unsigned char*)d_ws;
    if (N_LAUNCHES == 1) { a.ph_lo = 0; a.ph_hi = N_PHASES; hipLaunchKernelGGL(mk_fwd, dim3(grid), dim3(NWAVES * 64), LDS_BYTES, stream, a); }
    else for (int li = 0; li < N_PHASES; ++li) { a.ph_lo = li; a.ph_hi = li + 1; hipLaunchKernelGGL(mk_fwd, dim3(grid), dim3(NWAVES * 64), LDS_BYTES, stream, a); }
}
```
